# Optimizing an MI355X kernel written in HIP

```python
import math
import jax, jax.numpy as jnp
from jax import lax
import numpy as np

D_MODEL = 1024
BATCH = 8
SEQ = 8192
DEPTH = 1
DEC_BATCH = 32
DEC_SEQ = 2048
PAST_LEN = 128

HEAD_DIM = 64
N_HEADS_A = 8
KV_HEADS_A = 2
N_HEADS_B = 8
KV_HEADS_B = 2
N_HEADS_C = 4
HEAD_DIM_C = 128
MEM_LEN = 256
WIDTH_A = N_HEADS_A * HEAD_DIM
WIDTH_B = N_HEADS_B * HEAD_DIM
WIDTH_C = N_HEADS_C * HEAD_DIM_C
D_FF = 2816
BLOCK = 128
WINDOW = 128
GRID_W = 64
ROPE_THETA = 10000.0
N_BUCKETS = 32
MAX_DISTANCE = 128
EPS = 1e-6
NEG_INF = -1e30
SPLIT_WIDTHS = (WIDTH_A, KV_HEADS_A * HEAD_DIM, KV_HEADS_A * HEAD_DIM,
                WIDTH_B, KV_HEADS_B * HEAD_DIM, KV_HEADS_B * HEAD_DIM,
                WIDTH_C, D_MODEL, D_MODEL, D_MODEL)
W_IN_COLS = sum(SPLIT_WIDTHS)

kernel_name = "hybrid_gated_encoder_block"


def _rmsnorm(x, g):
    xf = x.astype(jnp.float32)
    y = xf * lax.rsqrt(jnp.mean(xf * xf, axis=-1, keepdims=True) + EPS)
    return (y * g.astype(jnp.float32)).astype(x.dtype)


def _swiglu(x, w_in, w_out):
    gu = x @ w_in
    g, u = jnp.split(gu, 2, axis=-1)
    return (jax.nn.silu(g) * u) @ w_out


def _axial_rope(seq_len):
    rows = seq_len // GRID_W
    row = jnp.repeat(jnp.arange(rows, dtype=jnp.float32), GRID_W)
    col = jnp.tile(jnp.arange(GRID_W, dtype=jnp.float32), rows)
    axis_dim = HEAD_DIM // 2
    inv = ROPE_THETA ** (-jnp.arange(0, axis_dim, 2, dtype=jnp.float32) / axis_dim)
    ang = jnp.concatenate([row[:, None] * inv, col[:, None] * inv], axis=-1)
    return jnp.cos(ang), jnp.sin(ang)


def _apply_rope(x, cos, sin):
    B, S, H, D = x.shape
    xf = x.astype(jnp.float32).reshape(B, S, H, D // 2, 2)
    x0, x1 = xf[..., 0], xf[..., 1]
    c = cos[None, :, None, :]
    s = sin[None, :, None, :]
    out = jnp.stack([x0 * c - x1 * s, x0 * s + x1 * c], axis=-1)
    return out.reshape(B, S, H, D).astype(x.dtype)


def _t5_bucket(rel):
    nb = N_BUCKETS // 2
    max_exact = nb // 2
    ret = jnp.where(rel > 0, nb, 0)
    n = jnp.abs(rel)
    nf = jnp.maximum(n, 1).astype(jnp.float32)
    large = max_exact + (jnp.log(nf / max_exact) / math.log(MAX_DISTANCE / max_exact)
                         * (nb - max_exact)).astype(jnp.int32)
    large = jnp.minimum(large, nb - 1)
    return ret + jnp.where(n < max_exact, n, large)


def _global_attn(q, k, v):
    B, S, H, hd = q.shape
    kvh = k.shape[2]
    G = H // kvh
    nblk = S // BLOCK
    scale = hd ** -0.5
    qb = q.reshape(B, nblk, BLOCK, kvh, G, hd).transpose(1, 0, 2, 3, 4, 5)

    def one(qblk):
        s = jnp.einsum('bqkgd,bskd->bkgqs', qblk, k).astype(jnp.float32) * scale
        p = jax.nn.softmax(s, axis=-1)
        return jnp.einsum('bkgqs,bskd->bqkgd', p.astype(v.dtype), v)

    ob = lax.map(one, qb)
    return ob.transpose(1, 0, 2, 3, 4, 5).reshape(B, S, H * hd)


def _window_attn(q, k, v, bias, sink):
    B, S, H, hd = q.shape
    kvh = k.shape[2]
    G = H // kvh
    nblk = S // BLOCK
    scale = hd ** -0.5
    pad = ((0, 0), (BLOCK, BLOCK), (0, 0), (0, 0))
    kp = jnp.pad(k, pad).reshape(B, nblk + 2, BLOCK, kvh, hd)
    vp = jnp.pad(v, pad).reshape(B, nblk + 2, BLOCK, kvh, hd)
    kw = jnp.concatenate([kp[:, :-2], kp[:, 1:-1], kp[:, 2:]], axis=2)
    vw = jnp.concatenate([vp[:, :-2], vp[:, 1:-1], vp[:, 2:]], axis=2)
    qb = q.reshape(B, nblk, BLOCK, kvh, G, hd)
    s = jnp.einsum('bnqkgd,bnskd->bnkgqs', qb, kw).astype(jnp.float32) * scale
    s = s + bias.astype(jnp.float32).reshape(kvh, G, BLOCK, 3 * BLOCK)
    il = jnp.arange(BLOCK)[:, None]
    jl = jnp.arange(3 * BLOCK)[None, :]
    rel = jl - BLOCK - il
    kpos = (jnp.arange(nblk) * BLOCK - BLOCK)[:, None, None] + jl[None]
    mask = (jnp.abs(rel) <= WINDOW)[None] & (kpos >= 0) & (kpos < S)
    s = jnp.where(mask[None, :, None, None], s, NEG_INF)
    sk = sink.astype(jnp.float32).reshape(kvh, G)[None, None, :, :, None]
    m = jnp.maximum(jnp.max(s, axis=-1), sk)
    p = jnp.exp(s - m[..., None])
    p = p / (jnp.sum(p, axis=-1, keepdims=True) + jnp.exp(sk - m)[..., None])
    o = jnp.einsum('bnkgqs,bnskd->bnqkgd', p.astype(v.dtype), vw)
    return o.reshape(B, S, H * hd)


def _cross_attn(q, k, v):
    B, S, H, hd = q.shape
    s = jnp.einsum('bshd,bmhd->bhsm', q, k).astype(jnp.float32) * (hd ** -0.5)
    p = jax.nn.softmax(s, axis=-1)
    return jnp.einsum('bhsm,bmhd->bshd', p.astype(v.dtype), v).reshape(B, S, H * hd)


def _trunk(x, mem, rel_bias, norm_ffn1, ffn1_w_in, ffn1_w_out, norm_mix, w_in,
           q_norm_a, k_norm_a, sink_b, norm_mem, w_mem_kv, w_br_a, w_br_b, w_br_c,
           w_out, norm_ffn2, ffn2_w_in, ffn2_w_out, norm_final):
    B, S, _ = x.shape
    cos, sin = _axial_rope(S)
    rel = jnp.arange(3 * BLOCK)[None, :] - BLOCK - jnp.arange(BLOCK)[:, None]
    bias_b = jnp.transpose(rel_bias[_t5_bucket(rel)], (2, 0, 1))
    offsets = list(np.cumsum(SPLIT_WIDTHS)[:-1])
    h = x
    for l in range(DEPTH):
        h = h + 0.5 * _swiglu(_rmsnorm(h, norm_ffn1[l]), ffn1_w_in[l], ffn1_w_out[l])
        n = _rmsnorm(h, norm_mix[l])
        proj = n @ w_in[l]
        qa, ka, va, qb, kb, vb, qc, ga, gb, gc = jnp.split(proj, offsets, axis=-1)
        qa = _apply_rope(_rmsnorm(qa.reshape(B, S, N_HEADS_A, HEAD_DIM), q_norm_a[l]), cos, sin)
        ka = _apply_rope(_rmsnorm(ka.reshape(B, S, KV_HEADS_A, HEAD_DIM), k_norm_a[l]), cos, sin)
        ya = _global_attn(qa, ka, va.reshape(B, S, KV_HEADS_A, HEAD_DIM))
        yb = _window_attn(qb.reshape(B, S, N_HEADS_B, HEAD_DIM),
                          kb.reshape(B, S, KV_HEADS_B, HEAD_DIM),
                          vb.reshape(B, S, KV_HEADS_B, HEAD_DIM), bias_b, sink_b[l])
        kvm = _rmsnorm(mem, norm_mem[l]) @ w_mem_kv[l]
        kc, vc = jnp.split(kvm, 2, axis=-1)
        M = mem.shape[1]
        yc = _cross_attn(qc.reshape(B, S, N_HEADS_C, HEAD_DIM_C),
                         kc.reshape(B, M, N_HEADS_C, HEAD_DIM_C),
                         vc.reshape(B, M, N_HEADS_C, HEAD_DIM_C))
        merged = (jax.nn.sigmoid(ga) * (ya @ w_br_a[l])
                  + jax.nn.sigmoid(gb) * (yb @ w_br_b[l])
                  + jax.nn.sigmoid(gc) * (yc @ w_br_c[l]))
        h = h + merged @ w_out[l]
        h = h + 0.5 * _swiglu(_rmsnorm(h, norm_ffn2[l]), ffn2_w_in[l], ffn2_w_out[l])
    return _rmsnorm(h, norm_final)


def setup_inputs(seed: int = 0) -> dict:
    key = jax.random.key(seed)
    ks = jax.random.split(key, 32)
    f32 = jnp.float32

    def nrm(k, shape, scale):
        return jax.random.normal(k, shape, f32) * scale

    def gain(k, shape):
        return 1.0 + 0.05 * jax.random.normal(k, shape, f32)

    L, D = DEPTH, D_MODEL
    return {
        "x_prompt": nrm(ks[0], (BATCH, SEQ, D), 1.0),
        "x_sample": nrm(ks[1], (DEC_BATCH, DEC_SEQ, D), 1.0),
        "mem_prompt": nrm(ks[2], (BATCH, MEM_LEN, D), 1.0),
        "mem_sample": nrm(ks[3], (DEC_BATCH, MEM_LEN, D), 1.0),
        "rel_bias": nrm(ks[4], (N_BUCKETS, N_HEADS_B), 0.5),
        "norm_ffn1": gain(ks[5], (L, D)),
        "ffn1_w_in": nrm(ks[6], (L, D, 2 * D_FF), D ** -0.5),
        "ffn1_w_out": nrm(ks[7], (L, D_FF, D), D_FF ** -0.5),
        "norm_mix": gain(ks[8], (L, D)),
        "w_in": nrm(ks[9], (L, D, W_IN_COLS), D ** -0.5),
        "q_norm_a": gain(ks[10], (L, HEAD_DIM)),
        "k_norm_a": gain(ks[11], (L, HEAD_DIM)),
        "sink_b": nrm(ks[12], (L, N_HEADS_B), 0.5),
        "norm_mem": gain(ks[13], (L, D)),
        "w_mem_kv": nrm(ks[14], (L, D, 2 * WIDTH_C), D ** -0.5),
        "w_br_a": nrm(ks[15], (L, WIDTH_A, D), WIDTH_A ** -0.5),
        "w_br_b": nrm(ks[16], (L, WIDTH_B, D), WIDTH_B ** -0.5),
        "w_br_c": nrm(ks[17], (L, WIDTH_C, D), WIDTH_C ** -0.5),
        "w_out": nrm(ks[18], (L, D, D), D ** -0.5),
        "norm_ffn2": gain(ks[19], (L, D)),
        "ffn2_w_in": nrm(ks[20], (L, D, 2 * D_FF), D ** -0.5),
        "ffn2_w_out": nrm(ks[21], (L, D_FF, D), D_FF ** -0.5),
        "norm_final": gain(ks[22], (D,)),
    }


def reference(x_prompt, x_sample, mem_prompt, mem_sample, rel_bias, norm_ffn1, ffn1_w_in,
              ffn1_w_out, norm_mix, w_in, q_norm_a, k_norm_a, sink_b, norm_mem, w_mem_kv,
              w_br_a, w_br_b, w_br_c, w_out, norm_ffn2, ffn2_w_in, ffn2_w_out, norm_final):
    y_prompt = _trunk(x_prompt, mem_prompt, rel_bias, norm_ffn1, ffn1_w_in, ffn1_w_out,
                      norm_mix, w_in, q_norm_a, k_norm_a, sink_b, norm_mem, w_mem_kv,
                      w_br_a, w_br_b, w_br_c, w_out, norm_ffn2, ffn2_w_in, ffn2_w_out,
                      norm_final)
    y_sample = _trunk(x_sample, mem_sample, rel_bias, norm_ffn1, ffn1_w_in, ffn1_w_out,
                      norm_mix, w_in, q_norm_a, k_norm_a, sink_b, norm_mem, w_mem_kv,
                      w_br_a, w_br_b, w_br_c, w_out, norm_ffn2, ffn2_w_in, ffn2_w_out,
                      norm_final)
    return (y_prompt, y_sample)
```

```cpp
#include <hip/hip_runtime.h>
#include <hip/hip_cooperative_groups.h>
#include <cstdio>
#include <cstdint>
namespace cg = cooperative_groups;

#ifndef MK_MULTI_LAUNCH
#define MK_MULTI_LAUNCH 1
#endif

#ifndef PH_MASK
#define PH_MASK 0xFFFF
#endif
#define PH_EN(i) ((PH_MASK >> (i)) & 1)
#define LAS __attribute__((address_space(3)))
typedef unsigned short bf16_t;
typedef short bf16x8 __attribute__((ext_vector_type(8)));
typedef float f32x4 __attribute__((ext_vector_type(4)));
typedef float f32x2 __attribute__((ext_vector_type(2)));
typedef float f32x16 __attribute__((ext_vector_type(16)));
typedef unsigned u32x4 __attribute__((ext_vector_type(4)));
typedef unsigned u32x2 __attribute__((ext_vector_type(2)));
typedef __bf16 bf16x2_t __attribute__((ext_vector_type(2)));

constexpr int DM = 1024, FF = 2816, PROJ = 5120, CH = 16384, NCH = 8;
constexpr int NMEM = 40 * 256;
constexpr float EPS = 1e-6f;
constexpr float LOG2E = 1.4426950408889634f;

constexpr size_t al(size_t x) { return (x + 4095) & ~(size_t)4095; }
constexpr size_t WS_WFF1I = 0;
constexpr size_t WS_WFF1O = WS_WFF1I + al((size_t)2 * FF * DM * 2);
constexpr size_t WS_WIN   = WS_WFF1O + al((size_t)DM * FF * 2);
constexpr size_t WS_WMEM  = WS_WIN + al((size_t)PROJ * DM * 2);
constexpr size_t WS_WBR   = WS_WMEM + al((size_t)DM * DM * 2);
constexpr size_t WS_WOUT  = WS_WBR + al((size_t)3 * DM * 512 * 2);
constexpr size_t WS_WFF2I = WS_WOUT + al((size_t)DM * DM * 2);
constexpr size_t WS_WFF2O = WS_WFF2I + al((size_t)2 * FF * DM * 2);
constexpr size_t WS_MEMN  = WS_WFF2O + al((size_t)DM * FF * 2);
constexpr size_t WS_KVM   = WS_MEMN + al((size_t)NMEM * DM * 2);
constexpr size_t WS_VTC   = WS_KVM + al((size_t)NMEM * DM * 2);
constexpr size_t WS_ROPE  = WS_VTC + al((size_t)NMEM * 512 * 2);
constexpr size_t WS_BIAS  = WS_ROPE + al((size_t)128 * 16 * 8);
constexpr size_t WS_XN    = WS_BIAS + al((size_t)8 * 257 * 4);
constexpr size_t WS_HID   = WS_XN + al((size_t)CH * DM * 2);
constexpr size_t WS_PROJ  = WS_HID + al((size_t)CH * FF * 2);
constexpr size_t WS_VTA   = WS_PROJ + al((size_t)CH * PROJ * 2);
constexpr size_t WS_VTB   = WS_VTA + al((size_t)CH * 128 * 2);
constexpr size_t WS_Y     = WS_VTB + al((size_t)CH * 128 * 2);
constexpr size_t WS_PART  = WS_Y + al((size_t)3 * CH * 512 * 2);
constexpr size_t WS_END   = WS_PART + al((size_t)CH * DM * 4);

constexpr int LDS_BYTES = 135168;

__device__ __forceinline__ unsigned pk2(float lo, float hi) { f32x2 v = {lo, hi}; bf16x2_t b = __builtin_convertvector(v, bf16x2_t); return __builtin_bit_cast(unsigned, b); }
__device__ __forceinline__ float bflo(unsigned w) { return __uint_as_float(w << 16); }
__device__ __forceinline__ float bfhi(unsigned w) { return __uint_as_float(w & 0xffff0000u); }
__device__ __forceinline__ float wave_sum(float v) {
#pragma unroll
    for (int o = 1; o < 64; o <<= 1) v += __shfl_xor(v, o);
    return v;
}
__device__ __forceinline__ float sigmoidf_(float x) { return __builtin_amdgcn_rcpf(1.0f + __builtin_amdgcn_exp2f(-x * LOG2E)); }

namespace pg8 {
constexpr int BM = 256, BK = 64, HALF = 128, HTB = HALF * BK * 2, STAGE_BYTES = 8 * HTB, NXCD = 8, WGM = 8;
__host__ __device__ __forceinline__ int lds_byte(int r, int c) { const int st = (r >> 4) * 2 + (c >> 5), rr = r & 15, cc = c & 31, ob = rr * 64 + cc * 2; return st * 1024 + (ob ^ (((ob >> 9) & 1) << 5)); }
__host__ __device__ __forceinline__ void stage_rc(int b, int& R, int& C) { const int st = b / 1024, sb = b % 1024, swz = sb ^ (((sb >> 9) & 1) << 5); R = (st >> 1) * 16 + swz / 64; C = (st & 1) * 32 + (swz % 64) / 2; }
__host__ __device__ __forceinline__ int perm32(int rho) { const int n = rho >> 4, i = rho & 15; return 8 * (i >> 2) + 4 * n + (i & 3); }

struct Unit { int pm, pn, pz; };
struct Gemm { const bf16_t* A; const bf16_t* Bt; int M, N, K; size_t zA, zB; };

struct StaticOrder {
    int nM, nN, nwg, G, c;
    __device__ void init(int M, int N, int G_, int c_) { nM = M / BM; nN = N / BM; nwg = nM * nN; G = G_; c = c_; }
    __device__ bool next(int i, Unit& u) const {
        const long L = (long)i * G + c; if (L >= nwg) return false;
        int wgid = (int)L; { const int q = nwg / NXCD, r = nwg % NXCD, xcd = wgid % NXCD, off = wgid / NXCD; wgid = (xcd < r ? xcd * (q + 1) : r * (q + 1) + (xcd - r) * q) + off; }
        const int nig = WGM * nN, gid = wgid / nig, fm = gid * WGM, gsz = (nM - fm) < WGM ? (nM - fm) : WGM;
        u.pm = fm + ((wgid % nig) % gsz); u.pn = (wgid % nig) / gsz; u.pz = 0; return true;
    }
};
struct BranchOrder {
    StaticOrder b;
    __device__ bool next(int i, Unit& u) const { if (!b.next(i / 3, u)) return false; u.pz = i % 3; return true; }
};

struct EpiPlain {
    static constexpr bool PERM = true;
    bf16_t* O; int ldc;
    __device__ __forceinline__ void operator()(const f32x4 (&acc)[2][2][4][2], const Unit& u, int wr, int wc, int fr, int fq) const {
        const int row0 = u.pm * BM + wr * 64 + fr, col0 = u.pn * BM + wc * 32 + 8 * fq;
#pragma unroll
        for (int ai = 0; ai < 2; ++ai)
#pragma unroll
            for (int m = 0; m < 4; ++m) { bf16_t* rowp = O + (size_t)(row0 + ai * HALF + m * 16) * ldc + col0;
#pragma unroll
                for (int bj = 0; bj < 2; ++bj) { const f32x4 v0 = acc[ai][bj][m][0], v1 = acc[ai][bj][m][1];
                    u32x4 w; w.x = pk2(v0[0], v0[1]); w.y = pk2(v0[2], v0[3]); w.z = pk2(v1[0], v1[1]); w.w = pk2(v1[2], v1[3]);
                    *(u32x4*)(rowp + bj * HALF) = w; } }
    }
};
struct EpiSwiglu {
    static constexpr bool PERM = true;
    bf16_t* O;
    __device__ __forceinline__ void operator()(const f32x4 (&acc)[2][2][4][2], const Unit& u, int wr, int wc, int fr, int fq) const {
        const int row0 = u.pm * BM + wr * 64 + fr, col0 = u.pn * HALF + wc * 32 + 8 * fq;
#pragma unroll
        for (int ai = 0; ai < 2; ++ai)
#pragma unroll
            for (int m = 0; m < 4; ++m) { bf16_t* rowp = O + (size_t)(row0 + ai * HALF + m * 16) * FF + col0;
                float h[8];
#pragma unroll
                for (int n = 0; n < 2; ++n)
#pragma unroll
                    for (int e = 0; e < 4; ++e) { const float g = acc[ai][0][m][n][e], uu = acc[ai][1][m][n][e]; h[n * 4 + e] = g * sigmoidf_(g) * uu; }
                u32x4 w; w.x = pk2(h[0], h[1]); w.y = pk2(h[2], h[3]); w.z = pk2(h[4], h[5]); w.w = pk2(h[6], h[7]);
                *(u32x4*)rowp = w; }
    }
};
struct EpiResid {
    static constexpr bool PERM = false;
    const float* res; float* out; float scale;
    __device__ __forceinline__ void operator()(const f32x4 (&acc)[2][2][4][2], const Unit& u, int wr, int wc, int fr, int fq) const {
        const int row0 = u.pm * BM + wr * 64 + fr, col0 = u.pn * BM + wc * 32 + 4 * fq;
#pragma unroll
        for (int ai = 0; ai < 2; ++ai)
#pragma unroll
            for (int m = 0; m < 4; ++m) { const size_t off = (size_t)(row0 + ai * HALF + m * 16) * DM + col0;
#pragma unroll
                for (int bj = 0; bj < 2; ++bj)
#pragma unroll
                    for (int n = 0; n < 2; ++n) { const f32x4 r = *(const f32x4*)(res + off + bj * HALF + n * 16);
                        *(f32x4*)(out + off + bj * HALF + n * 16) = r + acc[ai][bj][m][n] * scale; } }
    }
};
struct EpiGate {
    static constexpr bool PERM = true;
    const bf16_t* proj; float* part; bf16_t* merged;
    __device__ __forceinline__ void operator()(const f32x4 (&acc)[2][2][4][2], const Unit& u, int wr, int wc, int fr, int fq) const {
        const int row0 = u.pm * BM + wr * 64 + fr, col0 = u.pn * BM + wc * 32 + 8 * fq;
        const int pz = u.pz;
#pragma unroll
        for (int ai = 0; ai < 2; ++ai)
#pragma unroll
            for (int m = 0; m < 4; ++m) { const size_t row = (size_t)(row0 + ai * HALF + m * 16);
#pragma unroll
                for (int bj = 0; bj < 2; ++bj) { const int col = col0 + bj * HALF;
                    const u32x4 gw = *(const u32x4*)(proj + row * PROJ + 2048 + 1024 * pz + col);
                    f32x4 z0, z1;
                    z0[0] = sigmoidf_(bflo(gw.x)); z0[1] = sigmoidf_(bfhi(gw.x)); z0[2] = sigmoidf_(bflo(gw.y)); z0[3] = sigmoidf_(bfhi(gw.y));
                    z1[0] = sigmoidf_(bflo(gw.z)); z1[1] = sigmoidf_(bfhi(gw.z)); z1[2] = sigmoidf_(bflo(gw.w)); z1[3] = sigmoidf_(bfhi(gw.w));
                    z0 = z0 * acc[ai][bj][m][0]; z1 = z1 * acc[ai][bj][m][1];
                    float* pp = part + row * DM + col;
                    if (pz != 0) { z0 = z0 + *(const f32x4*)pp; z1 = z1 + *(const f32x4*)(pp + 4); }
                    if (pz != 2) { *(f32x4*)pp = z0; *(f32x4*)(pp + 4) = z1; }
                    else { u32x4 w; w.x = pk2(z0[0], z0[1]); w.y = pk2(z0[2], z0[3]); w.z = pk2(z1[0], z1[1]); w.w = pk2(z1[2], z1[3]);
                        *(u32x4*)(merged + row * DM + col) = w; } } }
    }
};

template <class Epi, class Sched>
__device__ __forceinline__ void gemm_phase(LAS unsigned char* lds, const int tid, const Gemm g, const Sched& S, const Epi& E) {
    const int wid = __builtin_amdgcn_readfirstlane(tid >> 6), lane = tid & 63, wr = wid >> 2, wc = wid & 3, fr = lane & 15, fq = lane >> 4;
    const int K = g.K, nt = K / BK;
    unsigned voffA[2], voffB[2];
#pragma unroll
    for (int i = 0; i < 2; ++i) { int R, C; stage_rc(tid * 16 + i * 8192, R, C); const int Rb = Epi::PERM ? ((R & ~31) + perm32(R & 31)) : R;
        voffA[i] = (unsigned)(R * K + C) * 2u; voffB[i] = (unsigned)(Rb * K + C) * 2u; }
    const size_t kstep = (size_t)(BK * 2);
    const size_t hstep = (size_t)HALF * K * 2;
    const size_t tstep = 2 * hstep;
    const unsigned ldsw = (unsigned)wid * 1024u;
    const int aoff = lds_byte(wr * 64 + fr, fq * 8), boff = lds_byte(wc * 32 + fr, fq * 8);
#define PG8_SA(b, h) (((b) * 2 + (h)) * HTB)
#define PG8_SB(b, h) ((4 + (b) * 2 + (h)) * HTB)
#define PG8_STAGE(bufoff, gbase, voff) do { _Pragma("unroll") for (int _i = 0; _i < 2; ++_i) \
        __builtin_amdgcn_global_load_lds((const unsigned*)((const char*)(gbase) + (voff)[_i]), (LAS unsigned*)(lds + (bufoff) + ldsw + _i * 8192), 16, 0, 0); } while (0)
#define PG8_LDA(dst, b, h) do { _Pragma("unroll") for (int m = 0; m < 4; ++m) _Pragma("unroll") for (int k = 0; k < 2; ++k) dst[m][k] = *(const LAS bf16x8*)(lds + PG8_SA(b, h) + aoff + m * 2048 + k * 1024); } while (0)
#define PG8_LDB(dst, b, h) do { _Pragma("unroll") for (int n = 0; n < 2; ++n) _Pragma("unroll") for (int k = 0; k < 2; ++k) dst[n][k] = *(const LAS bf16x8*)(lds + PG8_SB(b, h) + boff + n * 2048 + k * 1024); } while (0)
#define PG8_MMA(ai, bj, At, Bt) do { __builtin_amdgcn_s_setprio(1); _Pragma("unroll") for (int m = 0; m < 4; ++m) _Pragma("unroll") for (int n = 0; n < 2; ++n) _Pragma("unroll") for (int k = 0; k < 2; ++k) \
        acc[ai][bj][m][n] = __builtin_amdgcn_mfma_f32_16x16x32_bf16(Bt[n][k], At[m][k], acc[ai][bj][m][n], 0, 0, 0); __builtin_amdgcn_s_setprio(0); } while (0)
#define PG8_WAIT_V(n) asm volatile("s_waitcnt vmcnt(" #n ")" ::: "memory")
#define PG8_WAIT_L(n) asm volatile("s_waitcnt lgkmcnt(" #n ")" ::: "memory")
#define PG8_BAR __builtin_amdgcn_s_barrier()
#define PG8_SCHED __builtin_amdgcn_sched_barrier(0)
    Unit cur, nxt; int ui = 0;
    if (!S.next(0, cur)) return;
    f32x4 acc[2][2][4][2];
#pragma unroll
    for (int a = 0; a < 2; ++a)
#pragma unroll
        for (int b = 0; b < 2; ++b)
#pragma unroll
            for (int m = 0; m < 4; ++m)
#pragma unroll
                for (int n = 0; n < 2; ++n) acc[a][b][m][n] = (f32x4){0.f, 0.f, 0.f, 0.f};
    bf16x8 At[4][2], B0[2][2], B1[2][2];
    const char* cA = (const char*)g.A + (size_t)cur.pm * tstep + (size_t)cur.pz * g.zA; const char* cB = (const char*)g.Bt + (size_t)cur.pn * tstep + (size_t)cur.pz * g.zB;
    PG8_STAGE(PG8_SB(0, 0), cB, voffB); PG8_STAGE(PG8_SB(0, 1), cB + hstep, voffB); PG8_STAGE(PG8_SA(0, 0), cA, voffA); PG8_STAGE(PG8_SA(0, 1), cA + hstep, voffA);
    if (wr == 1) PG8_BAR;
    PG8_WAIT_V(2); PG8_BAR;
    PG8_STAGE(PG8_SB(1, 0), cB + kstep, voffB); PG8_STAGE(PG8_SA(1, 0), cA + kstep, voffA); PG8_STAGE(PG8_SB(1, 1), cB + hstep + kstep, voffB);
    PG8_WAIT_V(6); PG8_BAR;
    for (;;) {
        const bool has_next = S.next(ui + 1, nxt);
        const char* nA = has_next ? (const char*)g.A + (size_t)nxt.pm * tstep + (size_t)nxt.pz * g.zA : cA;
        const char* nB = has_next ? (const char*)g.Bt + (size_t)nxt.pn * tstep + (size_t)nxt.pz * g.zB : cB;
        for (int t = 0; t < nt; t += 2) {
            const bool last = (t == nt - 2);
            const char* a1 = cA + (size_t)(t + 1) * kstep;
            const char* a2 = last ? nA : cA + (size_t)(t + 2) * kstep; const char* b2 = last ? nB : cB + (size_t)(t + 2) * kstep;
            const char* a3 = a2 + kstep; const char* b3 = b2 + kstep;
            PG8_LDB(B0, 0, 0); PG8_LDB(B1, 0, 1); PG8_SCHED; PG8_LDA(At, 0, 0); PG8_STAGE(PG8_SA(1, 1), a1 + hstep, voffA);
            PG8_WAIT_V(8); PG8_WAIT_L(0); PG8_BAR; PG8_MMA(0, 0, At, B0); PG8_MMA(0, 1, At, B1); PG8_BAR; PG8_SCHED;
            PG8_LDA(At, 0, 1); PG8_STAGE(PG8_SB(0, 0), b2, voffB); PG8_STAGE(PG8_SB(0, 1), b2 + hstep, voffB); PG8_STAGE(PG8_SA(0, 0), a2, voffA);
            PG8_WAIT_V(8); PG8_WAIT_L(0); PG8_BAR; PG8_MMA(1, 0, At, B0); PG8_MMA(1, 1, At, B1); PG8_BAR; PG8_SCHED;
            PG8_LDB(B0, 1, 0); PG8_LDB(B1, 1, 1); PG8_SCHED; PG8_LDA(At, 1, 0); PG8_STAGE(PG8_SA(0, 1), a2 + hstep, voffA);
            PG8_WAIT_V(8); PG8_WAIT_L(0); PG8_BAR; PG8_MMA(0, 0, At, B0); PG8_MMA(0, 1, At, B1); PG8_BAR; PG8_SCHED;
            PG8_LDA(At, 1, 1); PG8_STAGE(PG8_SB(1, 0), b3, voffB); PG8_STAGE(PG8_SB(1, 1), b3 + hstep, voffB); PG8_STAGE(PG8_SA(1, 0), a3, voffA);
            PG8_WAIT_V(8); PG8_WAIT_L(0); PG8_BAR; PG8_MMA(1, 0, At, B0); PG8_MMA(1, 1, At, B1); PG8_BAR; PG8_SCHED;
        }
        if (wr == 0) PG8_BAR;
        E(acc, cur, wr, wc, fr, fq);
        if (!has_next) break;
#pragma unroll
        for (int a = 0; a < 2; ++a)
#pragma unroll
            for (int b = 0; b < 2; ++b)
#pragma unroll
                for (int m = 0; m < 4; ++m)
#pragma unroll
                    for (int n = 0; n < 2; ++n) acc[a][b][m][n] = (f32x4){0.f, 0.f, 0.f, 0.f};
        cur = nxt; cA = nA; cB = nB; ++ui;
        if (wr == 1) PG8_BAR;
    }
    PG8_WAIT_V(0);
    PG8_BAR;
#undef PG8_SA
#undef PG8_SB
#undef PG8_STAGE
#undef PG8_LDA
#undef PG8_LDB
#undef PG8_MMA
#undef PG8_WAIT_V
#undef PG8_WAIT_L
#undef PG8_BAR
#undef PG8_SCHED
}
}

constexpr int ATT_BIAS_OFF = 73728;
template <int HD, int MODE>
__device__ __forceinline__ void attn_unit(LAS unsigned char* lds, const int tid, const bf16_t* Qg, int q_pitch, const bf16_t* Kg, int k_pitch,
                                          const bf16_t* Vtg, int vt_pitch, bf16_t* Og, int o_pitch, int t0, int t1, float c,
                                          int q0, const float* biasg, float m_init, float l_init) {
    constexpr int KROW = HD * 2 + 16, VROW = 144, KBYTES = 64 * KROW, VBYTES = HD * VROW, BUF = KBYTES + VBYTES, NP = HD / 64;
    static_assert(2 * BUF <= ATT_BIAS_OFF, "attention LDS");
    const int lane = tid & 63, wid = __builtin_amdgcn_readfirstlane(tid >> 6), r32 = lane & 31, hi = lane >> 5;
    bf16x8 qf[HD / 16];
    { const bf16_t* qrow = Qg + (size_t)(wid * 32 + r32) * q_pitch + hi * 8;
#pragma unroll
      for (int d0 = 0; d0 < HD / 16; ++d0) qf[d0] = *(const bf16x8*)(qrow + d0 * 16); }
    u32x4 kst[NP], vst[NP];
    const bf16_t* kg[NP]; const bf16_t* vg[NP]; unsigned kl[NP], vl[NP];
#pragma unroll
    for (int p = 0; p < NP; ++p) { const int idx = tid + 512 * p; const int krow = idx / (HD / 8), kch = idx % (HD / 8), vd = idx >> 3, vch = idx & 7;
        kg[p] = Kg + (size_t)krow * k_pitch + kch * 8; vg[p] = Vtg + (size_t)vd * vt_pitch + vch * 8;
        kl[p] = krow * KROW + kch * 16; vl[p] = KBYTES + vd * VROW + vch * 16; }
#define ATT_LOAD(t) do { _Pragma("unroll") for (int p = 0; p < NP; ++p) { kst[p] = *(const u32x4*)(kg[p] + (size_t)(t) * 64 * k_pitch); vst[p] = *(const u32x4*)(vg[p] + (t) * 64); } } while (0)
#define ATT_STORE(b) do { _Pragma("unroll") for (int p = 0; p < NP; ++p) { *(LAS u32x4*)(lds + (b) * BUF + kl[p]) = kst[p]; *(LAS u32x4*)(lds + (b) * BUF + vl[p]) = vst[p]; } } while (0)
    const int pr = (r32 & 0x13) | ((r32 & 4) << 1) | ((r32 & 8) >> 1);
    const unsigned krd = pr * KROW + hi * 16, vrd = KBYTES + r32 * VROW + hi * 16;
    f32x16 o[HD / 32];
#pragma unroll
    for (int d0 = 0; d0 < HD / 32; ++d0)
#pragma unroll
        for (int r = 0; r < 16; ++r) o[d0][r] = 0.f;
    float m_run = m_init, l_run = l_init;
    const LAS float* biasl = (const LAS float*)(lds + ATT_BIAS_OFF);
    __syncthreads();
    ATT_LOAD(t0); ATT_STORE(0);
    if (MODE == 1) { if (tid < 257) ((LAS float*)(lds + ATT_BIAS_OFF))[tid] = biasg[tid]; }
    int cur = 0;
    const int qlo = q0 + wid * 32;
    for (int t = t0; t < t1; ++t) {
        __syncthreads();
        const bool more = (t + 1 < t1);
        if (more) ATT_LOAD(t + 1);
        bool active = true;
        if (MODE == 1) active = !(64 * t + 63 < qlo - 128 || 64 * t > qlo + 31 + 128);
        if (active) {
            const LAS unsigned char* kb = lds + cur * BUF + krd;
            const LAS unsigned char* vb = lds + cur * BUF + vrd;
            f32x16 s0, s1;
#pragma unroll
            for (int r = 0; r < 16; ++r) { s0[r] = 0.f; s1[r] = 0.f; }
#pragma unroll
            for (int d0 = 0; d0 < HD / 16; ++d0) {
                const bf16x8 k0 = *(const LAS bf16x8*)(kb + d0 * 32);
                const bf16x8 k1 = *(const LAS bf16x8*)(kb + 32 * KROW + d0 * 32);
                s0 = __builtin_amdgcn_mfma_f32_32x32x16_bf16(k0, qf[d0], s0, 0, 0, 0);
                s1 = __builtin_amdgcn_mfma_f32_32x32x16_bf16(k1, qf[d0], s1, 0, 0, 0);
            }
            if (MODE == 0) {
#pragma unroll
                for (int r = 0; r < 16; ++r) { s0[r] *= c; s1[r] *= c; }
            } else {
                const int qpos = qlo + r32, kbase = 64 * t + 8 * hi;
#pragma unroll
                for (int r = 0; r < 16; ++r) {
                    const int rel0 = kbase + 16 * (r >> 3) + (r & 7) - qpos, rel1 = rel0 + 32;
                    const int i0 = min(max(rel0 + 128, 0), 256), i1 = min(max(rel1 + 128, 0), 256);
                    const float b0 = biasl[i0], b1 = biasl[i1];
                    s0[r] = (rel0 >= -128 && rel0 <= 128) ? fmaf(s0[r], c, b0) : -1e30f;
                    s1[r] = (rel1 >= -128 && rel1 <= 128) ? fmaf(s1[r], c, b1) : -1e30f;
                }
            }
            float mx = fmaxf(s0[0], s1[0]);
#pragma unroll
            for (int r = 1; r < 16; ++r) mx = fmaxf(mx, fmaxf(s0[r], s1[r]));
            mx = fmaxf(mx, __shfl_xor(mx, 32));
            const float m_new = fmaxf(m_run, mx);
            const float alpha = __builtin_amdgcn_exp2f(m_run - m_new);
            m_run = m_new;
            float rs = 0.f;
#pragma unroll
            for (int r = 0; r < 16; ++r) { s0[r] = __builtin_amdgcn_exp2f(s0[r] - m_new); s1[r] = __builtin_amdgcn_exp2f(s1[r] - m_new); rs += s0[r] + s1[r]; }
            l_run = l_run * alpha + rs;
#pragma unroll
            for (int d0 = 0; d0 < HD / 32; ++d0)
#pragma unroll
                for (int r = 0; r < 16; ++r) o[d0][r] *= alpha;
            bf16x8 pf[4];
            { u32x4 w;
              w.x = pk2(s0[0], s0[1]); w.y = pk2(s0[2], s0[3]); w.z = pk2(s0[4], s0[5]); w.w = pk2(s0[6], s0[7]); pf[0] = __builtin_bit_cast(bf16x8, w);
              w.x = pk2(s0[8], s0[9]); w.y = pk2(s0[10], s0[11]); w.z = pk2(s0[12], s0[13]); w.w = pk2(s0[14], s0[15]); pf[1] = __builtin_bit_cast(bf16x8, w);
              w.x = pk2(s1[0], s1[1]); w.y = pk2(s1[2], s1[3]); w.z = pk2(s1[4], s1[5]); w.w = pk2(s1[6], s1[7]); pf[2] = __builtin_bit_cast(bf16x8, w);
              w.x = pk2(s1[8], s1[9]); w.y = pk2(s1[10], s1[11]); w.z = pk2(s1[12], s1[13]); w.w = pk2(s1[14], s1[15]); pf[3] = __builtin_bit_cast(bf16x8, w); }
#pragma unroll
            for (int d0 = 0; d0 < HD / 32; ++d0)
#pragma unroll
                for (int kk = 0; kk < 4; ++kk) {
                    const bf16x8 vf = *(const LAS bf16x8*)(vb + d0 * 32 * VROW + kk * 32);
                    o[d0] = __builtin_amdgcn_mfma_f32_32x32x16_bf16(vf, pf[kk], o[d0], 0, 0, 0);
                }
        }
        if (more) ATT_STORE(cur ^ 1);
        cur ^= 1;
    }
    const float l_tot = l_run + __shfl_xor(l_run, 32);
    const float inv = 1.0f / l_tot;
    bf16_t* orow = Og + (size_t)(wid * 32 + r32) * o_pitch + 4 * hi;
#pragma unroll
    for (int d0 = 0; d0 < HD / 32; ++d0)
#pragma unroll
        for (int rq = 0; rq < 4; ++rq) { u32x2 w; w.x = pk2(o[d0][4 * rq] * inv, o[d0][4 * rq + 1] * inv); w.y = pk2(o[d0][4 * rq + 2] * inv, o[d0][4 * rq + 3] * inv);
            *(u32x2*)(orow + 32 * d0 + 8 * rq) = w; }
#undef ATT_LOAD
#undef ATT_STORE
}

__device__ __forceinline__ void rms_row_bf16(const float* src, const float* gain, bf16_t* dst, int lane) {
    const f32x4* xr = (const f32x4*)src + lane; const f32x4* gr = (const f32x4*)gain + lane;
    f32x4 v[4]; float s = 0.f;
#pragma unroll
    for (int j = 0; j < 4; ++j) { v[j] = xr[64 * j]; s += (v[j].x * v[j].x + v[j].y * v[j].y) + (v[j].z * v[j].z + v[j].w * v[j].w); }
    const float rstd = 1.0f / sqrtf(wave_sum(s) * (1.0f / DM) + EPS);
    u32x2* o8 = (u32x2*)dst + lane;
#pragma unroll
    for (int j = 0; j < 4; ++j) { const f32x4 g = gr[64 * j]; u32x2 w; w.x = pk2(v[j].x * rstd * g.x, v[j].y * rstd * g.y); w.y = pk2(v[j].z * rstd * g.z, v[j].w * rstd * g.w); o8[64 * j] = w; }
}
__device__ __forceinline__ void rms_row_f32_inplace(float* p, const float* gain, int lane) {
    f32x4* xr = (f32x4*)p + lane; const f32x4* gr = (const f32x4*)gain + lane;
    f32x4 v[4]; float s = 0.f;
#pragma unroll
    for (int j = 0; j < 4; ++j) { v[j] = xr[64 * j]; s += (v[j].x * v[j].x + v[j].y * v[j].y) + (v[j].z * v[j].z + v[j].w * v[j].w); }
    const float rstd = 1.0f / sqrtf(wave_sum(s) * (1.0f / DM) + EPS);
#pragma unroll
    for (int j = 0; j < 4; ++j) { const f32x4 g = gr[64 * j]; xr[64 * j] = v[j] * rstd * g; }
}
__device__ __forceinline__ void transpose_item(const float* W, int K, int N, bf16_t* WT, int mode, LAS float* scr, int item, int lane) {
    const int nblk = N / 32, kb = item / nblk, nb = item % nblk, k0 = 64 * kb, n0 = 32 * nb;
#pragma unroll 8
    for (int i = 0; i < 32; ++i) { const int kk = 2 * i + (lane >> 5); scr[kk * 33 + (lane & 31)] = W[(size_t)(k0 + kk) * N + n0 + (lane & 31)]; }
    asm volatile("s_waitcnt lgkmcnt(0)" ::: "memory");
    int r0 = n0;
    if (mode == 1) { const int half = n0 >= FF ? 1 : 0, np = n0 - FF * half; r0 = 256 * (np / 128) + 128 * half + (np % 128); }
    const int c = lane & 7;
#pragma unroll
    for (int j = 0; j < 4; ++j) { const int n = (lane >> 3) + 8 * j; const LAS float* s = scr + (8 * c) * 33 + n;
        u32x4 o; o.x = pk2(s[0 * 33], s[1 * 33]); o.y = pk2(s[2 * 33], s[3 * 33]); o.z = pk2(s[4 * 33], s[5 * 33]); o.w = pk2(s[6 * 33], s[7 * 33]);
        *(u32x4*)(WT + (size_t)(r0 + n) * K + k0 + 8 * c) = o; }
    asm volatile("s_waitcnt lgkmcnt(0)" ::: "memory");
}
__device__ __forceinline__ void transpose64_bf16(const bf16_t* src, size_t src_pitch, bf16_t* dst, size_t dst_pitch, LAS unsigned short* scr, int lane) {
#pragma unroll
    for (int p = 0; p < 8; ++p) { const int row = 8 * p + (lane >> 3), ch = lane & 7; const u32x4 v = *(const u32x4*)(src + (size_t)row * src_pitch + 8 * ch);
        LAS unsigned short* d = scr + row * 66 + 8 * ch;
        d[0] = (unsigned short)v.x; d[1] = (unsigned short)(v.x >> 16); d[2] = (unsigned short)v.y; d[3] = (unsigned short)(v.y >> 16);
        d[4] = (unsigned short)v.z; d[5] = (unsigned short)(v.z >> 16); d[6] = (unsigned short)v.w; d[7] = (unsigned short)(v.w >> 16); }
    asm volatile("s_waitcnt lgkmcnt(0)" ::: "memory");
#pragma unroll
    for (int p = 0; p < 8; ++p) { const int j = 8 * p + (lane >> 3), i0 = 8 * (lane & 7); const LAS unsigned short* s = scr + i0 * 66 + j;
        u32x4 o; o.x = (unsigned)s[0] | ((unsigned)s[66] << 16); o.y = (unsigned)s[2 * 66] | ((unsigned)s[3 * 66] << 16);
        o.z = (unsigned)s[4 * 66] | ((unsigned)s[5 * 66] << 16); o.w = (unsigned)s[6 * 66] | ((unsigned)s[7 * 66] << 16);
        *(u32x4*)(dst + (size_t)j * dst_pitch + i0) = o; }
    asm volatile("s_waitcnt lgkmcnt(0)" ::: "memory");
}
__device__ __forceinline__ void sincos_d(double a, float& sn, float& cs) {
    const double k = rint(a * 0.63661977236758134308);
    const double r = (a - k * 1.57079632679489655800) - k * 6.123233995736766036e-17;
    const double r2 = r * r;
    const double s = r * (1.0 + r2 * (-1.0 / 6 + r2 * (1.0 / 120 + r2 * (-1.0 / 5040 + r2 * (1.0 / 362880 + r2 * (-1.0 / 39916800 + r2 * (1.0 / 6227020800.0)))))));
    const double c = 1.0 + r2 * (-0.5 + r2 * (1.0 / 24 + r2 * (-1.0 / 720 + r2 * (1.0 / 40320 + r2 * (-1.0 / 3628800 + r2 * (1.0 / 479001600.0 + r2 * (-1.0 / 87178291200.0)))))));
    const int q = ((int)k) & 3;
    const double ss = (q == 0) ? s : (q == 1) ? c : (q == 2) ? -s : -c;
    const double cc = (q == 0) ? c : (q == 1) ? -s : (q == 2) ? -c : s;
    sn = (float)ss; cs = (float)cc;
}

struct Args { const float* in[23]; float* out; unsigned char* ws; int ph_lo, ph_hi; };
enum { I_XP = 0, I_XS, I_MP, I_MS, I_RELB, I_NFF1, I_FF1I, I_FF1O, I_NMIX, I_WIN, I_QN, I_KN, I_SINK, I_NMEM, I_WMEM, I_BRA, I_BRB, I_BRC, I_WOUT, I_NFF2, I_FF2I, I_FF2O, I_NFIN };
constexpr int N_PRO = 3, N_PER = 13, N_STEPS = N_PRO + N_PER * NCH;

constexpr int LDS_PTRS = 133120;
__device__ __forceinline__ const float* ldsptr(LAS unsigned char* lds, int i) {
    const unsigned long long v = ((const LAS unsigned long long*)(lds + LDS_PTRS))[i];
    const unsigned lo = __builtin_amdgcn_readfirstlane((unsigned)v), hi = __builtin_amdgcn_readfirstlane((unsigned)(v >> 32));
    return (const float*)(((unsigned long long)hi << 32) | lo);
}
#define INP(i) ldsptr(lds, (i))
__global__ void __launch_bounds__(512, 2) mega_fwd(Args a) {
    extern __shared__ __attribute__((aligned(16))) unsigned char lds_raw[];
    LAS unsigned char* lds = (LAS unsigned char*)lds_raw;
    cg::grid_group grid = cg::this_grid();
    if (threadIdx.x < 23) ((LAS unsigned long long*)(lds + LDS_PTRS))[threadIdx.x] = (unsigned long long)a.in[threadIdx.x];
    if (threadIdx.x == 23) ((LAS unsigned long long*)(lds + LDS_PTRS))[23] = (unsigned long long)a.out;
    if (threadIdx.x == 24) ((LAS unsigned long long*)(lds + LDS_PTRS))[24] = (unsigned long long)a.ws;
    __syncthreads();
    const int ph_lo = a.ph_lo, ph_hi = a.ph_hi;
    for (int step = ph_lo; step < ph_hi; ++step) {
        int tid = threadIdx.x; asm volatile("" : "+v"(tid));
        const int lane = tid & 63, wave = __builtin_amdgcn_readfirstlane(tid >> 6);
        const int G = gridDim.x, bx = blockIdx.x;
        const int vcu = (G % 8 == 0) ? (bx % 8) * (G / 8) + bx / 8 : bx;
        const int gw = vcu * 8 + wave, NGW = G * 8;
        unsigned char* ws = (unsigned char*)INP(24);
        float* const outp = (float*)INP(23);
        bf16_t* const W_ff1i = (bf16_t*)(ws + WS_WFF1I); bf16_t* const W_ff1o = (bf16_t*)(ws + WS_WFF1O); bf16_t* const W_in = (bf16_t*)(ws + WS_WIN);
        bf16_t* const W_mem = (bf16_t*)(ws + WS_WMEM); bf16_t* const W_br = (bf16_t*)(ws + WS_WBR); bf16_t* const W_out = (bf16_t*)(ws + WS_WOUT);
        bf16_t* const W_ff2i = (bf16_t*)(ws + WS_WFF2I); bf16_t* const W_ff2o = (bf16_t*)(ws + WS_WFF2O);
        bf16_t* const memn = (bf16_t*)(ws + WS_MEMN); bf16_t* const kvm = (bf16_t*)(ws + WS_KVM); bf16_t* const vtc = (bf16_t*)(ws + WS_VTC);
        f32x2* const rope = (f32x2*)(ws + WS_ROPE); float* const biast = (float*)(ws + WS_BIAS);
        bf16_t* const xn = (bf16_t*)(ws + WS_XN); bf16_t* const hid = (bf16_t*)(ws + WS_HID); bf16_t* const proj = (bf16_t*)(ws + WS_PROJ);
        bf16_t* const vta = (bf16_t*)(ws + WS_VTA); bf16_t* const vtb = (bf16_t*)(ws + WS_VTB); bf16_t* const yb3 = (bf16_t*)(ws + WS_Y);
        float* const part = (float*)(ws + WS_PART);
        if (PH_EN(0) && step == 0) {
            LAS float* scr = (LAS float*)(lds + wave * 16384);
            constexpr int I_FI = (DM / 64) * (2 * FF / 32), I_FO = (FF / 64) * (DM / 32), I_IN = (DM / 64) * (PROJ / 32), I_SQ = (DM / 64) * (DM / 32), I_BR = (512 / 64) * (DM / 32);
            constexpr int NITEMS = 2 * I_FI + 2 * I_FO + I_IN + 2 * I_SQ + 3 * I_BR;
            for (int it = gw; it < NITEMS; it += NGW) {
                int r = it;
                if (r < I_FI) { transpose_item(INP(I_FF1I), DM, 2 * FF, W_ff1i, 1, scr, r, lane); continue; } r -= I_FI;
                if (r < I_FI) { transpose_item(INP(I_FF2I), DM, 2 * FF, W_ff2i, 1, scr, r, lane); continue; } r -= I_FI;
                if (r < I_FO) { transpose_item(INP(I_FF1O), FF, DM, W_ff1o, 0, scr, r, lane); continue; } r -= I_FO;
                if (r < I_FO) { transpose_item(INP(I_FF2O), FF, DM, W_ff2o, 0, scr, r, lane); continue; } r -= I_FO;
                if (r < I_IN) { transpose_item(INP(I_WIN), DM, PROJ, W_in, 0, scr, r, lane); continue; } r -= I_IN;
                if (r < I_SQ) { transpose_item(INP(I_WMEM), DM, DM, W_mem, 0, scr, r, lane); continue; } r -= I_SQ;
                if (r < I_SQ) { transpose_item(INP(I_WOUT), DM, DM, W_out, 0, scr, r, lane); continue; } r -= I_SQ;
                if (r < I_BR) { transpose_item(INP(I_BRA), 512, DM, W_br, 0, scr, r, lane); continue; } r -= I_BR;
                if (r < I_BR) { transpose_item(INP(I_BRB), 512, DM, W_br + (size_t)DM * 512, 0, scr, r, lane); continue; } r -= I_BR;
                transpose_item(INP(I_BRC), 512, DM, W_br + (size_t)2 * DM * 512, 0, scr, r, lane);
            }
            const float* mp_p = INP(I_MP); const float* ms_p = INP(I_MS); const float* nmem_p = INP(I_NMEM);
            for (int m = gw; m < NMEM; m += NGW) {
                const float* src = (m < 2048) ? mp_p + (size_t)m * DM : ms_p + (size_t)(m - 2048) * DM;
                rms_row_bf16(src, nmem_p, memn + (size_t)m * DM, lane);
            }
            for (int i = vcu * 512 + tid; i < 2048; i += G * 512) {
                const int n = i >> 4, j = i & 15;
                const int jl = j & 3, jh = j >> 2;
                const float b = (jl == 0) ? 1.0f : (jl == 1) ? 0.5623413251903491f : (jl == 2) ? 0.31622776601683794f : 0.1778279410038923f;
                const float s = (jh == 0) ? 1.0f : (jh == 1) ? 0.1f : (jh == 2) ? 0.01f : 0.001f;
                const float inv = b * s;
                const float ang = (float)n * inv;
                float sn, cs; sincos_d((double)ang, sn, cs);
                rope[i] = (f32x2){cs, sn};
            }
            const float* relb_p = INP(I_RELB);
            for (int i = vcu * 512 + tid; i < 8 * 257; i += G * 512) {
                const int h = i / 257, rel = (i % 257) - 128;
                const int n = rel < 0 ? -rel : rel;
                int large = 33 - __clz(n * n > 0 ? n * n : 1); if (large > 15) large = 15;
                const int bucket = (rel > 0 ? 16 : 0) + (n < 8 ? n : large);
                biast[i] = relb_p[bucket * 8 + h] * LOG2E;
            }
        } else if (PH_EN(1) && step == 1) {
            pg8::Gemm g{memn, W_mem, NMEM, DM, DM, 0, 0}; pg8::StaticOrder S; S.init(NMEM, DM, G, bx);
            pg8::EpiPlain E{kvm, DM};
            pg8::gemm_phase(lds, tid, g, S, E);
        } else if (PH_EN(2) && step == 2) {
            LAS unsigned short* scr = (LAS unsigned short*)(lds + wave * 16384);
            for (int it = gw; it < 40 * 4 * 4 * 2; it += NGW) {
                const int db = it & 1, h = (it >> 1) & 3, mb = (it >> 3) & 3, seq = it >> 5;
                transpose64_bf16(kvm + (size_t)(seq * 256 + 64 * mb) * DM + 512 + 128 * h + 64 * db, DM,
                                 vtc + ((size_t)(seq * 4 + h) * 128 + 64 * db) * 256 + 64 * mb, 256, scr, lane);
            }
        } else {
            const int c = (step - N_PRO) / N_PER, k = (step - N_PRO) % N_PER;
            const bool prompt = c < 4;
            const float* xin = prompt ? INP(I_XP) + (size_t)c * CH * DM : INP(I_XS) + (size_t)(c - 4) * CH * DM;
            float* hout = outp + (size_t)c * CH * DM;
            const int S_ = prompt ? 8192 : 2048, nseq = CH / S_, NQB = S_ / 256;
            const int memseq0 = prompt ? 2 * c : 8 + 8 * (c - 4);
            if (PH_EN(3) && (k == 0 || k == 3 || k == 9)) {
                const float* src = (k == 0) ? xin : hout;
                const float* gain = (k == 0) ? INP(I_NFF1) : (k == 3) ? INP(I_NMIX) : INP(I_NFF2);
                for (int m = gw; m < CH; m += NGW) rms_row_bf16(src + (size_t)m * DM, gain, xn + (size_t)m * DM, lane);
            } else if (PH_EN(4) && (k == 1 || k == 10)) {
                pg8::Gemm g{xn, (k == 1) ? W_ff1i : W_ff2i, CH, 2 * FF, DM, 0, 0}; pg8::StaticOrder S; S.init(CH, 2 * FF, G, bx);
                pg8::EpiSwiglu E{hid};
                pg8::gemm_phase(lds, tid, g, S, E);
            } else if (PH_EN(5) && (k == 2 || k == 11)) {
                pg8::Gemm g{hid, (k == 2) ? W_ff1o : W_ff2o, CH, DM, FF, 0, 0}; pg8::StaticOrder S; S.init(CH, DM, G, bx);
                pg8::EpiResid E{(k == 2) ? xin : hout, hout, 0.5f};
                pg8::gemm_phase(lds, tid, g, S, E);
            } else if (PH_EN(6) && k == 4) {
                pg8::Gemm g{xn, W_in, CH, PROJ, DM, 0, 0}; pg8::StaticOrder S; S.init(CH, PROJ, G, bx);
                pg8::EpiPlain E{proj, PROJ};
                pg8::gemm_phase(lds, tid, g, S, E);
            } else if (PH_EN(7) && k == 5) {
                const float* qn_p = INP(I_QN); const float* kn_p = INP(I_KN);
                for (int wi = gw; wi < CH * 10 / 8; wi += NGW) {
                    const int item = wi * 8 + (lane >> 3), sub = lane & 7;
                    const int tok = item / 10, hh = item % 10;
                    bf16_t* p = proj + (size_t)tok * PROJ + 64 * hh + 8 * sub;
                    const u32x4 v = *(const u32x4*)p;
                    float x[8] = {bflo(v.x), bfhi(v.x), bflo(v.y), bfhi(v.y), bflo(v.z), bfhi(v.z), bflo(v.w), bfhi(v.w)};
                    float ss = 0.f;
#pragma unroll
                    for (int e = 0; e < 8; ++e) ss += x[e] * x[e];
                    ss += __shfl_xor(ss, 1); ss += __shfl_xor(ss, 2); ss += __shfl_xor(ss, 4);
                    const float rstd = 1.0f / sqrtf(ss * (1.0f / 64) + EPS);
                    const float* gn = ((hh < 8) ? qn_p : kn_p) + 8 * sub;
                    const f32x4 g0 = *(const f32x4*)gn, g1 = *(const f32x4*)(gn + 4);
                    x[0] *= rstd * g0.x; x[1] *= rstd * g0.y; x[2] *= rstd * g0.z; x[3] *= rstd * g0.w;
                    x[4] *= rstd * g1.x; x[5] *= rstd * g1.y; x[6] *= rstd * g1.z; x[7] *= rstd * g1.w;
                    const int pos = tok % S_;
                    const int nidx = (sub < 4) ? (pos >> 6) : (pos & 63);
                    const f32x4* rt = (const f32x4*)(rope + nidx * 16 + 4 * (sub & 3));
                    const f32x4 c01 = rt[0], c23 = rt[1];
                    float y[8];
                    y[0] = x[0] * c01.x - x[1] * c01.y; y[1] = x[0] * c01.y + x[1] * c01.x;
                    y[2] = x[2] * c01.z - x[3] * c01.w; y[3] = x[2] * c01.w + x[3] * c01.z;
                    y[4] = x[4] * c23.x - x[5] * c23.y; y[5] = x[4] * c23.y + x[5] * c23.x;
                    y[6] = x[6] * c23.z - x[7] * c23.w; y[7] = x[6] * c23.w + x[7] * c23.z;
                    u32x4 w; w.x = pk2(y[0], y[1]); w.y = pk2(y[2], y[3]); w.z = pk2(y[4], y[5]); w.w = pk2(y[6], y[7]);
                    *(u32x4*)p = w;
                }
                LAS unsigned short* scr = (LAS unsigned short*)(lds + wave * 16384);
                for (int it = gw; it < (CH / 64) * 4; it += NGW) {
                    const int kvh = it & 1, which = (it >> 1) & 1, tt = it >> 2;
                    const int tok = 64 * tt, seq = tok / S_, pos = tok % S_;
                    transpose64_bf16(proj + (size_t)tok * PROJ + (which ? 1408 : 640) + 64 * kvh, PROJ,
                                     (which ? vtb : vta) + ((size_t)(seq * 2 + kvh) * 64) * S_ + pos, S_, scr, lane);
                }
            } else if (PH_EN(8) && k == 6) {
                for (int u = vcu; u < 512; u += G) {
                    const int qb = u % NQB, g4 = (u / NQB) % 4, kvh = (u / NQB / 4) % 2, seq = u / (NQB * 8), head = kvh * 4 + g4;
                    const size_t tokq = (size_t)seq * S_ + (size_t)qb * 256;
                    attn_unit<64, 0>(lds, tid, proj + tokq * PROJ + 64 * head, PROJ, proj + (size_t)seq * S_ * PROJ + 512 + 64 * kvh, PROJ,
                                     vta + ((size_t)(seq * 2 + kvh) * 64) * S_, S_, yb3 + tokq * 512 + 64 * head, 512, 0, S_ / 64,
                                     0.125f * LOG2E, 0, nullptr, -1e30f, 0.f);
                }
                for (int u = vcu; u < 512; u += G) {
                    const int qb = u % NQB, g4 = (u / NQB) % 4, kvh = (u / NQB / 4) % 2, seq = u / (NQB * 8), head = kvh * 4 + g4;
                    const size_t tokq = (size_t)seq * S_ + (size_t)qb * 256;
                    const int q0 = qb * 256;
                    const int t0 = (q0 >= 128) ? (q0 - 128) / 64 : 0, t1 = min(S_, q0 + 384) / 64;
                    attn_unit<64, 1>(lds, tid, proj + tokq * PROJ + 768 + 64 * head, PROJ, proj + (size_t)seq * S_ * PROJ + 1280 + 64 * kvh, PROJ,
                                     vtb + ((size_t)(seq * 2 + kvh) * 64) * S_, S_, yb3 + (size_t)CH * 512 + tokq * 512 + 64 * head, 512, t0, t1,
                                     0.125f * LOG2E, q0, biast + head * 257, INP(I_SINK)[head] * LOG2E, 1.0f);
                }
                for (int u = vcu; u < 256; u += G) {
                    const int qb = u % NQB, h = (u / NQB) % 4, seq = u / (NQB * 4);
                    const size_t tokq = (size_t)seq * S_ + (size_t)qb * 256;
                    const int ms = memseq0 + seq;
                    attn_unit<128, 0>(lds, tid, proj + tokq * PROJ + 1536 + 128 * h, PROJ, kvm + (size_t)ms * 256 * DM + 128 * h, DM,
                                      vtc + ((size_t)(ms * 4 + h) * 128) * 256, 256, yb3 + (size_t)2 * CH * 512 + tokq * 512 + 128 * h, 512, 0, 4,
                                      0.08838834764831845f * LOG2E, 0, nullptr, -1e30f, 0.f);
                }
                __syncthreads();
            } else if (PH_EN(9) && k == 7) {
                pg8::Gemm g{yb3, W_br, CH, DM, 512, (size_t)CH * 512 * 2, (size_t)DM * 512 * 2}; pg8::BranchOrder S; S.b.init(CH, DM, G, bx);
                pg8::EpiGate E{proj, part, xn};
                pg8::gemm_phase(lds, tid, g, S, E);
            } else if (PH_EN(10) && k == 8) {
                pg8::Gemm g{xn, W_out, CH, DM, DM, 0, 0}; pg8::StaticOrder S; S.init(CH, DM, G, bx);
                pg8::EpiResid E{hout, hout, 1.0f};
                pg8::gemm_phase(lds, tid, g, S, E);
            } else if (PH_EN(11) && k == 12) {
                const float* nfin_p = INP(I_NFIN);
                for (int m = gw; m < CH; m += NGW) rms_row_f32_inplace(hout + (size_t)m * DM, nfin_p, lane);
            }
        }
        if (step + 1 < ph_hi) grid.sync();
    }
}

extern "C" void kernel_launch(void* const* d_in, const int* in_sizes, int n_in, void* d_out, int out_size, void* d_ws, size_t ws_size, hipStream_t stream) {
    static int grid = 0;
    if (grid == 0) {
        if (n_in != 23 || ws_size < WS_END) { fprintf(stderr, "kernel_launch: unexpected n_in %d or ws_size %zu (need %zu)\n", n_in, ws_size, (size_t)WS_END); grid = -1; return; }
        int dev = 0, cus = 0, per_cu = 0;
        hipGetDevice(&dev);
        hipDeviceGetAttribute(&cus, hipDeviceAttributeMultiprocessorCount, dev);
        if (hipFuncSetAttribute((const void*)mega_fwd, hipFuncAttributeMaxDynamicSharedMemorySize, LDS_BYTES) != hipSuccess) { fprintf(stderr, "kernel_launch: hipFuncSetAttribute failed\n"); }
        if (hipOccupancyMaxActiveBlocksPerMultiprocessor(&per_cu, (const void*)mega_fwd, 512, LDS_BYTES) != hipSuccess || per_cu < 1) { fprintf(stderr, "kernel_launch: occupancy query gave %d\n", per_cu); per_cu = 1; }
        (void)hipGetLastError();
        grid = cus * 1;
        fprintf(stderr, "kernel_launch: cus %d per_cu %d grid %d ws %zu\n", cus, per_cu, grid, ws_size);
    }
    if (grid < 0) return;
    Args a{};
    for (int i = 0; i < 23; ++i) a.in[i] = (const float*)d_in[i];
    a.out = (float*)d_out; a.ws = (unsigned char*)d_ws;
#if MK_MULTI_LAUNCH
    for (int s = 0; s < N_STEPS; ++s) {
        a.ph_lo = s; a.ph_hi = s + 1;
        hipLaunchKernelGGL(mega_fwd, dim3(grid), dim3(512), LDS_BYTES, stream, a);
    }
#else
    a.ph_lo = 0; a.ph_hi = N_STEPS;
    void* args[] = {&a};
    hipError_t e = hipLaunchCooperativeKernel((const void*)mega_fwd, dim3(grid), dim3(512), args, LDS_BYTES, stream);
    if (e != hipSuccess) fprintf(stderr, "cooperative launch failed: %s (grid %d)\n", hipGetErrorString(e), grid);
#endif
}
```

```cpp
#include <hip/hip_runtime.h>
#include <hip/hip_cooperative_groups.h>
#include <cstdio>
#include <cstdint>
namespace cg = cooperative_groups;

#ifndef MK_MULTI_LAUNCH
#define MK_MULTI_LAUNCH 0
#endif

#ifndef PH_MASK
#define PH_MASK 0xFFFF
#endif
#define PH_EN(i) ((PH_MASK >> (i)) & 1)
#ifndef ATT_MASK
#define ATT_MASK 7
#endif
#define ATT_EN(i) ((ATT_MASK >> (i)) & 1)
#ifndef PH_DUP
#define PH_DUP 0
#endif
#define LAS __attribute__((address_space(3)))
typedef unsigned short bf16_t;
typedef short bf16x8 __attribute__((ext_vector_type(8)));
typedef float f32x4 __attribute__((ext_vector_type(4)));
typedef float f32x2 __attribute__((ext_vector_type(2)));
typedef float f32x16 __attribute__((ext_vector_type(16)));
typedef unsigned u32x4 __attribute__((ext_vector_type(4)));
typedef unsigned u32x2 __attribute__((ext_vector_type(2)));
typedef __bf16 bf16x2_t __attribute__((ext_vector_type(2)));
#define GAS __attribute__((address_space(1)))
typedef GAS float gfloat; typedef GAS bf16_t gbf16; typedef GAS f32x4 gf32x4; typedef GAS f32x2 gf32x2; typedef GAS u32x4 gu32x4; typedef GAS u32x2 gu32x2;
typedef GAS bf16x8 gbf16x8; typedef GAS unsigned char guchar; typedef GAS char gchar; typedef GAS unsigned gunsigned;

constexpr int DM = 1024, FF = 2816, PROJ = 5120, CH = 32768, NCH = 131072 / CH, NCH_P = NCH / 2;
constexpr int NMEM = 40 * 256;
constexpr float EPS = 1e-6f;
constexpr float LOG2E = 1.4426950408889634f;

constexpr size_t al(size_t x) { return (x + 4095) & ~(size_t)4095; }
constexpr size_t WS_WFF1I = 0;
constexpr size_t WS_WFF1O = WS_WFF1I + al((size_t)2 * FF * DM * 2);
constexpr size_t WS_WIN   = WS_WFF1O + al((size_t)DM * FF * 2);
constexpr size_t WS_WMEM  = WS_WIN + al((size_t)PROJ * DM * 2);
constexpr size_t WS_WBR   = WS_WMEM + al((size_t)DM * DM * 2);
constexpr size_t WS_WOUT  = WS_WBR + al((size_t)3 * DM * 512 * 2);
constexpr size_t WS_WFF2I = WS_WOUT + al((size_t)DM * DM * 2);
constexpr size_t WS_WFF2O = WS_WFF2I + al((size_t)2 * FF * DM * 2);
constexpr size_t WS_MEMN  = WS_WFF2O + al((size_t)DM * FF * 2);
constexpr size_t WS_KVM   = WS_MEMN + al((size_t)NMEM * DM * 2);
constexpr size_t WS_VTC   = WS_KVM + al((size_t)NMEM * DM * 2);
constexpr size_t WS_ROPE  = WS_VTC + al((size_t)NMEM * 512 * 2);
constexpr size_t WS_BIAS  = WS_ROPE + al((size_t)128 * 16 * 8);
constexpr size_t WS_XN    = WS_BIAS + al((size_t)8 * 768 * 4);
constexpr size_t WS_HID   = WS_XN + al((size_t)CH * DM * 2);
constexpr size_t WS_PROJ  = WS_HID + al((size_t)CH * FF * 2);
constexpr size_t WS_VTA   = WS_PROJ + al((size_t)CH * PROJ * 2);
constexpr size_t WS_VTB   = WS_VTA + al((size_t)CH * 128 * 2);
constexpr size_t WS_Y     = WS_VTB + al((size_t)CH * 128 * 2);
constexpr size_t WS_PART  = WS_Y + al((size_t)3 * CH * 512 * 2);
constexpr size_t WS_MRG   = WS_PART + al((size_t)CH * DM * 4);
constexpr size_t WS_SSQ   = WS_MRG + al((size_t)CH * DM * 2);
constexpr size_t WS_BAR   = WS_SSQ + al((size_t)3 * CH * 4 * 4);
constexpr size_t WS_CNT   = WS_BAR + 32768;
constexpr size_t WS_END   = WS_CNT + 32768;

constexpr int LDS_RED = 131072;
constexpr int LDS_BYTES = 138240;

__device__ __forceinline__ unsigned pk2(float lo, float hi) { f32x2 v = {lo, hi}; bf16x2_t b = __builtin_convertvector(v, bf16x2_t); return __builtin_bit_cast(unsigned, b); }
__device__ __forceinline__ float bflo(unsigned w) { return __uint_as_float(w << 16); }
__device__ __forceinline__ float bfhi(unsigned w) { return __uint_as_float(w & 0xffff0000u); }
__device__ __forceinline__ float wave_sum(float v) {
#pragma unroll
    for (int o = 1; o < 64; o <<= 1) v += __shfl_xor(v, o);
    return v;
}
__device__ __forceinline__ float sigmoidf_(float x) { return __builtin_amdgcn_rcpf(1.0f + __builtin_amdgcn_exp2f(-x * LOG2E)); }

namespace pg8 {
constexpr int BM = 256, BK = 64, HALF = 128, HTB = HALF * BK * 2, STAGE_BYTES = 8 * HTB, NXCD = 8, WGM = 8;
__host__ __device__ __forceinline__ int lds_byte(int r, int c) { const int st = (r >> 4) * 2 + (c >> 5), rr = r & 15, cc = c & 31, ob = rr * 64 + cc * 2; return st * 1024 + (ob ^ (((ob >> 9) & 1) << 5)); }
__host__ __device__ __forceinline__ void stage_rc(int b, int& R, int& C) { const int st = b / 1024, sb = b % 1024, swz = sb ^ (((sb >> 9) & 1) << 5); R = (st >> 1) * 16 + swz / 64; C = (st & 1) * 32 + (swz % 64) / 2; }
__host__ __device__ __forceinline__ int perm32(int rho) { const int n = rho >> 4, i = rho & 15; return 8 * (i >> 2) + 4 * n + (i & 3); }

struct Unit { int pm, pn, pz; };
struct Gemm { const gbf16* A; const gbf16* Bt; int M, N, K; size_t zA, zB; };

struct StaticOrder {
    int nM, nN, nwg, G, c;
    __device__ void init(int M, int N, int G_, int c_) { nM = M / BM; nN = N / BM; nwg = nM * nN; G = G_; c = c_; }
    __device__ bool next(int i, Unit& u) const {
        const long L = (long)i * G + c; if (L >= nwg) return false;
        int wgid = (int)L; { const int q = nwg / NXCD, r = nwg % NXCD, xcd = wgid % NXCD, off = wgid / NXCD; wgid = (xcd < r ? xcd * (q + 1) : r * (q + 1) + (xcd - r) * q) + off; }
        const int nig = WGM * nN, gid = wgid / nig, fm = gid * WGM, gsz = (nM - fm) < WGM ? (nM - fm) : WGM;
        u.pm = fm + ((wgid % nig) % gsz); u.pn = (wgid % nig) / gsz; u.pz = 0; return true;
    }
};
struct BranchOrder {
    StaticOrder b;
    __device__ bool next(int i, Unit& u) const { if (!b.next(i / 3, u)) return false; u.pz = i % 3; return true; }
};

struct EpiPlain {
    static constexpr bool PERM = true;
    gbf16* O; int ldc;
    __device__ __forceinline__ void operator()(const f32x4 (&acc)[2][2][4][2], const Unit& u, int wr, int wc, int fr, int fq, LAS unsigned char* lds, int tid) const {
        const int row0 = u.pm * BM + wr * 64 + fr, col0 = u.pn * BM + wc * 32 + 8 * fq;
#pragma unroll
        for (int ai = 0; ai < 2; ++ai)
#pragma unroll
            for (int m = 0; m < 4; ++m) { gbf16* rowp = O + (size_t)(row0 + ai * HALF + m * 16) * ldc + col0;
#pragma unroll
                for (int bj = 0; bj < 2; ++bj) { const f32x4 v0 = acc[ai][bj][m][0], v1 = acc[ai][bj][m][1];
                    u32x4 w; w.x = pk2(v0[0], v0[1]); w.y = pk2(v0[2], v0[3]); w.z = pk2(v1[0], v1[1]); w.w = pk2(v1[2], v1[3]);
                    *(gu32x4*)(rowp + bj * HALF) = w; } }
    }
};
struct EpiSwiglu {
    static constexpr bool PERM = true;
    gbf16* O;
    __device__ __forceinline__ void operator()(const f32x4 (&acc)[2][2][4][2], const Unit& u, int wr, int wc, int fr, int fq, LAS unsigned char* lds, int tid) const {
        const int row0 = u.pm * BM + wr * 64 + fr, col0 = u.pn * HALF + wc * 32 + 8 * fq;
#pragma unroll
        for (int ai = 0; ai < 2; ++ai)
#pragma unroll
            for (int m = 0; m < 4; ++m) { gbf16* rowp = O + (size_t)(row0 + ai * HALF + m * 16) * FF + col0;
                float h[8];
#pragma unroll
                for (int n = 0; n < 2; ++n)
#pragma unroll
                    for (int e = 0; e < 4; ++e) { const float g = acc[ai][0][m][n][e], uu = acc[ai][1][m][n][e]; h[n * 4 + e] = g * sigmoidf_(g) * uu; }
                u32x4 w; w.x = pk2(h[0], h[1]); w.y = pk2(h[2], h[3]); w.z = pk2(h[4], h[5]); w.w = pk2(h[6], h[7]);
                *(gu32x4*)rowp = w; }
    }
};
struct EpiGate {
    static constexpr bool PERM = true;
    const gbf16* proj; gbf16* part; gbf16* merged;
    __device__ __forceinline__ void operator()(const f32x4 (&acc)[2][2][4][2], const Unit& u, int wr, int wc, int fr, int fq, LAS unsigned char* lds, int tid) const {
        const int row0 = u.pm * BM + wr * 64 + fr, col0 = u.pn * BM + wc * 32 + 8 * fq;
        const int pz = u.pz;
        gbf16* dst = (pz == 2) ? merged : part;
#pragma unroll
        for (int ai = 0; ai < 2; ++ai) {
            u32x4 gv[4][2], pv[4][2];
#pragma unroll
            for (int m = 0; m < 4; ++m) { const size_t row = (size_t)(row0 + ai * HALF + m * 16);
#pragma unroll
                for (int bj = 0; bj < 2; ++bj) { const int col = col0 + bj * HALF;
                    gv[m][bj] = *(const gu32x4*)(proj + row * PROJ + 2048 + 1024 * pz + col);
                    if (pz != 0) pv[m][bj] = *(const gu32x4*)(part + row * DM + col); else pv[m][bj] = (u32x4){0u, 0u, 0u, 0u}; } }
            asm volatile("" ::: "memory");
#pragma unroll
            for (int m = 0; m < 4; ++m) { const size_t row = (size_t)(row0 + ai * HALF + m * 16);
#pragma unroll
                for (int bj = 0; bj < 2; ++bj) { const int col = col0 + bj * HALF; const u32x4 gw = gv[m][bj], pw = pv[m][bj];
                    f32x4 z0, z1;
                    z0[0] = sigmoidf_(bflo(gw.x)); z0[1] = sigmoidf_(bfhi(gw.x)); z0[2] = sigmoidf_(bflo(gw.y)); z0[3] = sigmoidf_(bfhi(gw.y));
                    z1[0] = sigmoidf_(bflo(gw.z)); z1[1] = sigmoidf_(bfhi(gw.z)); z1[2] = sigmoidf_(bflo(gw.w)); z1[3] = sigmoidf_(bfhi(gw.w));
                    const f32x4 q0 = {bflo(pw.x), bfhi(pw.x), bflo(pw.y), bfhi(pw.y)}, q1 = {bflo(pw.z), bfhi(pw.z), bflo(pw.w), bfhi(pw.w)};
                    z0 = z0 * acc[ai][bj][m][0] + q0; z1 = z1 * acc[ai][bj][m][1] + q1;
                    u32x4 w; w.x = pk2(z0[0], z0[1]); w.y = pk2(z0[2], z0[3]); w.z = pk2(z1[0], z1[1]); w.w = pk2(z1[2], z1[3]);
                    *(gu32x4*)(dst + row * DM + col) = w; } }
            asm volatile("" ::: "memory");
        }
    }
};


__device__ __forceinline__ float rstd_from(const gfloat* ssq, size_t row) { const f32x4 p = *(const gf32x4*)(ssq + row * 4); return 1.0f / sqrtf(((p.x + p.y) + (p.z + p.w)) * (1.0f / DM) + EPS); }
struct EpiPlainRstd {
    static constexpr bool PERM = true;
    gbf16* O; int ldc; const gfloat* ssq; int qscale;
    __device__ __forceinline__ void operator()(const f32x4 (&acc)[2][2][4][2], const Unit& u, int wr, int wc, int fr, int fq, LAS unsigned char* lds, int tid) const {
        const int row0 = u.pm * BM + wr * 64 + fr, col0 = u.pn * BM + wc * 32 + 8 * fq;
        const float tsc = !qscale ? 1.0f : (u.pn == 3 || u.pn == 4) ? 0.125f * LOG2E : (u.pn == 6 || u.pn == 7) ? 0.08838834764831845f * LOG2E : 1.0f;
        float rsv[2][4];
        { f32x4 pv_[2][4];
#pragma unroll
          for (int ai = 0; ai < 2; ++ai)
#pragma unroll
              for (int m = 0; m < 4; ++m) pv_[ai][m] = *(const gf32x4*)(ssq + (size_t)(row0 + ai * HALF + m * 16) * 4);
          asm volatile("" ::: "memory");
#pragma unroll
          for (int ai = 0; ai < 2; ++ai)
#pragma unroll
              for (int m = 0; m < 4; ++m) { const f32x4 p = pv_[ai][m]; rsv[ai][m] = __builtin_amdgcn_rsqf(((p.x + p.y) + (p.z + p.w)) * (1.0f / DM) + EPS) * tsc; } }
#pragma unroll
        for (int ai = 0; ai < 2; ++ai)
#pragma unroll
            for (int m = 0; m < 4; ++m) { const size_t row = (size_t)(row0 + ai * HALF + m * 16); const float rs = rsv[ai][m]; gbf16* rowp = O + row * ldc + col0;
#pragma unroll
                for (int bj = 0; bj < 2; ++bj) { const f32x4 v0 = acc[ai][bj][m][0] * rs, v1 = acc[ai][bj][m][1] * rs;
                    u32x4 w; w.x = pk2(v0[0], v0[1]); w.y = pk2(v0[2], v0[3]); w.z = pk2(v1[0], v1[1]); w.w = pk2(v1[2], v1[3]);
                    *(gu32x4*)(rowp + bj * HALF) = w; } }
    }
};
struct EpiSwigluRstd {
    static constexpr bool PERM = true;
    gbf16* O; const gfloat* ssq;
    __device__ __forceinline__ void operator()(const f32x4 (&acc)[2][2][4][2], const Unit& u, int wr, int wc, int fr, int fq, LAS unsigned char* lds, int tid) const {
        const int row0 = u.pm * BM + wr * 64 + fr, col0 = u.pn * HALF + wc * 32 + 8 * fq;
        float rsv[2][4];
        { f32x4 pv_[2][4];
#pragma unroll
          for (int ai = 0; ai < 2; ++ai)
#pragma unroll
              for (int m = 0; m < 4; ++m) pv_[ai][m] = *(const gf32x4*)(ssq + (size_t)(row0 + ai * HALF + m * 16) * 4);
          asm volatile("" ::: "memory");
#pragma unroll
          for (int ai = 0; ai < 2; ++ai)
#pragma unroll
              for (int m = 0; m < 4; ++m) { const f32x4 p = pv_[ai][m]; rsv[ai][m] = __builtin_amdgcn_rsqf(((p.x + p.y) + (p.z + p.w)) * (1.0f / DM) + EPS); } }
#pragma unroll
        for (int ai = 0; ai < 2; ++ai)
#pragma unroll
            for (int m = 0; m < 4; ++m) { const size_t row = (size_t)(row0 + ai * HALF + m * 16); const float rs = rsv[ai][m]; gbf16* rowp = O + row * FF + col0;
                float h[8];
#pragma unroll
                for (int n = 0; n < 2; ++n)
#pragma unroll
                    for (int e = 0; e < 4; ++e) { const float g = acc[ai][0][m][n][e] * rs, uu = acc[ai][1][m][n][e] * rs; h[n * 4 + e] = g * sigmoidf_(g) * uu; }
                u32x4 w; w.x = pk2(h[0], h[1]); w.y = pk2(h[2], h[3]); w.z = pk2(h[4], h[5]); w.w = pk2(h[6], h[7]);
                *(gu32x4*)rowp = w; }
    }
};
template <bool RES_BF16>
struct EpiResidStats {
    static constexpr bool PERM = true;
    const gfloat* resf; const gbf16* resb; gbf16* xb; gfloat* ssq; float scale;
    __device__ __forceinline__ void operator()(const f32x4 (&acc)[2][2][4][2], const Unit& u, int wr, int wc, int fr, int fq, LAS unsigned char* lds, int tid) const {
        const int row0 = u.pm * BM + wr * 64 + fr, col0 = u.pn * BM + wc * 32 + 8 * fq;
        LAS float* red = (LAS float*)(lds + LDS_RED);
#pragma unroll
        for (int ai = 0; ai < 2; ++ai) {
            f32x4 rv[4][2][2]; u32x4 rw[4][2];
#pragma unroll
            for (int m = 0; m < 4; ++m) { const size_t off = (size_t)(row0 + ai * HALF + m * 16) * DM + col0;
#pragma unroll
                for (int bj = 0; bj < 2; ++bj) {
                    if (RES_BF16) rw[m][bj] = *(const gu32x4*)(resb + off + bj * HALF);
                    else { rv[m][bj][0] = *(const gf32x4*)(resf + off + bj * HALF); rv[m][bj][1] = *(const gf32x4*)(resf + off + bj * HALF + 4); } } }
            asm volatile("" ::: "memory");
            if (RES_BF16) {
#pragma unroll
                for (int m = 0; m < 4; ++m)
#pragma unroll
                    for (int bj = 0; bj < 2; ++bj) { const u32x4 w = rw[m][bj];
                        rv[m][bj][0] = (f32x4){bflo(w.x), bfhi(w.x), bflo(w.y), bfhi(w.y)}; rv[m][bj][1] = (f32x4){bflo(w.z), bfhi(w.z), bflo(w.w), bfhi(w.w)}; } }
#pragma unroll
            for (int m = 0; m < 4; ++m) { const size_t off = (size_t)(row0 + ai * HALF + m * 16) * DM + col0; float ss = 0.f;
#pragma unroll
                for (int bj = 0; bj < 2; ++bj) { const f32x4 v0 = rv[m][bj][0] + acc[ai][bj][m][0] * scale, v1 = rv[m][bj][1] + acc[ai][bj][m][1] * scale;
                    u32x4 w; w.x = pk2(v0[0], v0[1]); w.y = pk2(v0[2], v0[3]); w.z = pk2(v1[0], v1[1]); w.w = pk2(v1[2], v1[3]);
                    *(gu32x4*)(xb + off + bj * HALF) = w;
                    ss += ((v0[0] * v0[0] + v0[1] * v0[1]) + (v0[2] * v0[2] + v0[3] * v0[3])) + ((v1[0] * v1[0] + v1[1] * v1[1]) + (v1[2] * v1[2] + v1[3] * v1[3])); }
                ss += __shfl_xor(ss, 16); ss += __shfl_xor(ss, 32);
                if (fq == 0) red[wc * 256 + ai * HALF + wr * 64 + m * 16 + fr] = ss; }
            asm volatile("" ::: "memory"); }
        asm volatile("s_waitcnt lgkmcnt(0)" ::: "memory"); __builtin_amdgcn_s_barrier(); asm volatile("" ::: "memory");
        if (tid < 256) ssq[(size_t)(u.pm * BM + tid) * 4 + u.pn] = (red[tid] + red[256 + tid]) + (red[512 + tid] + red[768 + tid]);
    }
};


struct EpiResidFinal {
    static constexpr bool PERM = true;
    const gbf16* res; gfloat* out; gfloat* ssq; unsigned* cnt; const gfloat* gain; float scale; unsigned want;
    __device__ __forceinline__ void operator()(f32x4 (&acc)[2][2][4][2], const Unit& u, int wr, int wc, int fr, int fq, LAS unsigned char* lds, int tid) const {
        const int row0 = u.pm * BM + wr * 64 + fr, col0 = u.pn * BM + wc * 32 + 8 * fq;
        LAS float* red = (LAS float*)(lds + LDS_RED);
        LAS float* rsl = (LAS float*)(lds + LDS_RED) + 1024;
#pragma unroll
        for (int ai = 0; ai < 2; ++ai) {
            f32x4 rv[4][2][2]; u32x4 rw[4][2];
#pragma unroll
            for (int m = 0; m < 4; ++m) { const size_t off = (size_t)(row0 + ai * HALF + m * 16) * DM + col0;
#pragma unroll
                for (int bj = 0; bj < 2; ++bj) rw[m][bj] = *(const gu32x4*)(res + off + bj * HALF); }
            asm volatile("" ::: "memory");
#pragma unroll
            for (int m = 0; m < 4; ++m)
#pragma unroll
                for (int bj = 0; bj < 2; ++bj) { const u32x4 w = rw[m][bj];
                    rv[m][bj][0] = (f32x4){bflo(w.x), bfhi(w.x), bflo(w.y), bfhi(w.y)}; rv[m][bj][1] = (f32x4){bflo(w.z), bfhi(w.z), bflo(w.w), bfhi(w.w)}; }
#pragma unroll
            for (int m = 0; m < 4; ++m) { float ss = 0.f;
#pragma unroll
                for (int bj = 0; bj < 2; ++bj)
#pragma unroll
                    for (int n = 0; n < 2; ++n) { const f32x4 v = rv[m][bj][n] + acc[ai][bj][m][n] * scale; acc[ai][bj][m][n] = v;
                        ss += (v[0] * v[0] + v[1] * v[1]) + (v[2] * v[2] + v[3] * v[3]); }
                ss += __shfl_xor(ss, 16); ss += __shfl_xor(ss, 32);
                if (fq == 0) red[wc * 256 + ai * HALF + wr * 64 + m * 16 + fr] = ss; }
            asm volatile("" ::: "memory"); }
        asm volatile("s_waitcnt lgkmcnt(0)" ::: "memory"); __builtin_amdgcn_s_barrier(); asm volatile("" ::: "memory");
        if (tid < 256) __hip_atomic_store(ssq + (size_t)(u.pm * BM + tid) * 4 + u.pn, (red[tid] + red[256 + tid]) + (red[512 + tid] + red[768 + tid]), __ATOMIC_RELAXED, __HIP_MEMORY_SCOPE_AGENT);
        asm volatile("s_waitcnt vmcnt(0)" ::: "memory"); __builtin_amdgcn_s_barrier(); asm volatile("" ::: "memory");
        if (tid == 0) {
            unsigned* c = cnt + 64 * u.pm;
            __hip_atomic_fetch_add(c, 1u, __ATOMIC_RELAXED, __HIP_MEMORY_SCOPE_AGENT);
            unsigned sp = 0;
            while (__hip_atomic_load(c, __ATOMIC_RELAXED, __HIP_MEMORY_SCOPE_AGENT) < want) { __builtin_amdgcn_s_sleep(1); if (++sp > (1u << 22)) break; }
            __builtin_amdgcn_fence(__ATOMIC_ACQUIRE, "agent");
        }
        asm volatile("s_waitcnt vmcnt(0) lgkmcnt(0)" ::: "memory"); __builtin_amdgcn_s_barrier(); asm volatile("" ::: "memory");
        if (tid < 256) { const gfloat* p = ssq + (size_t)(u.pm * BM + tid) * 4; f32x4 pv4;
            asm volatile("global_load_dwordx4 %0, %1, off sc0 sc1\n\ts_waitcnt vmcnt(0)" : "=v"(pv4) : "v"(p) : "memory");
            rsl[tid] = __builtin_amdgcn_rsqf(((pv4.x + pv4.y) + (pv4.z + pv4.w)) * (1.0f / DM) + EPS); }
        asm volatile("s_waitcnt vmcnt(0) lgkmcnt(0)" ::: "memory"); __builtin_amdgcn_s_barrier(); asm volatile("" ::: "memory");
        f32x4 gv[2][2];
#pragma unroll
        for (int bj = 0; bj < 2; ++bj)
#pragma unroll
            for (int n = 0; n < 2; ++n) gv[bj][n] = *(const gf32x4*)(gain + col0 + bj * HALF + n * 4);
#pragma unroll
        for (int ai = 0; ai < 2; ++ai)
#pragma unroll
            for (int m = 0; m < 4; ++m) { const int rl = ai * HALF + wr * 64 + m * 16 + fr; const float rs = rsl[rl]; const size_t off = (size_t)(u.pm * BM + rl) * DM + col0;
#pragma unroll
                for (int bj = 0; bj < 2; ++bj)
#pragma unroll
                    for (int n = 0; n < 2; ++n) *(gf32x4*)(out + off + bj * HALF + n * 4) = acc[ai][bj][m][n] * rs * gv[bj][n]; }
    }
};

template <class Epi, class Sched>
__device__ __forceinline__ void gemm_phase(LAS unsigned char* lds, const int tid, const Gemm g, const Sched& S, const Epi& E) {
    const int wid = __builtin_amdgcn_readfirstlane(tid >> 6), lane = tid & 63, wr = wid >> 2, wc = wid & 3, fr = lane & 15, fq = lane >> 4;
    const int K = g.K, nt = K / BK;
    unsigned voffA[2], voffB[2];
#pragma unroll
    for (int i = 0; i < 2; ++i) { int R, C; stage_rc(tid * 16 + i * 8192, R, C); const int Rb = Epi::PERM ? ((R & ~31) + perm32(R & 31)) : R;
        voffA[i] = (unsigned)(R * K + C) * 2u; voffB[i] = (unsigned)(Rb * K + C) * 2u; }
    const size_t kstep = (size_t)(BK * 2);
    const size_t hstep = (size_t)HALF * K * 2;
    const size_t tstep = 2 * hstep;
    const unsigned ldsw = (unsigned)wid * 1024u;
    const int aoff = lds_byte(wr * 64 + fr, fq * 8), boff = lds_byte(wc * 32 + fr, fq * 8);
#define PG8_SA(b, h) (((b) * 2 + (h)) * HTB)
#define PG8_SB(b, h) ((4 + (b) * 2 + (h)) * HTB)
#define PG8_STAGE(bufoff, gbase, voff) do { _Pragma("unroll") for (int _i = 0; _i < 2; ++_i) \
        __builtin_amdgcn_global_load_lds((const gunsigned*)((const gchar*)(gbase) + (voff)[_i]), (LAS unsigned*)(lds + (bufoff) + ldsw + _i * 8192), 16, 0, 0); } while (0)
#define PG8_LDA(dst, b, h) do { _Pragma("unroll") for (int m = 0; m < 4; ++m) _Pragma("unroll") for (int k = 0; k < 2; ++k) dst[m][k] = *(const LAS bf16x8*)(lds + PG8_SA(b, h) + aoff + m * 2048 + k * 1024); } while (0)
#define PG8_LDB(dst, b, h) do { _Pragma("unroll") for (int n = 0; n < 2; ++n) _Pragma("unroll") for (int k = 0; k < 2; ++k) dst[n][k] = *(const LAS bf16x8*)(lds + PG8_SB(b, h) + boff + n * 2048 + k * 1024); } while (0)
#define PG8_MMA(ai, bj, At, Bt) do { __builtin_amdgcn_s_setprio(1); _Pragma("unroll") for (int m = 0; m < 4; ++m) _Pragma("unroll") for (int n = 0; n < 2; ++n) _Pragma("unroll") for (int k = 0; k < 2; ++k) \
        acc[ai][bj][m][n] = __builtin_amdgcn_mfma_f32_16x16x32_bf16(Bt[n][k], At[m][k], acc[ai][bj][m][n], 0, 0, 0); __builtin_amdgcn_s_setprio(0); } while (0)
#define PG8_WAIT_V(n) asm volatile("s_waitcnt vmcnt(" #n ")" ::: "memory")
#define PG8_WAIT_L(n) asm volatile("s_waitcnt lgkmcnt(" #n ")" ::: "memory")
#define PG8_BAR __builtin_amdgcn_s_barrier()
#define PG8_SCHED __builtin_amdgcn_sched_barrier(0)
    Unit cur, nxt; int ui = 0;
    if (!S.next(0, cur)) return;
    f32x4 acc[2][2][4][2];
#pragma unroll
    for (int a = 0; a < 2; ++a)
#pragma unroll
        for (int b = 0; b < 2; ++b)
#pragma unroll
            for (int m = 0; m < 4; ++m)
#pragma unroll
                for (int n = 0; n < 2; ++n) acc[a][b][m][n] = (f32x4){0.f, 0.f, 0.f, 0.f};
    bf16x8 At[4][2], B0[2][2], B1[2][2];
    const gchar* cA = (const gchar*)g.A + (size_t)cur.pm * tstep + (size_t)cur.pz * g.zA; const gchar* cB = (const gchar*)g.Bt + (size_t)cur.pn * tstep + (size_t)cur.pz * g.zB;
    PG8_STAGE(PG8_SB(0, 0), cB, voffB); PG8_STAGE(PG8_SB(0, 1), cB + hstep, voffB); PG8_STAGE(PG8_SA(0, 0), cA, voffA); PG8_STAGE(PG8_SA(0, 1), cA + hstep, voffA);
    if (wr == 1) PG8_BAR;
    PG8_WAIT_V(2); PG8_BAR;
    PG8_STAGE(PG8_SB(1, 0), cB + kstep, voffB); PG8_STAGE(PG8_SA(1, 0), cA + kstep, voffA); PG8_STAGE(PG8_SB(1, 1), cB + hstep + kstep, voffB);
    PG8_WAIT_V(6); PG8_BAR;
    for (;;) {
        const bool has_next = S.next(ui + 1, nxt);
        const gchar* nA = has_next ? (const gchar*)g.A + (size_t)nxt.pm * tstep + (size_t)nxt.pz * g.zA : cA;
        const gchar* nB = has_next ? (const gchar*)g.Bt + (size_t)nxt.pn * tstep + (size_t)nxt.pz * g.zB : cB;
        for (int t = 0; t < nt; t += 2) {
            const bool last = (t == nt - 2);
            const gchar* a1 = cA + (size_t)(t + 1) * kstep;
            const gchar* a2 = last ? nA : cA + (size_t)(t + 2) * kstep; const gchar* b2 = last ? nB : cB + (size_t)(t + 2) * kstep;
            const gchar* a3 = a2 + kstep; const gchar* b3 = b2 + kstep;
            PG8_LDB(B0, 0, 0); PG8_LDB(B1, 0, 1); PG8_SCHED; PG8_LDA(At, 0, 0); PG8_STAGE(PG8_SA(1, 1), a1 + hstep, voffA);
            PG8_WAIT_V(8); PG8_WAIT_L(0); PG8_BAR; PG8_MMA(0, 0, At, B0); PG8_MMA(0, 1, At, B1); PG8_BAR; PG8_SCHED;
            PG8_LDA(At, 0, 1); PG8_STAGE(PG8_SB(0, 0), b2, voffB); PG8_STAGE(PG8_SB(0, 1), b2 + hstep, voffB); PG8_STAGE(PG8_SA(0, 0), a2, voffA);
            PG8_WAIT_V(8); PG8_WAIT_L(0); PG8_BAR; PG8_MMA(1, 0, At, B0); PG8_MMA(1, 1, At, B1); PG8_BAR; PG8_SCHED;
            PG8_LDB(B0, 1, 0); PG8_LDB(B1, 1, 1); PG8_SCHED; PG8_LDA(At, 1, 0); PG8_STAGE(PG8_SA(0, 1), a2 + hstep, voffA);
            PG8_WAIT_V(8); PG8_WAIT_L(0); PG8_BAR; PG8_MMA(0, 0, At, B0); PG8_MMA(0, 1, At, B1); PG8_BAR; PG8_SCHED;
            PG8_LDA(At, 1, 1); PG8_STAGE(PG8_SB(1, 0), b3, voffB); PG8_STAGE(PG8_SB(1, 1), b3 + hstep, voffB); PG8_STAGE(PG8_SA(1, 0), a3, voffA);
            PG8_WAIT_V(8); PG8_WAIT_L(0); PG8_BAR; PG8_MMA(1, 0, At, B0); PG8_MMA(1, 1, At, B1); PG8_BAR; PG8_SCHED;
        }
        if (wr == 0) PG8_BAR;
        E(acc, cur, wr, wc, fr, fq, lds, tid);
        if (!has_next) break;
#pragma unroll
        for (int a = 0; a < 2; ++a)
#pragma unroll
            for (int b = 0; b < 2; ++b)
#pragma unroll
                for (int m = 0; m < 4; ++m)
#pragma unroll
                    for (int n = 0; n < 2; ++n) acc[a][b][m][n] = (f32x4){0.f, 0.f, 0.f, 0.f};
        cur = nxt; cA = nA; cB = nB; ++ui;
        if (wr == 1) PG8_BAR;
    }
    PG8_WAIT_V(0);
    PG8_BAR;
#undef PG8_SA
#undef PG8_SB
#undef PG8_STAGE
#undef PG8_LDA
#undef PG8_LDB
#undef PG8_MMA
#undef PG8_WAIT_V
#undef PG8_WAIT_L
#undef PG8_BAR
#undef PG8_SCHED
}
}

constexpr int ATT_BIAS_OFF = 110592;
template <int HD, int MODE>
__device__ __forceinline__ void attn_unit(LAS unsigned char* lds, const int tid_in, const gbf16* Qg, int q_pitch, const gbf16* Kg, int k_pitch,
                                          const gbf16* Vtg, int vt_pitch, gbf16* Og, int o_pitch, int t0, int t1, float c,
                                          int q0, const gfloat* biasg, float m_init, float l_init, const gfloat* qgain, const gf32x2* ropet) {
    constexpr int KROW = HD * 2 + 16, VROW = 144, KBYTES = 64 * KROW, VBYTES = HD * VROW, BUF = KBYTES + VBYTES, NP = HD / 64;
    static_assert(3 * BUF <= ATT_BIAS_OFF, "attention LDS");
    int tid = tid_in; asm volatile("" : "+v"(tid));
    const int lane = tid & 63, wid = __builtin_amdgcn_readfirstlane(tid >> 6), r32 = lane & 31, hi = lane >> 5;
    bf16x8 qf[HD / 16];
    u32x4 kstA[NP], vstA[NP], kstB[NP], vstB[NP];
    unsigned kgo[NP], vgo[NP], kl[NP], vl[NP];
#pragma unroll
    for (int p = 0; p < NP; ++p) { const int idx = tid + 512 * p; const int krow = idx / (HD / 8), kch = idx % (HD / 8), vd = idx >> 3, vch = idx & 7;
        kgo[p] = (unsigned)(krow * k_pitch + kch * 8) * 2u; vgo[p] = (unsigned)(vd * vt_pitch + vch * 8) * 2u;
        kl[p] = krow * KROW + kch * 16; vl[p] = KBYTES + vd * VROW + vch * 16; }
#define ATT_LOAD(t, KS, VS) do { const gchar* kb0_ = (const gchar*)(Kg + (size_t)(t) * 64 * k_pitch); const gchar* vb0_ = (const gchar*)(Vtg + (t) * 64); \
        _Pragma("unroll") for (int p = 0; p < NP; ++p) { KS[p] = *(const gu32x4*)(kb0_ + kgo[p]); VS[p] = *(const gu32x4*)(vb0_ + vgo[p]); } } while (0)
#define ATT_STORE(boff, KS, VS) do { _Pragma("unroll") for (int p = 0; p < NP; ++p) { *(LAS u32x4*)(lds + (boff) + kl[p]) = KS[p]; *(LAS u32x4*)(lds + (boff) + vl[p]) = VS[p]; } } while (0)
#define ATT_QK(S0, S1, boff) do { const LAS unsigned char* kb_ = lds + (boff) + krd; \
        _Pragma("unroll") for (int r = 0; r < 16; ++r) { S0[r] = 0.f; S1[r] = 0.f; } \
        _Pragma("unroll") for (int d0 = 0; d0 < HD / 16; ++d0) { \
            const bf16x8 k0_ = *(const LAS bf16x8*)(kb_ + d0 * 32); const bf16x8 k1_ = *(const LAS bf16x8*)(kb_ + 32 * KROW + d0 * 32); \
            S0 = __builtin_amdgcn_mfma_f32_32x32x16_bf16(k0_, qf[d0], S0, 0, 0, 0); S1 = __builtin_amdgcn_mfma_f32_32x32x16_bf16(k1_, qf[d0], S1, 0, 0, 0); } } while (0)
    const int pr = (r32 & 0x13) | ((r32 & 4) << 1) | ((r32 & 8) >> 1);
    const unsigned krd = pr * KROW + hi * 16, vrd = KBYTES + r32 * VROW + hi * 16;
    f32x16 o[HD / 32];
#pragma unroll
    for (int d0 = 0; d0 < HD / 32; ++d0)
#pragma unroll
        for (int r = 0; r < 16; ++r) o[d0][r] = 0.f;
    float m_run = m_init, l_run = l_init;
    const LAS float* biasl = (const LAS float*)(lds + ATT_BIAS_OFF);
    const int qpos = q0 + wid * 32 + r32;
    ATT_LOAD(t0, kstA, vstA); if (t0 + 1 < t1) ATT_LOAD(t0 + 1, kstB, vstB);
    { const gbf16* qrow = Qg + (size_t)(wid * 32 + r32) * q_pitch + hi * 8;
      u32x4 qraw[HD / 16]; f32x4 gq[HD / 16][2], cs[HD / 16][2];
      const int pos = q0 + wid * 32 + r32;
#pragma unroll
      for (int d0 = 0; d0 < HD / 16; ++d0) { qraw[d0] = *(const gu32x4*)(qrow + d0 * 16);
          const gf32x4* gp_ = (const gf32x4*)(qgain + 16 * d0 + 8 * hi); gq[d0][0] = gp_[0]; gq[d0][1] = gp_[1];
          const gf32x4* rp_ = (const gf32x4*)(ropet + ((d0 < HD / 32) ? (pos >> 6) : (pos & 63)) * 16 + 8 * (d0 % (HD / 32)) + 4 * hi); cs[d0][0] = rp_[0]; cs[d0][1] = rp_[1]; }
      float x[HD / 16][8]; float ss = 0.f;
#pragma unroll
      for (int d0 = 0; d0 < HD / 16; ++d0) { const u32x4 v = qraw[d0];
          x[d0][0] = bflo(v.x); x[d0][1] = bfhi(v.x); x[d0][2] = bflo(v.y); x[d0][3] = bfhi(v.y); x[d0][4] = bflo(v.z); x[d0][5] = bfhi(v.z); x[d0][6] = bflo(v.w); x[d0][7] = bfhi(v.w);
#pragma unroll
          for (int e = 0; e < 8; ++e) ss += x[d0][e] * x[d0][e]; }
      { auto rr = __builtin_amdgcn_permlane32_swap(__float_as_uint(ss), __float_as_uint(ss), false, false); ss = __uint_as_float(rr[0]) + __uint_as_float(rr[1]); }
      const float rstd = (1.0f / sqrtf(ss * (1.0f / HD) + EPS)) * c;
#pragma unroll
      for (int d0 = 0; d0 < HD / 16; ++d0) {
          float y[8];
#pragma unroll
          for (int p = 0; p < 4; ++p) { const float a = x[d0][2 * p] * rstd * gq[d0][p >> 1][2 * (p & 1)], b = x[d0][2 * p + 1] * rstd * gq[d0][p >> 1][2 * (p & 1) + 1];
              const float co = cs[d0][p >> 1][2 * (p & 1)], si = cs[d0][p >> 1][2 * (p & 1) + 1];
              y[2 * p] = a * co - b * si; y[2 * p + 1] = a * si + b * co; }
          u32x4 w; w.x = pk2(y[0], y[1]); w.y = pk2(y[2], y[3]); w.z = pk2(y[4], y[5]); w.w = pk2(y[6], y[7]); qf[d0] = __builtin_bit_cast(bf16x8, w); } }
    __syncthreads();
    ATT_STORE(0, kstA, vstA); if (t0 + 1 < t1) ATT_STORE(BUF, kstB, vstB);
    if (t0 + 2 < t1) ATT_LOAD(t0 + 2, kstA, vstA);
    if (MODE == 1) { if (tid < 257) ((LAS float*)(lds + ATT_BIAS_OFF))[tid] = biasg[tid]; }
    __syncthreads();
    int bc = 0, bn = BUF, bw = 2 * BUF;
    f32x16 sa0, sa1, sb0, sb1, negm;
    ATT_QK(sa0, sa1, 0);
    { float mx0 = fmaxf(sa0[0], sa1[0]);
#pragma unroll
      for (int r = 1; r < 16; ++r) mx0 = fmaxf(fmaxf(mx0, sa0[r]), sa1[r]);
      { auto rr = __builtin_amdgcn_permlane32_swap(__float_as_uint(mx0), __float_as_uint(mx0), false, false); mx0 = fmaxf(__uint_as_float(rr[0]), __uint_as_float(rr[1])); }
      m_run = mx0;
#pragma unroll
      for (int r = 0; r < 16; ++r) { sa0[r] -= mx0; sa1[r] -= mx0; negm[r] = -mx0; } }
#define ATT_SB() __builtin_amdgcn_sched_barrier(0)
#define ATT_STEP(SC0, SC1, SN0, SN1, t, KL, VL, KSt, VSt) do { \
        const bool has2_ = ((t) + 2 < t1); \
        if ((t) > t0) __syncthreads(); \
        if ((t) + 3 < t1) ATT_LOAD((t) + 3, KL, VL); \
        ATT_SB(); \
          \
        bf16x8 kf0_[HD / 16], kf1_[HD / 16]; \
        { const LAS unsigned char* kb_ = lds + bn + krd; \
          _Pragma("unroll") for (int d0 = 0; d0 < HD / 16; ++d0) { kf0_[d0] = *(const LAS bf16x8*)(kb_ + d0 * 32); kf1_[d0] = *(const LAS bf16x8*)(kb_ + 32 * KROW + d0 * 32); } } \
        ATT_SB(); \
          \
        float mx_ = fmaxf(SC0[0], SC1[0]); \
        _Pragma("unroll") for (int r = 1; r < 16; ++r) mx_ = fmaxf(fmaxf(mx_, SC0[r]), SC1[r]); \
        { auto rr = __builtin_amdgcn_permlane32_swap(__float_as_uint(mx_), __float_as_uint(mx_), false, false); mx_ = fmaxf(__uint_as_float(rr[0]), __uint_as_float(rr[1])); } \
        if (__any(mx_ > 4.0f)) { \
            const float dl_ = fmaxf(mx_, 0.f); const float al_ = __builtin_amdgcn_exp2f(-dl_); \
            m_run += dl_; l_run *= al_; \
            _Pragma("unroll") for (int r = 0; r < 16; ++r) { SC0[r] -= dl_; SC1[r] -= dl_; } \
            _Pragma("unroll") for (int d0 = 0; d0 < HD / 32; ++d0) _Pragma("unroll") for (int r = 0; r < 16; ++r) o[d0][r] *= al_; \
            _Pragma("unroll") for (int r = 0; r < 16; ++r) negm[r] = -m_run; } \
        ATT_SB(); \
          \
        SN0 = __builtin_amdgcn_mfma_f32_32x32x16_bf16(kf0_[0], qf[0], negm, 0, 0, 0); SN1 = __builtin_amdgcn_mfma_f32_32x32x16_bf16(kf1_[0], qf[0], negm, 0, 0, 0); \
        _Pragma("unroll") for (int d0 = 1; d0 < HD / 16; ++d0) { \
            SN0 = __builtin_amdgcn_mfma_f32_32x32x16_bf16(kf0_[d0], qf[d0], SN0, 0, 0, 0); SN1 = __builtin_amdgcn_mfma_f32_32x32x16_bf16(kf1_[d0], qf[d0], SN1, 0, 0, 0); } \
        float rs_ = 0.f; \
        _Pragma("unroll") for (int r = 0; r < 16; ++r) { SC0[r] = __builtin_amdgcn_exp2f(SC0[r]); rs_ += SC0[r]; } \
        bf16x8 pf_[4]; \
        { u32x4 w; \
          w.x = pk2(SC0[0], SC0[1]); w.y = pk2(SC0[2], SC0[3]); w.z = pk2(SC0[4], SC0[5]); w.w = pk2(SC0[6], SC0[7]); pf_[0] = __builtin_bit_cast(bf16x8, w); \
          w.x = pk2(SC0[8], SC0[9]); w.y = pk2(SC0[10], SC0[11]); w.z = pk2(SC0[12], SC0[13]); w.w = pk2(SC0[14], SC0[15]); pf_[1] = __builtin_bit_cast(bf16x8, w); } \
        _Pragma("unroll") for (int g_ = 0; g_ < HD / 8; ++g_) { \
            __builtin_amdgcn_sched_group_barrier(0x008, 1, 0); __builtin_amdgcn_sched_group_barrier(0x400, 2, 0); __builtin_amdgcn_sched_group_barrier(0x002, 5, 0); } \
        ATT_SB(); \
          \
        bf16x8 vf_[HD / 32][4]; \
        { const LAS unsigned char* vb_ = lds + bc + vrd; \
          _Pragma("unroll") for (int d0 = 0; d0 < HD / 32; ++d0) _Pragma("unroll") for (int kk = 0; kk < 4; ++kk) vf_[d0][kk] = *(const LAS bf16x8*)(vb_ + d0 * 32 * VROW + kk * 32); } \
        ATT_SB(); \
          \
        _Pragma("unroll") for (int r = 0; r < 16; ++r) { SC1[r] = __builtin_amdgcn_exp2f(SC1[r]); rs_ += SC1[r]; } \
        { u32x4 w; \
          w.x = pk2(SC1[0], SC1[1]); w.y = pk2(SC1[2], SC1[3]); w.z = pk2(SC1[4], SC1[5]); w.w = pk2(SC1[6], SC1[7]); pf_[2] = __builtin_bit_cast(bf16x8, w); \
          w.x = pk2(SC1[8], SC1[9]); w.y = pk2(SC1[10], SC1[11]); w.z = pk2(SC1[12], SC1[13]); w.w = pk2(SC1[14], SC1[15]); pf_[3] = __builtin_bit_cast(bf16x8, w); } \
        l_run += rs_; \
        ATT_SB(); \
          \
        _Pragma("unroll") for (int d0 = 0; d0 < HD / 32; ++d0) _Pragma("unroll") for (int kk = 0; kk < 4; ++kk) \
            o[d0] = __builtin_amdgcn_mfma_f32_32x32x16_bf16(vf_[d0][kk], pf_[kk], o[d0], 0, 0, 0); \
        ATT_SB(); \
        if (has2_) ATT_STORE(bw, KSt, VSt); \
        { const int tmp_ = bc; bc = bn; bn = bw; bw = tmp_; } \
    } while (0)
    int t = t0;
    for (; t + 1 < t1; t += 2) { ATT_STEP(sa0, sa1, sb0, sb1, t, kstB, vstB, kstA, vstA); ATT_STEP(sb0, sb1, sa0, sa1, t + 1, kstA, vstA, kstB, vstB); }
    if (t < t1) ATT_STEP(sa0, sa1, sb0, sb1, t, kstB, vstB, kstA, vstA);
    float l_tot; { auto rr = __builtin_amdgcn_permlane32_swap(__float_as_uint(l_run), __float_as_uint(l_run), false, false); l_tot = __uint_as_float(rr[0]) + __uint_as_float(rr[1]); }
    const float inv = 1.0f / l_tot;
    gbf16* orow = Og + (size_t)(wid * 32 + r32) * o_pitch + 4 * hi;
#pragma unroll
    for (int d0 = 0; d0 < HD / 32; ++d0)
#pragma unroll
        for (int rq = 0; rq < 4; ++rq) { u32x2 w; w.x = pk2(o[d0][4 * rq] * inv, o[d0][4 * rq + 1] * inv); w.y = pk2(o[d0][4 * rq + 2] * inv, o[d0][4 * rq + 3] * inv);
            *(gu32x2*)(orow + 32 * d0 + 8 * rq) = w; }
#undef ATT_STEP
#undef ATT_SB
#undef ATT_QK
#undef ATT_LOAD
#undef ATT_STORE
}

template <int HD, int MODE>
__device__ __forceinline__ void attn_unit_np(LAS unsigned char* lds, const int tid_in, const gbf16* Qg, int q_pitch, const gbf16* Kg, int k_pitch,
                                          const gbf16* Vtg, int vt_pitch, gbf16* Og, int o_pitch, int t0, int t1, float c,
                                          int q0, const gfloat* biasg, float m_init, float l_init) {
    constexpr int KROW = HD * 2 + 16, VROW = 144, KBYTES = 64 * KROW, VBYTES = HD * VROW, BUF = KBYTES + VBYTES, NP = HD / 64;
    static_assert(2 * BUF <= ATT_BIAS_OFF, "attention LDS");
    int tid = tid_in; asm volatile("" : "+v"(tid));
    const int lane = tid & 63, wid = __builtin_amdgcn_readfirstlane(tid >> 6), r32 = lane & 31, hi = lane >> 5;
    bf16x8 qf[HD / 16];
    { const gbf16* qrow = Qg + (size_t)(wid * 32 + r32) * q_pitch + hi * 8;
#pragma unroll
      for (int d0 = 0; d0 < HD / 16; ++d0) qf[d0] = *(const gbf16x8*)(qrow + d0 * 16); }
    u32x4 kst[NP], vst[NP];
    const gbf16* kg[NP]; const gbf16* vg[NP]; unsigned kl[NP], vl[NP];
#pragma unroll
    for (int p = 0; p < NP; ++p) { const int idx = tid + 512 * p; const int krow = idx / (HD / 8), kch = idx % (HD / 8), vd = idx >> 3, vch = idx & 7;
        kg[p] = Kg + (size_t)krow * k_pitch + kch * 8; vg[p] = Vtg + (size_t)vd * vt_pitch + vch * 8;
        kl[p] = krow * KROW + kch * 16; vl[p] = KBYTES + vd * VROW + vch * 16; }
#define ATT_LOAD(t) do { _Pragma("unroll") for (int p = 0; p < NP; ++p) { kst[p] = *(const gu32x4*)(kg[p] + (size_t)(t) * 64 * k_pitch); vst[p] = *(const gu32x4*)(vg[p] + (t) * 64); } } while (0)
#define ATT_STORE(b) do { _Pragma("unroll") for (int p = 0; p < NP; ++p) { *(LAS u32x4*)(lds + (b) * BUF + kl[p]) = kst[p]; *(LAS u32x4*)(lds + (b) * BUF + vl[p]) = vst[p]; } } while (0)
    const int pr = (r32 & 0x13) | ((r32 & 4) << 1) | ((r32 & 8) >> 1);
    const unsigned krd = pr * KROW + hi * 16, vrd = KBYTES + r32 * VROW + hi * 16;
    f32x16 o[HD / 32];
#pragma unroll
    for (int d0 = 0; d0 < HD / 32; ++d0)
#pragma unroll
        for (int r = 0; r < 16; ++r) o[d0][r] = 0.f;
    float m_run = m_init, l_run = l_init;
    const LAS float* biasl = (const LAS float*)(lds + ATT_BIAS_OFF);
    ATT_LOAD(t0);
    __syncthreads();
    ATT_STORE(0);
    if (MODE == 1) { ((LAS float*)(lds + ATT_BIAS_OFF))[tid] = biasg[tid]; if (tid < 256) ((LAS float*)(lds + ATT_BIAS_OFF))[512 + tid] = biasg[512 + tid]; }
    int cur = 0;
    const int qlo = q0 + wid * 32;
    for (int t = t0; t < t1; ++t) {
        __syncthreads();
        const bool more = (t + 1 < t1);
        if (more) ATT_LOAD(t + 1);
        bool active = true;
        if (MODE == 1) active = !(64 * t + 63 < qlo - 128 || 64 * t > qlo + 31 + 128);
        if (active) {
            const LAS unsigned char* kb = lds + cur * BUF + krd;
            const LAS unsigned char* vb = lds + cur * BUF + vrd;
            f32x16 s0, s1;
#pragma unroll
            for (int r = 0; r < 16; ++r) { s0[r] = 0.f; s1[r] = 0.f; }
            if constexpr (HD == 64) {
                bf16x8 kf0[HD / 16], kf1[HD / 16];
#pragma unroll
                for (int d0 = 0; d0 < HD / 16; ++d0) { kf0[d0] = *(const LAS bf16x8*)(kb + d0 * 32); kf1[d0] = *(const LAS bf16x8*)(kb + 32 * KROW + d0 * 32); }
                __builtin_amdgcn_sched_barrier(0);
#pragma unroll
                for (int d0 = 0; d0 < HD / 16; ++d0) { s0 = __builtin_amdgcn_mfma_f32_32x32x16_bf16(kf0[d0], qf[d0], s0, 0, 0, 0); s1 = __builtin_amdgcn_mfma_f32_32x32x16_bf16(kf1[d0], qf[d0], s1, 0, 0, 0); }
            } else {
#pragma unroll
            for (int d0 = 0; d0 < HD / 16; ++d0) {
                const bf16x8 k0 = *(const LAS bf16x8*)(kb + d0 * 32);
                const bf16x8 k1 = *(const LAS bf16x8*)(kb + 32 * KROW + d0 * 32);
                s0 = __builtin_amdgcn_mfma_f32_32x32x16_bf16(k0, qf[d0], s0, 0, 0, 0);
                s1 = __builtin_amdgcn_mfma_f32_32x32x16_bf16(k1, qf[d0], s1, 0, 0, 0);
            } }
            if (MODE == 1) {
                const LAS float* bl = biasl + (64 * t + 8 * hi - (qlo + r32) + 384);
#pragma unroll
                for (int r = 0; r < 16; ++r) { s0[r] += bl[16 * (r >> 3) + (r & 7)]; s1[r] += bl[32 + 16 * (r >> 3) + (r & 7)]; }
            }
            float mx = fmaxf(s0[0], s1[0]);
#pragma unroll
            for (int r = 1; r < 16; ++r) mx = fmaxf(mx, fmaxf(s0[r], s1[r]));
            { auto rr = __builtin_amdgcn_permlane32_swap(__float_as_uint(mx), __float_as_uint(mx), false, false); mx = fmaxf(__uint_as_float(rr[0]), __uint_as_float(rr[1])); }
            const float m_new = fmaxf(m_run, mx);
            const bool grew = __any(m_new > m_run);
            const float alpha = __builtin_amdgcn_exp2f(m_run - m_new);
            m_run = m_new;
            float rs = 0.f;
#pragma unroll
            for (int r = 0; r < 16; ++r) { s0[r] = __builtin_amdgcn_exp2f(s0[r] - m_new); s1[r] = __builtin_amdgcn_exp2f(s1[r] - m_new); rs += s0[r] + s1[r]; }
            l_run = l_run * alpha + rs;
            if (grew) {
#pragma unroll
                for (int d0 = 0; d0 < HD / 32; ++d0)
#pragma unroll
                    for (int r = 0; r < 16; ++r) o[d0][r] *= alpha;
            }
            bf16x8 pf[4];
            { u32x4 w;
              w.x = pk2(s0[0], s0[1]); w.y = pk2(s0[2], s0[3]); w.z = pk2(s0[4], s0[5]); w.w = pk2(s0[6], s0[7]); pf[0] = __builtin_bit_cast(bf16x8, w);
              w.x = pk2(s0[8], s0[9]); w.y = pk2(s0[10], s0[11]); w.z = pk2(s0[12], s0[13]); w.w = pk2(s0[14], s0[15]); pf[1] = __builtin_bit_cast(bf16x8, w);
              w.x = pk2(s1[0], s1[1]); w.y = pk2(s1[2], s1[3]); w.z = pk2(s1[4], s1[5]); w.w = pk2(s1[6], s1[7]); pf[2] = __builtin_bit_cast(bf16x8, w);
              w.x = pk2(s1[8], s1[9]); w.y = pk2(s1[10], s1[11]); w.z = pk2(s1[12], s1[13]); w.w = pk2(s1[14], s1[15]); pf[3] = __builtin_bit_cast(bf16x8, w); }
            if constexpr (HD == 64) {
                bf16x8 vfr[HD / 32][4];
#pragma unroll
                for (int d0 = 0; d0 < HD / 32; ++d0)
#pragma unroll
                    for (int kk = 0; kk < 4; ++kk) vfr[d0][kk] = *(const LAS bf16x8*)(vb + d0 * 32 * VROW + kk * 32);
                __builtin_amdgcn_sched_barrier(0);
#pragma unroll
                for (int d0 = 0; d0 < HD / 32; ++d0)
#pragma unroll
                    for (int kk = 0; kk < 4; ++kk) o[d0] = __builtin_amdgcn_mfma_f32_32x32x16_bf16(vfr[d0][kk], pf[kk], o[d0], 0, 0, 0);
            } else {
#pragma unroll
            for (int d0 = 0; d0 < HD / 32; ++d0)
#pragma unroll
                for (int kk = 0; kk < 4; ++kk) {
                    const bf16x8 vf = *(const LAS bf16x8*)(vb + d0 * 32 * VROW + kk * 32);
                    o[d0] = __builtin_amdgcn_mfma_f32_32x32x16_bf16(vf, pf[kk], o[d0], 0, 0, 0);
                } }
        }
        if (more) ATT_STORE(cur ^ 1);
        cur ^= 1;
    }
    float l_tot; { auto rr = __builtin_amdgcn_permlane32_swap(__float_as_uint(l_run), __float_as_uint(l_run), false, false); l_tot = __uint_as_float(rr[0]) + __uint_as_float(rr[1]); }
    const float inv = 1.0f / l_tot;
    gbf16* orow = Og + (size_t)(wid * 32 + r32) * o_pitch + 4 * hi;
#pragma unroll
    for (int d0 = 0; d0 < HD / 32; ++d0)
#pragma unroll
        for (int rq = 0; rq < 4; ++rq) { u32x2 w; w.x = pk2(o[d0][4 * rq] * inv, o[d0][4 * rq + 1] * inv); w.y = pk2(o[d0][4 * rq + 2] * inv, o[d0][4 * rq + 3] * inv);
            *(gu32x2*)(orow + 32 * d0 + 8 * rq) = w; }
#undef ATT_LOAD
#undef ATT_STORE
}

__device__ __forceinline__ void rms_row_bf16(const gfloat* src, const gfloat* gain, gbf16* dst, int lane) {
    const gf32x4* xr = (const gf32x4*)src + lane; const gf32x4* gr = (const gf32x4*)gain + lane;
    f32x4 v[4]; float s = 0.f;
#pragma unroll
    for (int j = 0; j < 4; ++j) { v[j] = xr[64 * j]; s += (v[j].x * v[j].x + v[j].y * v[j].y) + (v[j].z * v[j].z + v[j].w * v[j].w); }
    const float rstd = 1.0f / sqrtf(wave_sum(s) * (1.0f / DM) + EPS);
    gu32x2* o8 = (gu32x2*)dst + lane;
#pragma unroll
    for (int j = 0; j < 4; ++j) { const f32x4 g = gr[64 * j]; u32x2 w; w.x = pk2(v[j].x * rstd * g.x, v[j].y * rstd * g.y); w.y = pk2(v[j].z * rstd * g.z, v[j].w * rstd * g.w); o8[64 * j] = w; }
}
__device__ __forceinline__ void rms_row2_bf16(const gfloat* src0, const gfloat* src1, const gfloat* gain, gbf16* dst0, gbf16* dst1, int lane) {
    const gf32x4* x0 = (const gf32x4*)src0 + lane; const gf32x4* x1 = (const gf32x4*)src1 + lane; const gf32x4* gr = (const gf32x4*)gain + lane;
    f32x4 v[4], w[4], g[4]; float s = 0.f, t = 0.f;
#pragma unroll
    for (int j = 0; j < 4; ++j) { v[j] = x0[64 * j]; w[j] = x1[64 * j]; g[j] = gr[64 * j]; }
    asm volatile("" ::: "memory");
#pragma unroll
    for (int j = 0; j < 4; ++j) { s += (v[j].x * v[j].x + v[j].y * v[j].y) + (v[j].z * v[j].z + v[j].w * v[j].w); t += (w[j].x * w[j].x + w[j].y * w[j].y) + (w[j].z * w[j].z + w[j].w * w[j].w); }
#pragma unroll
    for (int o = 1; o < 64; o <<= 1) { s += __shfl_xor(s, o); t += __shfl_xor(t, o); }
    const float r0 = __builtin_amdgcn_rsqf(s * (1.0f / DM) + EPS), r1 = __builtin_amdgcn_rsqf(t * (1.0f / DM) + EPS);
    gu32x2* o0 = (gu32x2*)dst0 + lane; gu32x2* o1 = (gu32x2*)dst1 + lane;
#pragma unroll
    for (int j = 0; j < 4; ++j) { u32x2 a, b;
        a.x = pk2(v[j].x * r0 * g[j].x, v[j].y * r0 * g[j].y); a.y = pk2(v[j].z * r0 * g[j].z, v[j].w * r0 * g[j].w); o0[64 * j] = a;
        b.x = pk2(w[j].x * r1 * g[j].x, w[j].y * r1 * g[j].y); b.y = pk2(w[j].z * r1 * g[j].z, w[j].w * r1 * g[j].w); o1[64 * j] = b; }
}
__device__ __forceinline__ void final_row2(gfloat* p0, gfloat* p1, const gfloat* gain, float rs0, float rs1, int lane) {
    gf32x4* x0 = (gf32x4*)p0 + lane; gf32x4* x1 = (gf32x4*)p1 + lane; const gf32x4* gr = (const gf32x4*)gain + lane;
    f32x4 v[4], w[4];
#pragma unroll
    for (int j = 0; j < 4; ++j) { v[j] = x0[64 * j]; w[j] = x1[64 * j]; }
#pragma unroll
    for (int j = 0; j < 4; ++j) { const f32x4 g = gr[64 * j]; x0[64 * j] = v[j] * rs0 * g; x1[64 * j] = w[j] * rs1 * g; }
}
__device__ __forceinline__ float rstd_row(const gfloat* ssq, int row) { const f32x4 p = *(const gf32x4*)(ssq + (size_t)row * 4); return 1.0f / sqrtf(((p.x + p.y) + (p.z + p.w)) * (1.0f / DM) + EPS); }
__device__ __forceinline__ void final_row(gfloat* p, const gfloat* gain, float rstd, int lane) {
    gf32x4* xr = (gf32x4*)p + lane; const gf32x4* gr = (const gf32x4*)gain + lane;
    f32x4 v[4];
#pragma unroll
    for (int j = 0; j < 4; ++j) v[j] = xr[64 * j];
#pragma unroll
    for (int j = 0; j < 4; ++j) { const f32x4 g = gr[64 * j]; xr[64 * j] = v[j] * rstd * g; }
}
__device__ __forceinline__ void transpose_item(const gfloat* W, int K, int N, gbf16* WT, int mode, LAS float* scr, int item, int lane, const gfloat* gain = nullptr) {
    const int nblk = N / 32, kb = item / nblk, nb = item % nblk, k0 = 64 * kb, n0 = 32 * nb;
#pragma unroll 8
    for (int i = 0; i < 32; ++i) { const int kk = 2 * i + (lane >> 5); float w = W[(size_t)(k0 + kk) * N + n0 + (lane & 31)]; if (gain) w *= gain[k0 + kk]; scr[kk * 33 + (lane & 31)] = w; }
    asm volatile("s_waitcnt lgkmcnt(0)" ::: "memory");
    int r0 = n0;
    if (mode == 1) { const int half = n0 >= FF ? 1 : 0, np = n0 - FF * half; r0 = 256 * (np / 128) + 128 * half + (np % 128); }
    const int c = lane & 7;
#pragma unroll
    for (int j = 0; j < 4; ++j) { const int n = (lane >> 3) + 8 * j; const LAS float* s = scr + (8 * c) * 33 + n;
        u32x4 o; o.x = pk2(s[0 * 33], s[1 * 33]); o.y = pk2(s[2 * 33], s[3 * 33]); o.z = pk2(s[4 * 33], s[5 * 33]); o.w = pk2(s[6 * 33], s[7 * 33]);
        *(gu32x4*)(WT + (size_t)(r0 + n) * K + k0 + 8 * c) = o; }
    asm volatile("s_waitcnt lgkmcnt(0)" ::: "memory");
}
__device__ __forceinline__ void transpose64_bf16(const gbf16* src, size_t src_pitch, gbf16* dst, size_t dst_pitch, LAS unsigned short* scr, int lane) {
#pragma unroll
    for (int p = 0; p < 8; ++p) { const int row = 8 * p + (lane >> 3), ch = lane & 7; const u32x4 v = *(const gu32x4*)(src + (size_t)row * src_pitch + 8 * ch);
        LAS unsigned short* d = scr + row * 66 + 8 * ch;
        d[0] = (unsigned short)v.x; d[1] = (unsigned short)(v.x >> 16); d[2] = (unsigned short)v.y; d[3] = (unsigned short)(v.y >> 16);
        d[4] = (unsigned short)v.z; d[5] = (unsigned short)(v.z >> 16); d[6] = (unsigned short)v.w; d[7] = (unsigned short)(v.w >> 16); }
    asm volatile("s_waitcnt lgkmcnt(0)" ::: "memory");
#pragma unroll
    for (int p = 0; p < 8; ++p) { const int j = 8 * p + (lane >> 3), i0 = 8 * (lane & 7); const LAS unsigned short* s = scr + i0 * 66 + j;
        u32x4 o; o.x = (unsigned)s[0] | ((unsigned)s[66] << 16); o.y = (unsigned)s[2 * 66] | ((unsigned)s[3 * 66] << 16);
        o.z = (unsigned)s[4 * 66] | ((unsigned)s[5 * 66] << 16); o.w = (unsigned)s[6 * 66] | ((unsigned)s[7 * 66] << 16);
        *(gu32x4*)(dst + (size_t)j * dst_pitch + i0) = o; }
    asm volatile("s_waitcnt lgkmcnt(0)" ::: "memory");
}
__device__ __forceinline__ void sincos_d(double a, float& sn, float& cs) {
    const double k = rint(a * 0.63661977236758134308);
    const double r = (a - k * 1.57079632679489655800) - k * 6.123233995736766036e-17;
    const double r2 = r * r;
    const double s = r * (1.0 + r2 * (-1.0 / 6 + r2 * (1.0 / 120 + r2 * (-1.0 / 5040 + r2 * (1.0 / 362880 + r2 * (-1.0 / 39916800 + r2 * (1.0 / 6227020800.0)))))));
    const double c = 1.0 + r2 * (-0.5 + r2 * (1.0 / 24 + r2 * (-1.0 / 720 + r2 * (1.0 / 40320 + r2 * (-1.0 / 3628800 + r2 * (1.0 / 479001600.0 + r2 * (-1.0 / 87178291200.0)))))));
    const int q = ((int)k) & 3;
    const double ss = (q == 0) ? s : (q == 1) ? c : (q == 2) ? -s : -c;
    const double cc = (q == 0) ? c : (q == 1) ? -s : (q == 2) ? -c : s;
    sn = (float)ss; cs = (float)cc;
}

#define XB_TMO      128
#define XB_XCNT(j)  (256  + 64 * (j))
#define XB_XSUB(j)  (1280 + 64 * (j))
#define XB_XGEN(j)  (2304 + 64 * (j))
#define XB_TOP      3328
#define XB_TOPGEN   3392
#define XCD_BAR_WORDS 3456
#define XB_SPIN_CAP (1u << 18)

__device__ __forceinline__ unsigned xb_ld(unsigned* p)              { return __hip_atomic_load(p, __ATOMIC_RELAXED, __HIP_MEMORY_SCOPE_AGENT); }
__device__ __forceinline__ unsigned xb_add(unsigned* p, unsigned v) { return __hip_atomic_fetch_add(p, v, __ATOMIC_RELAXED, __HIP_MEMORY_SCOPE_AGENT); }
__device__ __forceinline__ unsigned xb_xcc_id() { return (unsigned)__builtin_amdgcn_s_getreg((3 << 11) | 20) & 0xFu; }
#define XB_SPIN(cond, bar) do { unsigned _sp = 0; while (cond) { __builtin_amdgcn_s_sleep(1); \
    if ((++_sp & 255u) == 0u) { if (xb_ld(&(bar)[XB_TMO])) break; if (_sp > XB_SPIN_CAP) { atomicAdd(&(bar)[XB_TMO], 1u); break; } } } } while (0)

struct XcdBarrier {
    unsigned* bar; unsigned x;
    volatile LAS unsigned* st;
};

__device__ __forceinline__ XcdBarrier xcd_barrier_post(unsigned* bar, volatile LAS unsigned* st) {
    XcdBarrier b; b.bar = bar; b.x = xb_xcc_id(); b.st = st;
    if (threadIdx.x == 0) (void)xb_add(&bar[XB_XCNT(b.x)], 1u);
    return b;
}
__device__ __forceinline__ void xcd_barrier_complete(unsigned* bar, unsigned x, unsigned& nloc, unsigned& nx) {
    const unsigned G = gridDim.x * gridDim.y * gridDim.z;
    unsigned sum, cnt, mine, sp = 0u;
    for (;;) {
        sum = 0u; cnt = 0u; mine = 0u;
#pragma unroll
        for (unsigned j = 0; j < 16; ++j) { const unsigned c = xb_ld(&bar[XB_XCNT(j)]); sum += c; cnt += (c > 0u) ? 1u : 0u; mine = (j == x) ? c : mine; }
        if (sum == G) break;
        __builtin_amdgcn_s_sleep(1);
        if ((++sp & 255u) == 0u) { if (xb_ld(&bar[XB_TMO])) break; if (sp > XB_SPIN_CAP) { atomicAdd(&bar[XB_TMO], 1u); break; } }
    }
    nloc = mine > 0u ? mine : 1u; nx = cnt > 0u ? cnt : 1u;
}

__device__ __forceinline__ void xcd_barrier(const XcdBarrier& b) {
    asm volatile("s_waitcnt vmcnt(0)" ::: "memory");
    __syncthreads();
    if (threadIdx.x == 0) {
        unsigned* bar = b.bar; const unsigned bx_ = xb_xcc_id();
        __builtin_amdgcn_s_waitcnt(0);
        unsigned nloc = b.st[0], nx = b.st[1];
        if (nloc == 0u) { xcd_barrier_complete(bar, bx_, nloc, nx); b.st[0] = nloc; b.st[1] = nx; }
        const unsigned old = xb_add(&bar[XB_XSUB(bx_)], 1u);
        const unsigned gen = old / nloc;
        if (old + 1u == (gen + 1u) * nloc) {
            __builtin_amdgcn_fence(__ATOMIC_RELEASE, "agent");
            asm volatile("s_waitcnt vmcnt(0)" ::: "memory");
            const unsigned og = xb_add(&bar[XB_TOP], 1u);
            const unsigned tg = og / nx;
            if (og + 1u == (tg + 1u) * nx) xb_add(&bar[XB_TOPGEN], 1u);
            else XB_SPIN(xb_ld(&bar[XB_TOPGEN]) == tg, bar);
            __builtin_amdgcn_fence(__ATOMIC_ACQUIRE, "agent");
            xb_add(&bar[XB_XGEN(bx_)], 1u);
            asm volatile("s_waitcnt vmcnt(0)" ::: "memory");
        } else {
            XB_SPIN(xb_ld(&bar[XB_XGEN(bx_)]) == gen, bar);
            __builtin_amdgcn_fence(__ATOMIC_ACQUIRE, "agent");
            asm volatile("s_waitcnt vmcnt(0)" ::: "memory");
        }
    }
    __syncthreads();
}


#define XL_SUB(j)  (4096 + 64 * (j))
#define XL_GEN(j)  (5120 + 64 * (j))
#define XL_RANK(j) (6144 + 64 * (j))
#define XL_BAD     7168
__device__ __forceinline__ void xcd_local_barrier(const XcdBarrier& b) {
    asm volatile("s_waitcnt vmcnt(0)" ::: "memory");
    __syncthreads();
    if (threadIdx.x == 0) {
        unsigned* bar = b.bar; const unsigned x_ = xb_xcc_id();
        __builtin_amdgcn_s_waitcnt(0);
        const unsigned nloc = b.st[0], k_ = b.st[5]; b.st[5] = k_ + 1u;
        const unsigned target = (k_ + 1u) * nloc;
        (void)__hip_atomic_fetch_add(&bar[XL_SUB(x_)], 1u, __ATOMIC_RELAXED, __HIP_MEMORY_SCOPE_AGENT);
        XB_SPIN(xb_ld(&bar[XL_SUB(x_)]) < target, bar);
        __builtin_amdgcn_fence(__ATOMIC_ACQUIRE, "agent");
        asm volatile("s_waitcnt vmcnt(0)" ::: "memory");
    }
    __syncthreads();
}

struct Args { const float* in[23]; float* out; unsigned char* ws; int ph_lo, ph_hi; };
enum { I_XP = 0, I_XS, I_MP, I_MS, I_RELB, I_NFF1, I_FF1I, I_FF1O, I_NMIX, I_WIN, I_QN, I_KN, I_SINK, I_NMEM, I_WMEM, I_BRA, I_BRB, I_BRC, I_WOUT, I_NFF2, I_FF2I, I_FF2O, I_NFIN };
constexpr int N_PRO = 3, N_PER = 10, N_STEPS = N_PRO + N_PER * NCH + 1;

constexpr int LDS_XB = 136192 + 256;
constexpr int LDS_PTRS = 136192;
__device__ __forceinline__ const gfloat* ldsptr(LAS unsigned char* lds, int i) {
    const unsigned long long v = ((const LAS unsigned long long*)(lds + LDS_PTRS))[i];
    const unsigned lo = __builtin_amdgcn_readfirstlane((unsigned)v), hi = __builtin_amdgcn_readfirstlane((unsigned)(v >> 32));
    return (const gfloat*)(((unsigned long long)hi << 32) | lo);
}
#define INP(i) ldsptr(lds, (i))
__global__ void __launch_bounds__(512, 2) mega_fwd(Args a) {
    extern __shared__ __attribute__((aligned(16))) unsigned char lds_raw[];
    LAS unsigned char* lds = (LAS unsigned char*)lds_raw;
    cg::grid_group grid = cg::this_grid();
    if (threadIdx.x < 23) ((LAS unsigned long long*)(lds + LDS_PTRS))[threadIdx.x] = (unsigned long long)a.in[threadIdx.x];
    if (threadIdx.x == 23) ((LAS unsigned long long*)(lds + LDS_PTRS))[23] = (unsigned long long)a.out;
    if (threadIdx.x == 24) ((LAS unsigned long long*)(lds + LDS_PTRS))[24] = (unsigned long long)a.ws;
    if (threadIdx.x == 25) { ((volatile LAS unsigned*)(lds + LDS_XB))[0] = 0u; ((volatile LAS unsigned*)(lds + LDS_XB))[1] = 0u; }
    __syncthreads();
    const XcdBarrier xbar = xcd_barrier_post((unsigned*)(a.ws + WS_BAR), (volatile LAS unsigned*)(lds + LDS_XB));
    if (threadIdx.x == 0) { const unsigned x_ = xb_xcc_id(); ((volatile LAS unsigned*)(lds + LDS_XB))[2] = x_; ((volatile LAS unsigned*)(lds + LDS_XB))[3] = xb_add((unsigned*)(a.ws + WS_BAR) + XL_RANK(x_), 1u); ((volatile LAS unsigned*)(lds + LDS_XB))[4] = 0u; ((volatile LAS unsigned*)(lds + LDS_XB))[5] = 0u; }
    __syncthreads();
    const int wave_s = __builtin_amdgcn_readfirstlane((int)threadIdx.x >> 6);
#define STEP_LOCALS \
        int tid = wave_s * 64 + (int)__builtin_amdgcn_mbcnt_hi(~0u, __builtin_amdgcn_mbcnt_lo(~0u, 0u)); asm volatile("" : "+v"(tid)); \
        const int lane = tid & 63, wave = __builtin_amdgcn_readfirstlane(tid >> 6); \
        const int G = gridDim.x, bx = blockIdx.x; \
        const int vcu = (G % 8 == 0) ? (bx % 8) * (G / 8) + bx / 8 : bx; \
        const int gw = vcu * 8 + wave, NGW = G * 8; \
        guchar* ws = (guchar*)INP(24); \
        gfloat* const outp = (gfloat*)INP(23); \
        gbf16* const W_ff1i = (gbf16*)(ws + WS_WFF1I); gbf16* const W_ff1o = (gbf16*)(ws + WS_WFF1O); gbf16* const W_in = (gbf16*)(ws + WS_WIN); \
        gbf16* const W_mem = (gbf16*)(ws + WS_WMEM); gbf16* const W_br = (gbf16*)(ws + WS_WBR); gbf16* const W_out = (gbf16*)(ws + WS_WOUT); \
        gbf16* const W_ff2i = (gbf16*)(ws + WS_WFF2I); gbf16* const W_ff2o = (gbf16*)(ws + WS_WFF2O); \
        gbf16* const memn = (gbf16*)(ws + WS_MEMN); gbf16* const kvm = (gbf16*)(ws + WS_KVM); gbf16* const vtc = (gbf16*)(ws + WS_VTC); \
        gf32x2* const rope = (gf32x2*)(ws + WS_ROPE); gfloat* const biast = (gfloat*)(ws + WS_BIAS); \
        gbf16* const xn = (gbf16*)(ws + WS_XN); gbf16* const hid = (gbf16*)(ws + WS_HID); gbf16* const proj = (gbf16*)(ws + WS_PROJ); \
        gbf16* const vta = (gbf16*)(ws + WS_VTA); gbf16* const vtb = (gbf16*)(ws + WS_VTB); gbf16* const yb3 = (gbf16*)(ws + WS_Y); \
        gbf16* const part = (gbf16*)(ws + WS_PART); gbf16* const mrg = (gbf16*)(ws + WS_MRG); gfloat* const ssq = (gfloat*)(ws + WS_SSQ);
    if (PH_EN(0)) { STEP_LOCALS
            LAS float* scr = (LAS float*)(lds + wave * 16384);
            constexpr int I_FI = (DM / 64) * (2 * FF / 32), I_FO = (FF / 64) * (DM / 32), I_IN = (DM / 64) * (PROJ / 32), I_SQ = (DM / 64) * (DM / 32), I_BR = (512 / 64) * (DM / 32);
            constexpr int NITEMS = 2 * I_FI + 2 * I_FO + I_IN + 2 * I_SQ + 3 * I_BR;
            for (int it = gw; it < NITEMS; it += NGW) {
                int r = it;
                if (r < I_FI) { transpose_item(INP(I_FF1I), DM, 2 * FF, W_ff1i, 1, scr, r, lane); continue; } r -= I_FI;
                if (r < I_FI) { transpose_item(INP(I_FF2I), DM, 2 * FF, W_ff2i, 1, scr, r, lane, INP(I_NFF2)); continue; } r -= I_FI;
                if (r < I_FO) { transpose_item(INP(I_FF1O), FF, DM, W_ff1o, 0, scr, r, lane); continue; } r -= I_FO;
                if (r < I_FO) { transpose_item(INP(I_FF2O), FF, DM, W_ff2o, 0, scr, r, lane); continue; } r -= I_FO;
                if (r < I_IN) { transpose_item(INP(I_WIN), DM, PROJ, W_in, 0, scr, r, lane, INP(I_NMIX)); continue; } r -= I_IN;
                if (r < I_SQ) { transpose_item(INP(I_WMEM), DM, DM, W_mem, 0, scr, r, lane); continue; } r -= I_SQ;
                if (r < I_SQ) { transpose_item(INP(I_WOUT), DM, DM, W_out, 0, scr, r, lane); continue; } r -= I_SQ;
                if (r < I_BR) { transpose_item(INP(I_BRA), 512, DM, W_br, 0, scr, r, lane); continue; } r -= I_BR;
                if (r < I_BR) { transpose_item(INP(I_BRB), 512, DM, W_br + (size_t)DM * 512, 0, scr, r, lane); continue; } r -= I_BR;
                transpose_item(INP(I_BRC), 512, DM, W_br + (size_t)2 * DM * 512, 0, scr, r, lane);
            }
            const gfloat* mp_p = INP(I_MP); const gfloat* ms_p = INP(I_MS); const gfloat* nmem_p = INP(I_NMEM);
            for (int m = gw; m < NMEM; m += NGW) {
                const gfloat* src = (m < 2048) ? mp_p + (size_t)m * DM : ms_p + (size_t)(m - 2048) * DM;
                rms_row_bf16(src, nmem_p, memn + (size_t)m * DM, lane);
            }
            for (int i = vcu * 512 + tid; i < 2048; i += G * 512) {
                const int n = i >> 4, j = i & 15;
                const int jl = j & 3, jh = j >> 2;
                const float b = (jl == 0) ? 1.0f : (jl == 1) ? 0.5623413251903491f : (jl == 2) ? 0.31622776601683794f : 0.1778279410038923f;
                const float s = (jh == 0) ? 1.0f : (jh == 1) ? 0.1f : (jh == 2) ? 0.01f : 0.001f;
                const float inv = b * s;
                const float ang = (float)n * inv;
                float sn, cs; sincos_d((double)ang, sn, cs);
                rope[i] = (f32x2){cs, sn};
            }
            const gfloat* relb_p = INP(I_RELB);
            for (int i = vcu * 512 + tid; i < 8 * 768; i += G * 512) {
                const int h = i / 768, rel = (i % 768) - 384;
                if (rel < -128 || rel > 128) { biast[i] = -1e30f; continue; }
                const int n = rel < 0 ? -rel : rel;
                int large = 33 - __clz(n * n > 0 ? n * n : 1); if (large > 15) large = 15;
                const int bucket = (rel > 0 ? 16 : 0) + (n < 8 ? n : large);
                biast[i] = relb_p[bucket * 8 + h] * LOG2E;
            }
    }
    grid.sync();
    if (PH_EN(1)) { STEP_LOCALS
            pg8::Gemm g{memn, W_mem, NMEM, DM, DM, 0, 0}; pg8::StaticOrder S; S.init(NMEM, DM, G, bx);
            pg8::EpiPlain E{kvm, DM};
            pg8::gemm_phase(lds, tid, g, S, E);
    }
    xcd_barrier(xbar);
    if (threadIdx.x == 0) { volatile LAS unsigned* w_ = (volatile LAS unsigned*)(lds + LDS_XB);
        if (w_[0] * 8u != gridDim.x || w_[1] != 8u || w_[2] >= 8u || w_[3] >= gridDim.x / 8u) __hip_atomic_store((unsigned*)(a.ws + WS_BAR) + XL_BAD, 1u, __ATOMIC_RELAXED, __HIP_MEMORY_SCOPE_AGENT); }
    if (PH_EN(2)) { STEP_LOCALS
            LAS unsigned short* scr = (LAS unsigned short*)(lds + wave * 16384);
            for (int it = gw; it < 40 * 4 * 4 * 2; it += NGW) {
                const int db = it & 1, h = (it >> 1) & 3, mb = (it >> 3) & 3, seq = it >> 5;
                transpose64_bf16(kvm + (size_t)(seq * 256 + 64 * mb) * DM + 512 + 128 * h + 64 * db, DM,
                                 vtc + ((size_t)(seq * 4 + h) * 128 + 64 * db) * 256 + 64 * mb, 256, scr, lane);
            }
    }
    xcd_barrier(xbar);
    if (threadIdx.x == 0) ((volatile LAS unsigned*)(lds + LDS_XB))[4] = (__hip_atomic_load((unsigned*)(a.ws + WS_BAR) + XL_BAD, __ATOMIC_RELAXED, __HIP_MEMORY_SCOPE_AGENT) == 0u) ? 1u : 0u;
    __syncthreads();
    constexpr int NS = N_PER * NCH;
    for (int step2 = 0; step2 < 2 * NS; ++step2) {
        const int step = step2 >> 1;
        const bool dup_ = ((PH_DUP >> (step % N_PER)) & 1);
        if ((step2 & 1) && !dup_) continue;
        STEP_LOCALS
        const int xl_good = __builtin_amdgcn_readfirstlane((int)((volatile LAS unsigned*)(lds + LDS_XB))[4]);
        const int xl_x = __builtin_amdgcn_readfirstlane((int)((volatile LAS unsigned*)(lds + LDS_XB))[2]), xl_r = __builtin_amdgcn_readfirstlane((int)((volatile LAS unsigned*)(lds + LDS_XB))[3]);
        const int cx = xl_good ? (xl_x + 8 * xl_r) : bx;
        {
            const int c = step / N_PER, k = step % N_PER;
            const bool prompt = c < NCH_P;
#define XIN() (INP(prompt ? I_XP : I_XS) + (size_t)(prompt ? c : c - NCH_P) * CH * DM)
#define HOUT() ((gfloat*)INP(23) + (size_t)c * CH * DM)
            const int S_ = prompt ? 8192 : 2048, nseq = CH / S_, NQB = S_ / 256;
            const int memseq0 = prompt ? (CH / 8192) * c : 8 + (CH / 2048) * (c - NCH_P);
            gfloat* const ssq1 = ssq; gfloat* const ssq2 = ssq + CH * 4; gfloat* const ssq3 = ssq + 2 * CH * 4;
            if (PH_EN(3) && k == 0) {
                const gfloat* gain = INP(I_NFF1);
                const gfloat* xin_ = XIN();
                if (xl_good && (CH / 8) % (2 * G) == 0) {
                    const int m0 = (CH / 8) * xl_x + xl_r * 8 + wave;
                    for (int i0 = 0; i0 < CH / 8; i0 += 2 * G) { const size_t ra = (size_t)(m0 + i0) * DM, rb = (size_t)(m0 + i0 + G) * DM; rms_row2_bf16(xin_ + ra, xin_ + rb, gain, xn + ra, xn + rb, lane); }
                } else
                for (int m = gw; m < CH; m += 2 * NGW) { const int m1 = (m + NGW < CH) ? m + NGW : m; rms_row2_bf16(xin_ + (size_t)m * DM, xin_ + (size_t)m1 * DM, gain, xn + (size_t)m * DM, xn + (size_t)m1 * DM, lane); }
            } else if (PH_EN(4) && k == 1) {
                pg8::Gemm g{xn, W_ff1i, CH, 2 * FF, DM, 0, 0}; pg8::StaticOrder S; S.init(CH, 2 * FF, G, cx);
                pg8::EpiSwiglu E{hid};
                pg8::gemm_phase(lds, tid, g, S, E);
            } else if (PH_EN(5) && k == 2) {
                pg8::Gemm g{hid, W_ff1o, CH, DM, FF, 0, 0}; pg8::StaticOrder S; S.init(CH, DM, G, cx);
                pg8::EpiResidStats<false> E{XIN(), nullptr, xn, ssq1, 0.5f};
                pg8::gemm_phase(lds, tid, g, S, E);
            } else if (PH_EN(5) && k == 9) {
                pg8::Gemm g{hid, W_ff2o, CH, DM, FF, 0, 0}; pg8::StaticOrder S; S.init(CH, DM, G, cx);
                pg8::EpiResidFinal E{xn, HOUT(), ssq3, (unsigned*)(ws + WS_CNT), INP(I_NFIN), 0.5f, 4u * (unsigned)(c + 1)};
                pg8::gemm_phase(lds, tid, g, S, E);
            } else if (PH_EN(6) && k == 3) {
                pg8::Gemm g{xn, W_in, CH, PROJ, DM, 0, 0}; pg8::StaticOrder S; S.init(CH, PROJ, G, cx);
                pg8::EpiPlainRstd E{proj, PROJ, ssq1, 1};
                pg8::gemm_phase(lds, tid, g, S, E);
            } else if (PH_EN(7) && k == 4) {
                const gfloat* qn_p = INP(I_QN); const gfloat* kn_p = INP(I_KN);
                for (int wi = gw; wi < CH * 2 / 8; wi += 2 * NGW) {
                    const int sub = lane & 7;
                    gbf16* pp[2]; u32x4 vv[2]; int posv[2], hhv[2];
#pragma unroll
                    for (int q = 0; q < 2; ++q) { const int item = (wi + q * NGW) * 8 + (lane >> 3); const int tok = item / 2, hh = 8 + (item & 1);
                        pp[q] = proj + (size_t)tok * PROJ + 64 * hh + 8 * sub; vv[q] = *(const gu32x4*)pp[q]; posv[q] = tok % S_; hhv[q] = hh; }
#pragma unroll
                    for (int q = 0; q < 2; ++q) {
                        const u32x4 v = vv[q]; const int hh = hhv[q], pos = posv[q];
                        float x[8] = {bflo(v.x), bfhi(v.x), bflo(v.y), bfhi(v.y), bflo(v.z), bfhi(v.z), bflo(v.w), bfhi(v.w)};
                        float ss = 0.f;
#pragma unroll
                        for (int e = 0; e < 8; ++e) ss += x[e] * x[e];
                        ss += __shfl_xor(ss, 1); ss += __shfl_xor(ss, 2); ss += __shfl_xor(ss, 4);
                        const float rstd = (1.0f / sqrtf(ss * (1.0f / 64) + EPS)) * ((hh < 8) ? 0.125f * LOG2E : 1.0f);
                        const gfloat* gn = ((hh < 8) ? qn_p : kn_p) + 8 * sub;
                        const f32x4 g0 = *(const gf32x4*)gn, g1 = *(const gf32x4*)(gn + 4);
                        x[0] *= rstd * g0.x; x[1] *= rstd * g0.y; x[2] *= rstd * g0.z; x[3] *= rstd * g0.w;
                        x[4] *= rstd * g1.x; x[5] *= rstd * g1.y; x[6] *= rstd * g1.z; x[7] *= rstd * g1.w;
                        const int nidx = (sub < 4) ? (pos >> 6) : (pos & 63);
                        const gf32x4* rt = (const gf32x4*)(rope + nidx * 16 + 4 * (sub & 3));
                        const f32x4 c01 = rt[0], c23 = rt[1];
                        float y[8];
                        y[0] = x[0] * c01.x - x[1] * c01.y; y[1] = x[0] * c01.y + x[1] * c01.x;
                        y[2] = x[2] * c01.z - x[3] * c01.w; y[3] = x[2] * c01.w + x[3] * c01.z;
                        y[4] = x[4] * c23.x - x[5] * c23.y; y[5] = x[4] * c23.y + x[5] * c23.x;
                        y[6] = x[6] * c23.z - x[7] * c23.w; y[7] = x[6] * c23.w + x[7] * c23.z;
                        u32x4 w; w.x = pk2(y[0], y[1]); w.y = pk2(y[2], y[3]); w.z = pk2(y[4], y[5]); w.w = pk2(y[6], y[7]);
                        *(gu32x4*)pp[q] = w;
                    }
                }
                LAS unsigned short* scr = (LAS unsigned short*)(lds + wave * 16384);
                for (int it = gw; it < (CH / 64) * 4; it += NGW) {
                    const int kvh = it & 1, which = (it >> 1) & 1, tt = it >> 2;
                    const int tok = 64 * tt, seq = tok / S_, pos = tok % S_;
                    transpose64_bf16(proj + (size_t)tok * PROJ + (which ? 1408 : 640) + 64 * kvh, PROJ,
                                     (which ? vtb : vta) + ((size_t)(seq * 2 + kvh) * 64) * S_ + pos, S_, scr, lane);
                }
            } else if (PH_EN(8) && k == 5) {
                const gfloat* qn_att = INP(I_QN);
                for (int u = vcu; ATT_EN(0) && u < (CH / 256) * 8; u += G) {
                    const int qb = u % NQB, g4 = (u / NQB) % 4, kvh = (u / NQB / 4) % 2, seq = u / (NQB * 8), head = kvh * 4 + g4;
                    const size_t tokq = (size_t)seq * S_ + (size_t)qb * 256;
                    attn_unit<64, 0>(lds, tid, proj + tokq * PROJ + 64 * head, PROJ, proj + (size_t)seq * S_ * PROJ + 512 + 64 * kvh, PROJ,
                                     vta + ((size_t)(seq * 2 + kvh) * 64) * S_, S_, yb3 + tokq * 512 + 64 * head, 512, 0, S_ / 64,
                                     0.125f * LOG2E, qb * 256, nullptr, -1e30f, 0.f, qn_att, rope);
                }
                for (int u = vcu; ATT_EN(1) && u < (CH / 256) * 8; u += G) {
                    const int qb = u % NQB, g4 = (u / NQB) % 4, kvh = (u / NQB / 4) % 2, seq = u / (NQB * 8), head = kvh * 4 + g4;
                    const size_t tokq = (size_t)seq * S_ + (size_t)qb * 256;
                    const int q0 = qb * 256;
                    const int t0 = (q0 >= 128) ? (q0 - 128) / 64 : 0, t1 = min(S_, q0 + 384) / 64;
                    attn_unit_np<64, 1>(lds, tid, proj + tokq * PROJ + 768 + 64 * head, PROJ, proj + (size_t)seq * S_ * PROJ + 1280 + 64 * kvh, PROJ,
                                     vtb + ((size_t)(seq * 2 + kvh) * 64) * S_, S_, yb3 + (size_t)CH * 512 + tokq * 512 + 64 * head, 512, t0, t1,
                                     0.125f * LOG2E, q0, biast + head * 768, INP(I_SINK)[head] * LOG2E, 1.0f);
                }
                for (int u = vcu; ATT_EN(2) && u < (CH / 256) * 4; u += G) {
                    const int qb = u % NQB, h = (u / NQB) % 4, seq = u / (NQB * 4);
                    const size_t tokq = (size_t)seq * S_ + (size_t)qb * 256;
                    const int ms = memseq0 + seq;
                    attn_unit_np<128, 0>(lds, tid, proj + tokq * PROJ + 1536 + 128 * h, PROJ, kvm + (size_t)ms * 256 * DM + 128 * h, DM,
                                      vtc + ((size_t)(ms * 4 + h) * 128) * 256, 256, yb3 + (size_t)2 * CH * 512 + tokq * 512 + 128 * h, 512, 0, 4,
                                      0.08838834764831845f * LOG2E, 0, nullptr, -1e30f, 0.f);
                }
                __syncthreads();
            } else if (PH_EN(9) && k == 6) {
                pg8::Gemm g{yb3, W_br, CH, DM, 512, (size_t)CH * 512 * 2, (size_t)DM * 512 * 2}; pg8::BranchOrder S; S.b.init(CH, DM, G, cx);
                pg8::EpiGate E{proj, part, mrg};
                pg8::gemm_phase(lds, tid, g, S, E);
            } else if (PH_EN(10) && k == 7) {
                pg8::Gemm g{mrg, W_out, CH, DM, DM, 0, 0}; pg8::StaticOrder S; S.init(CH, DM, G, cx);
                pg8::EpiResidStats<true> E{nullptr, xn, xn, ssq2, 1.0f};
                pg8::gemm_phase(lds, tid, g, S, E);
            } else if (PH_EN(11) && k == 8) {
                pg8::Gemm g{xn, W_ff2i, CH, 2 * FF, DM, 0, 0}; pg8::StaticOrder S; S.init(CH, 2 * FF, G, cx);
                pg8::EpiSwigluRstd E{hid, ssq2};
                pg8::gemm_phase(lds, tid, g, S, E);
            }
        }
        if ((step2 & 1) || !dup_) {
            if (step + 1 < NS) { const int k_ = step % N_PER;
                if (xl_good && PH_DUP == 0 && (k_ <= 2 || k_ >= 6)) xcd_local_barrier(xbar);
                else xcd_barrier(xbar); }
        } else xcd_barrier(xbar);
    }
}

extern "C" void kernel_launch(void* const* d_in, const int* in_sizes, int n_in, void* d_out, int out_size, void* d_ws, size_t ws_size, hipStream_t stream) {
    static int grid = 0;
    if (grid == 0) {
        if (n_in != 23 || ws_size < WS_END) { fprintf(stderr, "kernel_launch: unexpected n_in %d or ws_size %zu (need %zu)\n", n_in, ws_size, (size_t)WS_END); grid = -1; return; }
        int dev = 0, cus = 0, per_cu = 0;
        hipGetDevice(&dev);
        hipDeviceGetAttribute(&cus, hipDeviceAttributeMultiprocessorCount, dev);
        if (hipFuncSetAttribute((const void*)mega_fwd, hipFuncAttributeMaxDynamicSharedMemorySize, LDS_BYTES) != hipSuccess) { fprintf(stderr, "kernel_launch: hipFuncSetAttribute failed\n"); }
        if (hipOccupancyMaxActiveBlocksPerMultiprocessor(&per_cu, (const void*)mega_fwd, 512, LDS_BYTES) != hipSuccess || per_cu < 1) { fprintf(stderr, "kernel_launch: occupancy query gave %d\n", per_cu); per_cu = 1; }
        (void)hipGetLastError();
        grid = cus * 1;
        fprintf(stderr, "kernel_launch: cus %d per_cu %d grid %d ws %zu\n", cus, per_cu, grid, ws_size);
    }
    if (grid < 0) return;
    Args a{};
    for (int i = 0; i < 23; ++i) a.in[i] = (const float*)d_in[i];
    a.out = (float*)d_out; a.ws = (unsigned char*)d_ws;
    a.ph_lo = 0; a.ph_hi = 0;
    if (hipMemsetAsync((char*)d_ws + WS_BAR, 0, 32768 + 32768, stream) != hipSuccess) { fprintf(stderr, "kernel_launch: hipMemsetAsync failed\n"); return; }
    void* args[] = {&a};
    hipError_t e = hipLaunchCooperativeKernel((const void*)mega_fwd, dim3(grid), dim3(512), args, LDS_BYTES, stream);
    if (e != hipSuccess) fprintf(stderr, "cooperative launch failed: %s (grid %d)\n", hipGetErrorString(e), grid);
}
```

```cpp
#include <hip/hip_runtime.h>
#include <hip/hip_cooperative_groups.h>
#include <cstdio>
#include <cstdint>
namespace cg = cooperative_groups;

#ifndef MK_MULTI_LAUNCH
#define MK_MULTI_LAUNCH 0
#endif

#ifndef PH_MASK
#define PH_MASK 0xFFFF
#endif
#define PH_EN(i) ((PH_MASK >> (i)) & 1)
#ifndef ATT_MASK
#define ATT_MASK 7
#endif
#define ATT_EN(i) ((ATT_MASK >> (i)) & 1)
#ifndef PH_DUP
#define PH_DUP 0
#endif
#define LAS __attribute__((address_space(3)))
typedef unsigned short bf16_t;
typedef short bf16x8 __attribute__((ext_vector_type(8)));
typedef float f32x4 __attribute__((ext_vector_type(4)));
typedef float f32x2 __attribute__((ext_vector_type(2)));
typedef float f32x16 __attribute__((ext_vector_type(16)));
typedef unsigned u32x4 __attribute__((ext_vector_type(4)));
typedef unsigned u32x2 __attribute__((ext_vector_type(2)));
typedef __bf16 bf16x2_t __attribute__((ext_vector_type(2)));
#define GAS __attribute__((address_space(1)))
typedef GAS float gfloat; typedef GAS bf16_t gbf16; typedef GAS f32x4 gf32x4; typedef GAS f32x2 gf32x2; typedef GAS u32x4 gu32x4; typedef GAS u32x2 gu32x2;
typedef GAS bf16x8 gbf16x8; typedef GAS unsigned char guchar; typedef GAS char gchar; typedef GAS unsigned gunsigned;

constexpr int DM = 1024, FF = 2816, PROJ = 5120, CH = 32768, NCH = 131072 / CH, NCH_P = NCH / 2;
constexpr int NMEM = 40 * 256;
constexpr float EPS = 1e-6f;
constexpr float LOG2E = 1.4426950408889634f;

constexpr size_t al(size_t x) { return (x + 4095) & ~(size_t)4095; }
constexpr size_t WS_WFF1I = 0;
constexpr size_t WS_WFF1O = WS_WFF1I + al((size_t)2 * FF * DM * 2);
constexpr size_t WS_WIN   = WS_WFF1O + al((size_t)DM * FF * 2);
constexpr size_t WS_WMEM  = WS_WIN + al((size_t)PROJ * DM * 2);
constexpr size_t WS_WBR   = WS_WMEM + al((size_t)DM * DM * 2);
constexpr size_t WS_WOUT  = WS_WBR + al((size_t)3 * DM * 512 * 2);
constexpr size_t WS_WFF2I = WS_WOUT + al((size_t)DM * DM * 2);
constexpr size_t WS_WFF2O = WS_WFF2I + al((size_t)2 * FF * DM * 2);
constexpr size_t WS_MEMN  = WS_WFF2O + al((size_t)DM * FF * 2);
constexpr size_t WS_KVM   = WS_MEMN + al((size_t)NMEM * DM * 2);
constexpr size_t WS_VTC   = WS_KVM + al((size_t)NMEM * DM * 2);
constexpr size_t WS_ROPE  = WS_VTC + al((size_t)NMEM * 512 * 2);
constexpr size_t WS_BIAS  = WS_ROPE + al((size_t)128 * 16 * 8);
constexpr size_t WS_XN    = WS_BIAS + al((size_t)8 * 768 * 4);
constexpr size_t WS_HID   = WS_XN + al((size_t)CH * DM * 2);
constexpr size_t WS_PROJ  = WS_HID + al((size_t)CH * FF * 2);
constexpr size_t WS_VTA   = WS_PROJ + al((size_t)CH * PROJ * 2);
constexpr size_t WS_VTB   = WS_VTA + al((size_t)CH * 128 * 2);
constexpr size_t WS_Y     = WS_VTB + al((size_t)CH * 128 * 2);
constexpr size_t WS_PART  = WS_Y + al((size_t)3 * CH * 512 * 2);
constexpr size_t WS_MRG   = WS_PART + al((size_t)CH * DM * 4);
constexpr size_t WS_SSQ   = WS_MRG + al((size_t)CH * DM * 2);
constexpr size_t WS_BAR   = WS_SSQ + al((size_t)3 * CH * 4 * 4);
constexpr size_t WS_CNT   = WS_BAR + 32768;
constexpr size_t WS_END   = WS_CNT + 32768;

constexpr int LDS_RED = 131072;
constexpr int LDS_BYTES = 138240;

__device__ __forceinline__ unsigned pk2(float lo, float hi) { f32x2 v = {lo, hi}; bf16x2_t b = __builtin_convertvector(v, bf16x2_t); return __builtin_bit_cast(unsigned, b); }
__device__ __forceinline__ float bflo(unsigned w) { return __uint_as_float(w << 16); }
__device__ __forceinline__ float bfhi(unsigned w) { return __uint_as_float(w & 0xffff0000u); }
__device__ __forceinline__ float wave_sum(float v) {
#pragma unroll
    for (int o = 1; o < 64; o <<= 1) v += __shfl_xor(v, o);
    return v;
}
__device__ __forceinline__ float sigmoidf_(float x) { return __builtin_amdgcn_rcpf(1.0f + __builtin_amdgcn_exp2f(-x * LOG2E)); }

namespace pg8 {
constexpr int BM = 256, BK = 64, HALF = 128, HTB = HALF * BK * 2, STAGE_BYTES = 8 * HTB, NXCD = 8, WGM = 8;
__host__ __device__ __forceinline__ int lds_byte(int r, int c) { const int st = (r >> 4) * 2 + (c >> 5), rr = r & 15, cc = c & 31, ob = rr * 64 + cc * 2; return st * 1024 + (ob ^ (((ob >> 9) & 1) << 5)); }
__host__ __device__ __forceinline__ void stage_rc(int b, int& R, int& C) { const int st = b / 1024, sb = b % 1024, swz = sb ^ (((sb >> 9) & 1) << 5); R = (st >> 1) * 16 + swz / 64; C = (st & 1) * 32 + (swz % 64) / 2; }
__host__ __device__ __forceinline__ int perm32(int rho) { const int n = rho >> 4, i = rho & 15; return 8 * (i >> 2) + 4 * n + (i & 3); }

struct Unit { int pm, pn, pz; };
struct Gemm { const gbf16* A; const gbf16* Bt; int M, N, K; size_t zA, zB; };

struct StaticOrder {
    int nM, nN, nwg, G, c;
    __device__ void init(int M, int N, int G_, int c_) { nM = M / BM; nN = N / BM; nwg = nM * nN; G = G_; c = c_; }
    __device__ bool next(int i, Unit& u) const {
        const long L = (long)i * G + c; if (L >= nwg) return false;
        int wgid = (int)L; { const int q = nwg / NXCD, r = nwg % NXCD, xcd = wgid % NXCD, off = wgid / NXCD; wgid = (xcd < r ? xcd * (q + 1) : r * (q + 1) + (xcd - r) * q) + off; }
        const int nig = WGM * nN, gid = wgid / nig, fm = gid * WGM, gsz = (nM - fm) < WGM ? (nM - fm) : WGM;
        u.pm = fm + ((wgid % nig) % gsz); u.pn = (wgid % nig) / gsz; u.pz = 0; return true;
    }
};
struct BranchOrder {
    StaticOrder b;
    __device__ bool next(int i, Unit& u) const { if (!b.next(i / 3, u)) return false; u.pz = i % 3; return true; }
};

struct EpiPlain {
    static constexpr bool PERM = true;
    gbf16* O; int ldc;
    __device__ __forceinline__ void operator()(const f32x4 (&acc)[2][2][4][2], const Unit& u, int wr, int wc, int fr, int fq, LAS unsigned char* lds, int tid) const {
        const int row0 = u.pm * BM + wr * 64 + fr, col0 = u.pn * BM + wc * 32 + 8 * fq;
#pragma unroll
        for (int ai = 0; ai < 2; ++ai)
#pragma unroll
            for (int m = 0; m < 4; ++m) { gbf16* rowp = O + (size_t)(row0 + ai * HALF + m * 16) * ldc + col0;
#pragma unroll
                for (int bj = 0; bj < 2; ++bj) { const f32x4 v0 = acc[ai][bj][m][0], v1 = acc[ai][bj][m][1];
                    u32x4 w; w.x = pk2(v0[0], v0[1]); w.y = pk2(v0[2], v0[3]); w.z = pk2(v1[0], v1[1]); w.w = pk2(v1[2], v1[3]);
                    *(gu32x4*)(rowp + bj * HALF) = w; } }
    }
};
struct EpiSwiglu {
    static constexpr bool PERM = true;
    gbf16* O;
    __device__ __forceinline__ void operator()(const f32x4 (&acc)[2][2][4][2], const Unit& u, int wr, int wc, int fr, int fq, LAS unsigned char* lds, int tid) const {
        const int row0 = u.pm * BM + wr * 64 + fr, col0 = u.pn * HALF + wc * 32 + 8 * fq;
#pragma unroll
        for (int ai = 0; ai < 2; ++ai)
#pragma unroll
            for (int m = 0; m < 4; ++m) { gbf16* rowp = O + (size_t)(row0 + ai * HALF + m * 16) * FF + col0;
                float h[8];
#pragma unroll
                for (int n = 0; n < 2; ++n)
#pragma unroll
                    for (int e = 0; e < 4; ++e) { const float g = acc[ai][0][m][n][e], uu = acc[ai][1][m][n][e]; h[n * 4 + e] = g * sigmoidf_(g) * uu; }
                u32x4 w; w.x = pk2(h[0], h[1]); w.y = pk2(h[2], h[3]); w.z = pk2(h[4], h[5]); w.w = pk2(h[6], h[7]);
                *(gu32x4*)rowp = w; }
    }
};
struct EpiGate {
    static constexpr bool PERM = true;
    const gbf16* proj; gbf16* part; gbf16* merged;
    __device__ __forceinline__ void operator()(const f32x4 (&acc)[2][2][4][2], const Unit& u, int wr, int wc, int fr, int fq, LAS unsigned char* lds, int tid) const {
        const int row0 = u.pm * BM + wr * 64 + fr, col0 = u.pn * BM + wc * 32 + 8 * fq;
        const int pz = u.pz;
        gbf16* dst = (pz == 2) ? merged : part;
#pragma unroll
        for (int ai = 0; ai < 2; ++ai) {
            u32x4 gv[4][2], pv[4][2];
#pragma unroll
            for (int m = 0; m < 4; ++m) { const size_t row = (size_t)(row0 + ai * HALF + m * 16);
#pragma unroll
                for (int bj = 0; bj < 2; ++bj) { const int col = col0 + bj * HALF;
                    gv[m][bj] = *(const gu32x4*)(proj + row * PROJ + 2048 + 1024 * pz + col);
                    if (pz != 0) pv[m][bj] = *(const gu32x4*)(part + row * DM + col); else pv[m][bj] = (u32x4){0u, 0u, 0u, 0u}; } }
            asm volatile("" ::: "memory");
#pragma unroll
            for (int m = 0; m < 4; ++m) { const size_t row = (size_t)(row0 + ai * HALF + m * 16);
#pragma unroll
                for (int bj = 0; bj < 2; ++bj) { const int col = col0 + bj * HALF; const u32x4 gw = gv[m][bj], pw = pv[m][bj];
                    f32x4 z0, z1;
                    z0[0] = sigmoidf_(bflo(gw.x)); z0[1] = sigmoidf_(bfhi(gw.x)); z0[2] = sigmoidf_(bflo(gw.y)); z0[3] = sigmoidf_(bfhi(gw.y));
                    z1[0] = sigmoidf_(bflo(gw.z)); z1[1] = sigmoidf_(bfhi(gw.z)); z1[2] = sigmoidf_(bflo(gw.w)); z1[3] = sigmoidf_(bfhi(gw.w));
                    const f32x4 q0 = {bflo(pw.x), bfhi(pw.x), bflo(pw.y), bfhi(pw.y)}, q1 = {bflo(pw.z), bfhi(pw.z), bflo(pw.w), bfhi(pw.w)};
                    z0 = z0 * acc[ai][bj][m][0] + q0; z1 = z1 * acc[ai][bj][m][1] + q1;
                    u32x4 w; w.x = pk2(z0[0], z0[1]); w.y = pk2(z0[2], z0[3]); w.z = pk2(z1[0], z1[1]); w.w = pk2(z1[2], z1[3]);
                    *(gu32x4*)(dst + row * DM + col) = w; } }
            asm volatile("" ::: "memory");
        }
    }
};


__device__ __forceinline__ float rstd_from(const gfloat* ssq, size_t row) { const f32x4 p = *(const gf32x4*)(ssq + row * 4); return 1.0f / sqrtf(((p.x + p.y) + (p.z + p.w)) * (1.0f / DM) + EPS); }
struct EpiPlainRstd {
    static constexpr bool PERM = true;
    gbf16* O; int ldc; const gfloat* ssq; int qscale;
    __device__ __forceinline__ void operator()(const f32x4 (&acc)[2][2][4][2], const Unit& u, int wr, int wc, int fr, int fq, LAS unsigned char* lds, int tid) const {
        const int row0 = u.pm * BM + wr * 64 + fr, col0 = u.pn * BM + wc * 32 + 8 * fq;
        const float tsc = !qscale ? 1.0f : (u.pn == 3 || u.pn == 4) ? 0.125f * LOG2E : (u.pn == 6 || u.pn == 7) ? 0.08838834764831845f * LOG2E : 1.0f;
        float rsv[2][4];
        { f32x4 pv_[2][4];
#pragma unroll
          for (int ai = 0; ai < 2; ++ai)
#pragma unroll
              for (int m = 0; m < 4; ++m) pv_[ai][m] = *(const gf32x4*)(ssq + (size_t)(row0 + ai * HALF + m * 16) * 4);
          asm volatile("" ::: "memory");
#pragma unroll
          for (int ai = 0; ai < 2; ++ai)
#pragma unroll
              for (int m = 0; m < 4; ++m) { const f32x4 p = pv_[ai][m]; rsv[ai][m] = __builtin_amdgcn_rsqf(((p.x + p.y) + (p.z + p.w)) * (1.0f / DM) + EPS) * tsc; } }
#pragma unroll
        for (int ai = 0; ai < 2; ++ai)
#pragma unroll
            for (int m = 0; m < 4; ++m) { const size_t row = (size_t)(row0 + ai * HALF + m * 16); const float rs = rsv[ai][m]; gbf16* rowp = O + row * ldc + col0;
#pragma unroll
                for (int bj = 0; bj < 2; ++bj) { const f32x4 v0 = acc[ai][bj][m][0] * rs, v1 = acc[ai][bj][m][1] * rs;
                    u32x4 w; w.x = pk2(v0[0], v0[1]); w.y = pk2(v0[2], v0[3]); w.z = pk2(v1[0], v1[1]); w.w = pk2(v1[2], v1[3]);
                    *(gu32x4*)(rowp + bj * HALF) = w; } }
    }
};
struct EpiSwigluRstd {
    static constexpr bool PERM = true;
    gbf16* O; const gfloat* ssq;
    __device__ __forceinline__ void operator()(const f32x4 (&acc)[2][2][4][2], const Unit& u, int wr, int wc, int fr, int fq, LAS unsigned char* lds, int tid) const {
        const int row0 = u.pm * BM + wr * 64 + fr, col0 = u.pn * HALF + wc * 32 + 8 * fq;
        float rsv[2][4];
        { f32x4 pv_[2][4];
#pragma unroll
          for (int ai = 0; ai < 2; ++ai)
#pragma unroll
              for (int m = 0; m < 4; ++m) pv_[ai][m] = *(const gf32x4*)(ssq + (size_t)(row0 + ai * HALF + m * 16) * 4);
          asm volatile("" ::: "memory");
#pragma unroll
          for (int ai = 0; ai < 2; ++ai)
#pragma unroll
              for (int m = 0; m < 4; ++m) { const f32x4 p = pv_[ai][m]; rsv[ai][m] = __builtin_amdgcn_rsqf(((p.x + p.y) + (p.z + p.w)) * (1.0f / DM) + EPS); } }
#pragma unroll
        for (int ai = 0; ai < 2; ++ai)
#pragma unroll
            for (int m = 0; m < 4; ++m) { const size_t row = (size_t)(row0 + ai * HALF + m * 16); const float rs = rsv[ai][m]; gbf16* rowp = O + row * FF + col0;
                float h[8];
#pragma unroll
                for (int n = 0; n < 2; ++n)
#pragma unroll
                    for (int e = 0; e < 4; ++e) { const float g = acc[ai][0][m][n][e] * rs, uu = acc[ai][1][m][n][e] * rs; h[n * 4 + e] = g * sigmoidf_(g) * uu; }
                u32x4 w; w.x = pk2(h[0], h[1]); w.y = pk2(h[2], h[3]); w.z = pk2(h[4], h[5]); w.w = pk2(h[6], h[7]);
                *(gu32x4*)rowp = w; }
    }
};
template <bool RES_BF16>
struct EpiResidStats {
    static constexpr bool PERM = true;
    const gfloat* resf; const gbf16* resb; gbf16* xb; gfloat* ssq; float scale;
    __device__ __forceinline__ void operator()(const f32x4 (&acc)[2][2][4][2], const Unit& u, int wr, int wc, int fr, int fq, LAS unsigned char* lds, int tid) const {
        const int row0 = u.pm * BM + wr * 64 + fr, col0 = u.pn * BM + wc * 32 + 8 * fq;
        LAS float* red = (LAS float*)(lds + LDS_RED);
#pragma unroll
        for (int ai = 0; ai < 2; ++ai) {
            f32x4 rv[4][2][2]; u32x4 rw[4][2];
#pragma unroll
            for (int m = 0; m < 4; ++m) { const size_t off = (size_t)(row0 + ai * HALF + m * 16) * DM + col0;
#pragma unroll
                for (int bj = 0; bj < 2; ++bj) {
                    if (RES_BF16) rw[m][bj] = *(const gu32x4*)(resb + off + bj * HALF);
                    else { rv[m][bj][0] = *(const gf32x4*)(resf + off + bj * HALF); rv[m][bj][1] = *(const gf32x4*)(resf + off + bj * HALF + 4); } } }
            asm volatile("" ::: "memory");
            if (RES_BF16) {
#pragma unroll
                for (int m = 0; m < 4; ++m)
#pragma unroll
                    for (int bj = 0; bj < 2; ++bj) { const u32x4 w = rw[m][bj];
                        rv[m][bj][0] = (f32x4){bflo(w.x), bfhi(w.x), bflo(w.y), bfhi(w.y)}; rv[m][bj][1] = (f32x4){bflo(w.z), bfhi(w.z), bflo(w.w), bfhi(w.w)}; } }
#pragma unroll
            for (int m = 0; m < 4; ++m) { const size_t off = (size_t)(row0 + ai * HALF + m * 16) * DM + col0; float ss = 0.f;
#pragma unroll
                for (int bj = 0; bj < 2; ++bj) { const f32x4 v0 = rv[m][bj][0] + acc[ai][bj][m][0] * scale, v1 = rv[m][bj][1] + acc[ai][bj][m][1] * scale;
                    u32x4 w; w.x = pk2(v0[0], v0[1]); w.y = pk2(v0[2], v0[3]); w.z = pk2(v1[0], v1[1]); w.w = pk2(v1[2], v1[3]);
                    *(gu32x4*)(xb + off + bj * HALF) = w;
                    ss += ((v0[0] * v0[0] + v0[1] * v0[1]) + (v0[2] * v0[2] + v0[3] * v0[3])) + ((v1[0] * v1[0] + v1[1] * v1[1]) + (v1[2] * v1[2] + v1[3] * v1[3])); }
                ss += __shfl_xor(ss, 16); ss += __shfl_xor(ss, 32);
                if (fq == 0) red[wc * 256 + ai * HALF + wr * 64 + m * 16 + fr] = ss; }
            asm volatile("" ::: "memory"); }
        asm volatile("s_waitcnt lgkmcnt(0)" ::: "memory"); __builtin_amdgcn_s_barrier(); asm volatile("" ::: "memory");
        if (tid < 256) ssq[(size_t)(u.pm * BM + tid) * 4 + u.pn] = (red[tid] + red[256 + tid]) + (red[512 + tid] + red[768 + tid]);
    }
};


struct EpiResidFinal {
    static constexpr bool PERM = true;
    const gbf16* res; gfloat* out; gfloat* ssq; unsigned* cnt; const gfloat* gain; float scale; unsigned want;
    __device__ __forceinline__ void operator()(f32x4 (&acc)[2][2][4][2], const Unit& u, int wr, int wc, int fr, int fq, LAS unsigned char* lds, int tid) const {
        const int row0 = u.pm * BM + wr * 64 + fr, col0 = u.pn * BM + wc * 32 + 8 * fq;
        LAS float* red = (LAS float*)(lds + LDS_RED);
        LAS float* rsl = (LAS float*)(lds + LDS_RED) + 1024;
#pragma unroll
        for (int ai = 0; ai < 2; ++ai) {
            f32x4 rv[4][2][2]; u32x4 rw[4][2];
#pragma unroll
            for (int m = 0; m < 4; ++m) { const size_t off = (size_t)(row0 + ai * HALF + m * 16) * DM + col0;
#pragma unroll
                for (int bj = 0; bj < 2; ++bj) rw[m][bj] = *(const gu32x4*)(res + off + bj * HALF); }
            asm volatile("" ::: "memory");
#pragma unroll
            for (int m = 0; m < 4; ++m)
#pragma unroll
                for (int bj = 0; bj < 2; ++bj) { const u32x4 w = rw[m][bj];
                    rv[m][bj][0] = (f32x4){bflo(w.x), bfhi(w.x), bflo(w.y), bfhi(w.y)}; rv[m][bj][1] = (f32x4){bflo(w.z), bfhi(w.z), bflo(w.w), bfhi(w.w)}; }
#pragma unroll
            for (int m = 0; m < 4; ++m) { float ss = 0.f;
#pragma unroll
                for (int bj = 0; bj < 2; ++bj)
#pragma unroll
                    for (int n = 0; n < 2; ++n) { const f32x4 v = rv[m][bj][n] + acc[ai][bj][m][n] * scale; acc[ai][bj][m][n] = v;
                        ss += (v[0] * v[0] + v[1] * v[1]) + (v[2] * v[2] + v[3] * v[3]); }
                ss += __shfl_xor(ss, 16); ss += __shfl_xor(ss, 32);
                if (fq == 0) red[wc * 256 + ai * HALF + wr * 64 + m * 16 + fr] = ss; }
            asm volatile("" ::: "memory"); }
        asm volatile("s_waitcnt lgkmcnt(0)" ::: "memory"); __builtin_amdgcn_s_barrier(); asm volatile("" ::: "memory");
        if (tid < 256) __hip_atomic_store(ssq + (size_t)(u.pm * BM + tid) * 4 + u.pn, (red[tid] + red[256 + tid]) + (red[512 + tid] + red[768 + tid]), __ATOMIC_RELAXED, __HIP_MEMORY_SCOPE_AGENT);
        asm volatile("s_waitcnt vmcnt(0)" ::: "memory"); __builtin_amdgcn_s_barrier(); asm volatile("" ::: "memory");
        if (tid == 0) {
            unsigned* c = cnt + 64 * u.pm;
            __hip_atomic_fetch_add(c, 1u, __ATOMIC_RELAXED, __HIP_MEMORY_SCOPE_AGENT);
            unsigned sp = 0;
            while (__hip_atomic_load(c, __ATOMIC_RELAXED, __HIP_MEMORY_SCOPE_AGENT) < want) { __builtin_amdgcn_s_sleep(1); if (++sp > (1u << 22)) break; }
            __builtin_amdgcn_fence(__ATOMIC_ACQUIRE, "agent");
        }
        asm volatile("s_waitcnt vmcnt(0) lgkmcnt(0)" ::: "memory"); __builtin_amdgcn_s_barrier(); asm volatile("" ::: "memory");
        if (tid < 256) { const gfloat* p = ssq + (size_t)(u.pm * BM + tid) * 4; f32x4 pv4;
            asm volatile("global_load_dwordx4 %0, %1, off sc0 sc1\n\ts_waitcnt vmcnt(0)" : "=v"(pv4) : "v"(p) : "memory");
            rsl[tid] = __builtin_amdgcn_rsqf(((pv4.x + pv4.y) + (pv4.z + pv4.w)) * (1.0f / DM) + EPS); }
        asm volatile("s_waitcnt vmcnt(0) lgkmcnt(0)" ::: "memory"); __builtin_amdgcn_s_barrier(); asm volatile("" ::: "memory");
        f32x4 gv[2][2];
#pragma unroll
        for (int bj = 0; bj < 2; ++bj)
#pragma unroll
            for (int n = 0; n < 2; ++n) gv[bj][n] = *(const gf32x4*)(gain + col0 + bj * HALF + n * 4);
#pragma unroll
        for (int ai = 0; ai < 2; ++ai)
#pragma unroll
            for (int m = 0; m < 4; ++m) { const int rl = ai * HALF + wr * 64 + m * 16 + fr; const float rs = rsl[rl]; const size_t off = (size_t)(u.pm * BM + rl) * DM + col0;
#pragma unroll
                for (int bj = 0; bj < 2; ++bj)
#pragma unroll
                    for (int n = 0; n < 2; ++n) *(gf32x4*)(out + off + bj * HALF + n * 4) = acc[ai][bj][m][n] * rs * gv[bj][n]; }
    }
};

template <class Epi, class Sched>
__device__ __forceinline__ void gemm_phase(LAS unsigned char* lds, const int tid, const Gemm g, const Sched& S, const Epi& E) {
    const int wid = __builtin_amdgcn_readfirstlane(tid >> 6), lane = tid & 63, wr = wid >> 2, wc = wid & 3, fr = lane & 15, fq = lane >> 4;
    const int K = g.K, nt = K / BK;
    unsigned voffA[2], voffB[2];
#pragma unroll
    for (int i = 0; i < 2; ++i) { int R, C; stage_rc(tid * 16 + i * 8192, R, C); const int Rb = Epi::PERM ? ((R & ~31) + perm32(R & 31)) : R;
        voffA[i] = (unsigned)(R * K + C) * 2u; voffB[i] = (unsigned)(Rb * K + C) * 2u; }
    const size_t kstep = (size_t)(BK * 2);
    const size_t hstep = (size_t)HALF * K * 2;
    const size_t tstep = 2 * hstep;
    const unsigned ldsw = (unsigned)wid * 1024u;
    const int aoff = lds_byte(wr * 64 + fr, fq * 8), boff = lds_byte(wc * 32 + fr, fq * 8);
#define PG8_SA(b, h) (((b) * 2 + (h)) * HTB)
#define PG8_SB(b, h) ((4 + (b) * 2 + (h)) * HTB)
#define PG8_STAGE(bufoff, gbase, voff) do { _Pragma("unroll") for (int _i = 0; _i < 2; ++_i) \
        __builtin_amdgcn_global_load_lds((const gunsigned*)((const gchar*)(gbase) + (voff)[_i]), (LAS unsigned*)(lds + (bufoff) + ldsw + _i * 8192), 16, 0, 0); } while (0)
#define PG8_LDA(dst, b, h) do { _Pragma("unroll") for (int m = 0; m < 4; ++m) _Pragma("unroll") for (int k = 0; k < 2; ++k) dst[m][k] = *(const LAS bf16x8*)(lds + PG8_SA(b, h) + aoff + m * 2048 + k * 1024); } while (0)
#define PG8_LDB(dst, b, h) do { _Pragma("unroll") for (int n = 0; n < 2; ++n) _Pragma("unroll") for (int k = 0; k < 2; ++k) dst[n][k] = *(const LAS bf16x8*)(lds + PG8_SB(b, h) + boff + n * 2048 + k * 1024); } while (0)
#define PG8_MMA(ai, bj, At, Bt) do { __builtin_amdgcn_s_setprio(1); _Pragma("unroll") for (int m = 0; m < 4; ++m) _Pragma("unroll") for (int n = 0; n < 2; ++n) _Pragma("unroll") for (int k = 0; k < 2; ++k) \
        acc[ai][bj][m][n] = __builtin_amdgcn_mfma_f32_16x16x32_bf16(Bt[n][k], At[m][k], acc[ai][bj][m][n], 0, 0, 0); __builtin_amdgcn_s_setprio(0); } while (0)
#define PG8_WAIT_V(n) asm volatile("s_waitcnt vmcnt(" #n ")" ::: "memory")
#define PG8_WAIT_L(n) asm volatile("s_waitcnt lgkmcnt(" #n ")" ::: "memory")
#define PG8_BAR __builtin_amdgcn_s_barrier()
#define PG8_SCHED __builtin_amdgcn_sched_barrier(0)
    Unit cur, nxt; int ui = 0;
    if (!S.next(0, cur)) return;
    f32x4 acc[2][2][4][2];
#pragma unroll
    for (int a = 0; a < 2; ++a)
#pragma unroll
        for (int b = 0; b < 2; ++b)
#pragma unroll
            for (int m = 0; m < 4; ++m)
#pragma unroll
                for (int n = 0; n < 2; ++n) acc[a][b][m][n] = (f32x4){0.f, 0.f, 0.f, 0.f};
    bf16x8 At[4][2], B0[2][2], B1[2][2];
    const gchar* cA = (const gchar*)g.A + (size_t)cur.pm * tstep + (size_t)cur.pz * g.zA; const gchar* cB = (const gchar*)g.Bt + (size_t)cur.pn * tstep + (size_t)cur.pz * g.zB;
    PG8_STAGE(PG8_SB(0, 0), cB, voffB); PG8_STAGE(PG8_SB(0, 1), cB + hstep, voffB); PG8_STAGE(PG8_SA(0, 0), cA, voffA); PG8_STAGE(PG8_SA(0, 1), cA + hstep, voffA);
    if (wr == 1) PG8_BAR;
    PG8_WAIT_V(2); PG8_BAR;
    PG8_STAGE(PG8_SB(1, 0), cB + kstep, voffB); PG8_STAGE(PG8_SA(1, 0), cA + kstep, voffA); PG8_STAGE(PG8_SB(1, 1), cB + hstep + kstep, voffB);
    PG8_WAIT_V(6); PG8_BAR;
    for (;;) {
        const bool has_next = S.next(ui + 1, nxt);
        const gchar* nA = has_next ? (const gchar*)g.A + (size_t)nxt.pm * tstep + (size_t)nxt.pz * g.zA : cA;
        const gchar* nB = has_next ? (const gchar*)g.Bt + (size_t)nxt.pn * tstep + (size_t)nxt.pz * g.zB : cB;
        for (int t = 0; t < nt; t += 2) {
            const bool last = (t == nt - 2);
            const gchar* a1 = cA + (size_t)(t + 1) * kstep;
            const gchar* a2 = last ? nA : cA + (size_t)(t + 2) * kstep; const gchar* b2 = last ? nB : cB + (size_t)(t + 2) * kstep;
            const gchar* a3 = a2 + kstep; const gchar* b3 = b2 + kstep;
            PG8_LDB(B0, 0, 0); PG8_LDB(B1, 0, 1); PG8_SCHED; PG8_LDA(At, 0, 0); PG8_STAGE(PG8_SA(1, 1), a1 + hstep, voffA);
            PG8_WAIT_V(8); PG8_WAIT_L(0); PG8_BAR; PG8_MMA(0, 0, At, B0); PG8_MMA(0, 1, At, B1); PG8_BAR; PG8_SCHED;
            PG8_LDA(At, 0, 1); PG8_STAGE(PG8_SB(0, 0), b2, voffB); PG8_STAGE(PG8_SB(0, 1), b2 + hstep, voffB); PG8_STAGE(PG8_SA(0, 0), a2, voffA);
            PG8_WAIT_V(8); PG8_WAIT_L(0); PG8_BAR; PG8_MMA(1, 0, At, B0); PG8_MMA(1, 1, At, B1); PG8_BAR; PG8_SCHED;
            PG8_LDB(B0, 1, 0); PG8_LDB(B1, 1, 1); PG8_SCHED; PG8_LDA(At, 1, 0); PG8_STAGE(PG8_SA(0, 1), a2 + hstep, voffA);
            PG8_WAIT_V(8); PG8_WAIT_L(0); PG8_BAR; PG8_MMA(0, 0, At, B0); PG8_MMA(0, 1, At, B1); PG8_BAR; PG8_SCHED;
            PG8_LDA(At, 1, 1); PG8_STAGE(PG8_SB(1, 0), b3, voffB); PG8_STAGE(PG8_SB(1, 1), b3 + hstep, voffB); PG8_STAGE(PG8_SA(1, 0), a3, voffA);
            PG8_WAIT_V(8); PG8_WAIT_L(0); PG8_BAR; PG8_MMA(1, 0, At, B0); PG8_MMA(1, 1, At, B1); PG8_BAR; PG8_SCHED;
        }
        if (wr == 0) PG8_BAR;
        E(acc, cur, wr, wc, fr, fq, lds, tid);
        if (!has_next) break;
#pragma unroll
        for (int a = 0; a < 2; ++a)
#pragma unroll
            for (int b = 0; b < 2; ++b)
#pragma unroll
                for (int m = 0; m < 4; ++m)
#pragma unroll
                    for (int n = 0; n < 2; ++n) acc[a][b][m][n] = (f32x4){0.f, 0.f, 0.f, 0.f};
        cur = nxt; cA = nA; cB = nB; ++ui;
        if (wr == 1) PG8_BAR;
    }
    PG8_WAIT_V(0);
    PG8_BAR;
#undef PG8_SA
#undef PG8_SB
#undef PG8_STAGE
#undef PG8_LDA
#undef PG8_LDB
#undef PG8_MMA
#undef PG8_WAIT_V
#undef PG8_WAIT_L
#undef PG8_BAR
#undef PG8_SCHED
}
}

constexpr int ATT_BIAS_OFF = 110592;
template <int HD, int MODE>
__device__ __forceinline__ void attn_unit(LAS unsigned char* lds, const int tid_in, const gbf16* Qg, int q_pitch, const gbf16* Kg, int k_pitch,
                                          const gbf16* Vtg, int vt_pitch, gbf16* Og, int o_pitch, int t0, int t1, float c,
                                          int q0, const gfloat* biasg, float m_init, float l_init, const gfloat* qgain, const gf32x2* ropet) {
    constexpr int KROW = HD * 2 + 16, VROW = 144, KBYTES = 64 * KROW, VBYTES = HD * VROW, BUF = KBYTES + VBYTES, NP = HD / 64;
    static_assert(3 * BUF <= ATT_BIAS_OFF, "attention LDS");
    int tid = tid_in; asm volatile("" : "+v"(tid));
    const int lane = tid & 63, wid = __builtin_amdgcn_readfirstlane(tid >> 6), r32 = lane & 31, hi = lane >> 5;
    bf16x8 qf[HD / 16];
    { const gbf16* qrow = Qg + (size_t)(wid * 32 + r32) * q_pitch + hi * 8;
      u32x4 qraw[HD / 16]; f32x4 gq[HD / 16][2], cs[HD / 16][2];
      const int pos = q0 + wid * 32 + r32;
#pragma unroll
      for (int d0 = 0; d0 < HD / 16; ++d0) { qraw[d0] = *(const gu32x4*)(qrow + d0 * 16);
          const gf32x4* gp_ = (const gf32x4*)(qgain + 16 * d0 + 8 * hi); gq[d0][0] = gp_[0]; gq[d0][1] = gp_[1];
          const gf32x4* rp_ = (const gf32x4*)(ropet + ((d0 < HD / 32) ? (pos >> 6) : (pos & 63)) * 16 + 8 * (d0 % (HD / 32)) + 4 * hi); cs[d0][0] = rp_[0]; cs[d0][1] = rp_[1]; }
      float x[HD / 16][8]; float ss = 0.f;
#pragma unroll
      for (int d0 = 0; d0 < HD / 16; ++d0) { const u32x4 v = qraw[d0];
          x[d0][0] = bflo(v.x); x[d0][1] = bfhi(v.x); x[d0][2] = bflo(v.y); x[d0][3] = bfhi(v.y); x[d0][4] = bflo(v.z); x[d0][5] = bfhi(v.z); x[d0][6] = bflo(v.w); x[d0][7] = bfhi(v.w);
#pragma unroll
          for (int e = 0; e < 8; ++e) ss += x[d0][e] * x[d0][e]; }
      { auto rr = __builtin_amdgcn_permlane32_swap(__float_as_uint(ss), __float_as_uint(ss), false, false); ss = __uint_as_float(rr[0]) + __uint_as_float(rr[1]); }
      const float rstd = (1.0f / sqrtf(ss * (1.0f / HD) + EPS)) * c;
#pragma unroll
      for (int d0 = 0; d0 < HD / 16; ++d0) {
          float y[8];
#pragma unroll
          for (int p = 0; p < 4; ++p) { const float a = x[d0][2 * p] * rstd * gq[d0][p >> 1][2 * (p & 1)], b = x[d0][2 * p + 1] * rstd * gq[d0][p >> 1][2 * (p & 1) + 1];
              const float co = cs[d0][p >> 1][2 * (p & 1)], si = cs[d0][p >> 1][2 * (p & 1) + 1];
              y[2 * p] = a * co - b * si; y[2 * p + 1] = a * si + b * co; }
          u32x4 w; w.x = pk2(y[0], y[1]); w.y = pk2(y[2], y[3]); w.z = pk2(y[4], y[5]); w.w = pk2(y[6], y[7]); qf[d0] = __builtin_bit_cast(bf16x8, w); } }
    u32x4 kstA[NP], vstA[NP], kstB[NP], vstB[NP];
    unsigned kgo[NP], vgo[NP], kl[NP], vl[NP];
#pragma unroll
    for (int p = 0; p < NP; ++p) { const int idx = tid + 512 * p; const int krow = idx / (HD / 8), kch = idx % (HD / 8), vd = idx >> 3, vch = idx & 7;
        kgo[p] = (unsigned)(krow * k_pitch + kch * 8) * 2u; vgo[p] = (unsigned)(vd * vt_pitch + vch * 8) * 2u;
        kl[p] = krow * KROW + kch * 16; vl[p] = KBYTES + vd * VROW + vch * 16; }
#define ATT_LOAD(t, KS, VS) do { const gchar* kb0_ = (const gchar*)(Kg + (size_t)(t) * 64 * k_pitch); const gchar* vb0_ = (const gchar*)(Vtg + (t) * 64); \
        _Pragma("unroll") for (int p = 0; p < NP; ++p) { KS[p] = *(const gu32x4*)(kb0_ + kgo[p]); VS[p] = *(const gu32x4*)(vb0_ + vgo[p]); } } while (0)
#define ATT_STORE(boff, KS, VS) do { _Pragma("unroll") for (int p = 0; p < NP; ++p) { *(LAS u32x4*)(lds + (boff) + kl[p]) = KS[p]; *(LAS u32x4*)(lds + (boff) + vl[p]) = VS[p]; } } while (0)
#define ATT_QK(S0, S1, boff) do { const LAS unsigned char* kb_ = lds + (boff) + krd; \
        _Pragma("unroll") for (int r = 0; r < 16; ++r) { S0[r] = 0.f; S1[r] = 0.f; } \
        _Pragma("unroll") for (int d0 = 0; d0 < HD / 16; ++d0) { \
            const bf16x8 k0_ = *(const LAS bf16x8*)(kb_ + d0 * 32); const bf16x8 k1_ = *(const LAS bf16x8*)(kb_ + 32 * KROW + d0 * 32); \
            S0 = __builtin_amdgcn_mfma_f32_32x32x16_bf16(k0_, qf[d0], S0, 0, 0, 0); S1 = __builtin_amdgcn_mfma_f32_32x32x16_bf16(k1_, qf[d0], S1, 0, 0, 0); } } while (0)
    const int pr = (r32 & 0x13) | ((r32 & 4) << 1) | ((r32 & 8) >> 1);
    const unsigned krd = pr * KROW + hi * 16, vrd = KBYTES + r32 * VROW + hi * 16;
    f32x16 o[HD / 32];
#pragma unroll
    for (int d0 = 0; d0 < HD / 32; ++d0)
#pragma unroll
        for (int r = 0; r < 16; ++r) o[d0][r] = 0.f;
    float m_run = m_init, l_run = l_init;
    const LAS float* biasl = (const LAS float*)(lds + ATT_BIAS_OFF);
    const int qpos = q0 + wid * 32 + r32;
    __syncthreads();
    ATT_LOAD(t0, kstA, vstA); if (t0 + 1 < t1) ATT_LOAD(t0 + 1, kstB, vstB);
    ATT_STORE(0, kstA, vstA); if (t0 + 1 < t1) ATT_STORE(BUF, kstB, vstB);
    if (t0 + 2 < t1) ATT_LOAD(t0 + 2, kstA, vstA);
    if (MODE == 1) { if (tid < 257) ((LAS float*)(lds + ATT_BIAS_OFF))[tid] = biasg[tid]; }
    __syncthreads();
    int bc = 0, bn = BUF, bw = 2 * BUF;
    f32x16 sa0, sa1, sb0, sb1, negm;
    ATT_QK(sa0, sa1, 0);
    { float mx0 = fmaxf(sa0[0], sa1[0]);
#pragma unroll
      for (int r = 1; r < 16; ++r) mx0 = fmaxf(fmaxf(mx0, sa0[r]), sa1[r]);
      { auto rr = __builtin_amdgcn_permlane32_swap(__float_as_uint(mx0), __float_as_uint(mx0), false, false); mx0 = fmaxf(__uint_as_float(rr[0]), __uint_as_float(rr[1])); }
      m_run = mx0;
#pragma unroll
      for (int r = 0; r < 16; ++r) { sa0[r] -= mx0; sa1[r] -= mx0; negm[r] = -mx0; } }
#define ATT_SB() __builtin_amdgcn_sched_barrier(0)
#define ATT_STEP(SC0, SC1, SN0, SN1, t, KL, VL, KSt, VSt) do { \
        const bool has2_ = ((t) + 2 < t1); \
        if ((t) > t0) __syncthreads(); \
        ATT_LOAD(min((t) + 3, t1 - 1), KL, VL);        \
        ATT_SB(); \
          \
        bf16x8 kf0_[HD / 16], kf1_[HD / 16]; \
        { const LAS unsigned char* kb_ = lds + bn + krd; \
          _Pragma("unroll") for (int d0 = 0; d0 < HD / 16; ++d0) { kf0_[d0] = *(const LAS bf16x8*)(kb_ + d0 * 32); kf1_[d0] = *(const LAS bf16x8*)(kb_ + 32 * KROW + d0 * 32); } } \
        ATT_SB(); \
          \
        float mx_ = fmaxf(SC0[0], SC1[0]); \
        _Pragma("unroll") for (int r = 1; r < 16; ++r) mx_ = fmaxf(fmaxf(mx_, SC0[r]), SC1[r]); \
        { auto rr = __builtin_amdgcn_permlane32_swap(__float_as_uint(mx_), __float_as_uint(mx_), false, false); mx_ = fmaxf(__uint_as_float(rr[0]), __uint_as_float(rr[1])); } \
        if (__any(mx_ > 4.0f)) { \
            const float dl_ = fmaxf(mx_, 0.f); const float al_ = __builtin_amdgcn_exp2f(-dl_); \
            m_run += dl_; l_run *= al_; \
            _Pragma("unroll") for (int r = 0; r < 16; ++r) { SC0[r] -= dl_; SC1[r] -= dl_; } \
            _Pragma("unroll") for (int d0 = 0; d0 < HD / 32; ++d0) _Pragma("unroll") for (int r = 0; r < 16; ++r) o[d0][r] *= al_; \
            _Pragma("unroll") for (int r = 0; r < 16; ++r) negm[r] = -m_run; } \
        ATT_SB(); \
          \
        SN0 = __builtin_amdgcn_mfma_f32_32x32x16_bf16(kf0_[0], qf[0], negm, 0, 0, 0); SN1 = __builtin_amdgcn_mfma_f32_32x32x16_bf16(kf1_[0], qf[0], negm, 0, 0, 0); \
        _Pragma("unroll") for (int d0 = 1; d0 < HD / 16; ++d0) { \
            SN0 = __builtin_amdgcn_mfma_f32_32x32x16_bf16(kf0_[d0], qf[d0], SN0, 0, 0, 0); SN1 = __builtin_amdgcn_mfma_f32_32x32x16_bf16(kf1_[d0], qf[d0], SN1, 0, 0, 0); } \
        float rs_ = 0.f; \
        _Pragma("unroll") for (int r = 0; r < 16; ++r) { SC0[r] = __builtin_amdgcn_exp2f(SC0[r]); rs_ += SC0[r]; } \
        bf16x8 pf_[4]; \
        { u32x4 w; \
          w.x = pk2(SC0[0], SC0[1]); w.y = pk2(SC0[2], SC0[3]); w.z = pk2(SC0[4], SC0[5]); w.w = pk2(SC0[6], SC0[7]); pf_[0] = __builtin_bit_cast(bf16x8, w); \
          w.x = pk2(SC0[8], SC0[9]); w.y = pk2(SC0[10], SC0[11]); w.z = pk2(SC0[12], SC0[13]); w.w = pk2(SC0[14], SC0[15]); pf_[1] = __builtin_bit_cast(bf16x8, w); } \
        _Pragma("unroll") for (int g_ = 0; g_ < HD / 8; ++g_) { \
            __builtin_amdgcn_sched_group_barrier(0x008, 1, 0); __builtin_amdgcn_sched_group_barrier(0x400, 2, 0); __builtin_amdgcn_sched_group_barrier(0x002, 5, 0); } \
        ATT_SB(); \
          \
        bf16x8 vf_[HD / 32][4]; \
        { const LAS unsigned char* vb_ = lds + bc + vrd; \
          _Pragma("unroll") for (int d0 = 0; d0 < HD / 32; ++d0) _Pragma("unroll") for (int kk = 0; kk < 4; ++kk) vf_[d0][kk] = *(const LAS bf16x8*)(vb_ + d0 * 32 * VROW + kk * 32); } \
        ATT_SB(); \
          \
        _Pragma("unroll") for (int r = 0; r < 16; ++r) { SC1[r] = __builtin_amdgcn_exp2f(SC1[r]); rs_ += SC1[r]; } \
        { u32x4 w; \
          w.x = pk2(SC1[0], SC1[1]); w.y = pk2(SC1[2], SC1[3]); w.z = pk2(SC1[4], SC1[5]); w.w = pk2(SC1[6], SC1[7]); pf_[2] = __builtin_bit_cast(bf16x8, w); \
          w.x = pk2(SC1[8], SC1[9]); w.y = pk2(SC1[10], SC1[11]); w.z = pk2(SC1[12], SC1[13]); w.w = pk2(SC1[14], SC1[15]); pf_[3] = __builtin_bit_cast(bf16x8, w); } \
        l_run += rs_; \
        ATT_SB(); \
          \
        _Pragma("unroll") for (int d0 = 0; d0 < HD / 32; ++d0) _Pragma("unroll") for (int kk = 0; kk < 4; ++kk) \
            o[d0] = __builtin_amdgcn_mfma_f32_32x32x16_bf16(vf_[d0][kk], pf_[kk], o[d0], 0, 0, 0); \
        ATT_SB(); \
        if (has2_) ATT_STORE(bw, KSt, VSt); \
        { const int tmp_ = bc; bc = bn; bn = bw; bw = tmp_; } \
    } while (0)
    int t = t0;
    for (; t + 1 < t1; t += 2) { ATT_STEP(sa0, sa1, sb0, sb1, t, kstB, vstB, kstA, vstA); ATT_STEP(sb0, sb1, sa0, sa1, t + 1, kstA, vstA, kstB, vstB); }
    if (t < t1) ATT_STEP(sa0, sa1, sb0, sb1, t, kstB, vstB, kstA, vstA);
    float l_tot; { auto rr = __builtin_amdgcn_permlane32_swap(__float_as_uint(l_run), __float_as_uint(l_run), false, false); l_tot = __uint_as_float(rr[0]) + __uint_as_float(rr[1]); }
    const float inv = 1.0f / l_tot;
    gbf16* orow = Og + (size_t)(wid * 32 + r32) * o_pitch + 4 * hi;
#pragma unroll
    for (int d0 = 0; d0 < HD / 32; ++d0)
#pragma unroll
        for (int rq = 0; rq < 4; ++rq) { u32x2 w; w.x = pk2(o[d0][4 * rq] * inv, o[d0][4 * rq + 1] * inv); w.y = pk2(o[d0][4 * rq + 2] * inv, o[d0][4 * rq + 3] * inv);
            *(gu32x2*)(orow + 32 * d0 + 8 * rq) = w; }
#undef ATT_STEP
#undef ATT_SB
#undef ATT_QK
#undef ATT_LOAD
#undef ATT_STORE
}

template <int HD, int MODE>
__device__ __forceinline__ void attn_unit_np(LAS unsigned char* lds, const int tid_in, const gbf16* Qg, int q_pitch, const gbf16* Kg, int k_pitch,
                                          const gbf16* Vtg, int vt_pitch, gbf16* Og, int o_pitch, int t0, int t1, float c,
                                          int q0, const gfloat* biasg, float m_init, float l_init) {
    constexpr int KROW = HD * 2 + 16, VROW = 144, KBYTES = 64 * KROW, VBYTES = HD * VROW, BUF = KBYTES + VBYTES, NP = HD / 64;
    static_assert(2 * BUF <= ATT_BIAS_OFF, "attention LDS");
    int tid = tid_in; asm volatile("" : "+v"(tid));
    const int lane = tid & 63, wid = __builtin_amdgcn_readfirstlane(tid >> 6), r32 = lane & 31, hi = lane >> 5;
    bf16x8 qf[HD / 16];
    { const gbf16* qrow = Qg + (size_t)(wid * 32 + r32) * q_pitch + hi * 8;
#pragma unroll
      for (int d0 = 0; d0 < HD / 16; ++d0) qf[d0] = *(const gbf16x8*)(qrow + d0 * 16); }
    u32x4 kst[NP], vst[NP];
    const gbf16* kg[NP]; const gbf16* vg[NP]; unsigned kl[NP], vl[NP];
#pragma unroll
    for (int p = 0; p < NP; ++p) { const int idx = tid + 512 * p; const int krow = idx / (HD / 8), kch = idx % (HD / 8), vd = idx >> 3, vch = idx & 7;
        kg[p] = Kg + (size_t)krow * k_pitch + kch * 8; vg[p] = Vtg + (size_t)vd * vt_pitch + vch * 8;
        kl[p] = krow * KROW + kch * 16; vl[p] = KBYTES + vd * VROW + vch * 16; }
#define ATT_LOAD(t) do { _Pragma("unroll") for (int p = 0; p < NP; ++p) { kst[p] = *(const gu32x4*)(kg[p] + (size_t)(t) * 64 * k_pitch); vst[p] = *(const gu32x4*)(vg[p] + (t) * 64); } } while (0)
#define ATT_STORE(b) do { _Pragma("unroll") for (int p = 0; p < NP; ++p) { *(LAS u32x4*)(lds + (b) * BUF + kl[p]) = kst[p]; *(LAS u32x4*)(lds + (b) * BUF + vl[p]) = vst[p]; } } while (0)
    const int pr = (r32 & 0x13) | ((r32 & 4) << 1) | ((r32 & 8) >> 1);
    const unsigned krd = pr * KROW + hi * 16, vrd = KBYTES + r32 * VROW + hi * 16;
    f32x16 o[HD / 32];
#pragma unroll
    for (int d0 = 0; d0 < HD / 32; ++d0)
#pragma unroll
        for (int r = 0; r < 16; ++r) o[d0][r] = 0.f;
    float m_run = m_init, l_run = l_init;
    const LAS float* biasl = (const LAS float*)(lds + ATT_BIAS_OFF);
    __syncthreads();
    ATT_LOAD(t0); ATT_STORE(0);
    if (MODE == 1) { ((LAS float*)(lds + ATT_BIAS_OFF))[tid] = biasg[tid]; if (tid < 256) ((LAS float*)(lds + ATT_BIAS_OFF))[512 + tid] = biasg[512 + tid]; }
    int cur = 0;
    const int qlo = q0 + wid * 32;
    for (int t = t0; t < t1; ++t) {
        __syncthreads();
        const bool more = (t + 1 < t1);
        if (more) ATT_LOAD(t + 1);
        bool active = true;
        if (MODE == 1) active = !(64 * t + 63 < qlo - 128 || 64 * t > qlo + 31 + 128);
        if (active) {
            const LAS unsigned char* kb = lds + cur * BUF + krd;
            const LAS unsigned char* vb = lds + cur * BUF + vrd;
            f32x16 s0, s1;
#pragma unroll
            for (int r = 0; r < 16; ++r) { s0[r] = 0.f; s1[r] = 0.f; }
            if constexpr (HD == 64) {
                bf16x8 kf0[HD / 16], kf1[HD / 16];
#pragma unroll
                for (int d0 = 0; d0 < HD / 16; ++d0) { kf0[d0] = *(const LAS bf16x8*)(kb + d0 * 32); kf1[d0] = *(const LAS bf16x8*)(kb + 32 * KROW + d0 * 32); }
                __builtin_amdgcn_sched_barrier(0);
#pragma unroll
                for (int d0 = 0; d0 < HD / 16; ++d0) { s0 = __builtin_amdgcn_mfma_f32_32x32x16_bf16(kf0[d0], qf[d0], s0, 0, 0, 0); s1 = __builtin_amdgcn_mfma_f32_32x32x16_bf16(kf1[d0], qf[d0], s1, 0, 0, 0); }
            } else {
#pragma unroll
            for (int d0 = 0; d0 < HD / 16; ++d0) {
                const bf16x8 k0 = *(const LAS bf16x8*)(kb + d0 * 32);
                const bf16x8 k1 = *(const LAS bf16x8*)(kb + 32 * KROW + d0 * 32);
                s0 = __builtin_amdgcn_mfma_f32_32x32x16_bf16(k0, qf[d0], s0, 0, 0, 0);
                s1 = __builtin_amdgcn_mfma_f32_32x32x16_bf16(k1, qf[d0], s1, 0, 0, 0);
            } }
            if (MODE == 1) {
                const LAS float* bl = biasl + (64 * t + 8 * hi - (qlo + r32) + 384);
#pragma unroll
                for (int r = 0; r < 16; ++r) { s0[r] += bl[16 * (r >> 3) + (r & 7)]; s1[r] += bl[32 + 16 * (r >> 3) + (r & 7)]; }
            }
            float mx = fmaxf(s0[0], s1[0]);
#pragma unroll
            for (int r = 1; r < 16; ++r) mx = fmaxf(mx, fmaxf(s0[r], s1[r]));
            { auto rr = __builtin_amdgcn_permlane32_swap(__float_as_uint(mx), __float_as_uint(mx), false, false); mx = fmaxf(__uint_as_float(rr[0]), __uint_as_float(rr[1])); }
            const float m_new = fmaxf(m_run, mx);
            const bool grew = __any(m_new > m_run);
            const float alpha = __builtin_amdgcn_exp2f(m_run - m_new);
            m_run = m_new;
            float rs = 0.f;
#pragma unroll
            for (int r = 0; r < 16; ++r) { s0[r] = __builtin_amdgcn_exp2f(s0[r] - m_new); s1[r] = __builtin_amdgcn_exp2f(s1[r] - m_new); rs += s0[r] + s1[r]; }
            l_run = l_run * alpha + rs;
            if (grew) {
#pragma unroll
                for (int d0 = 0; d0 < HD / 32; ++d0)
#pragma unroll
                    for (int r = 0; r < 16; ++r) o[d0][r] *= alpha;
            }
            bf16x8 pf[4];
            { u32x4 w;
              w.x = pk2(s0[0], s0[1]); w.y = pk2(s0[2], s0[3]); w.z = pk2(s0[4], s0[5]); w.w = pk2(s0[6], s0[7]); pf[0] = __builtin_bit_cast(bf16x8, w);
              w.x = pk2(s0[8], s0[9]); w.y = pk2(s0[10], s0[11]); w.z = pk2(s0[12], s0[13]); w.w = pk2(s0[14], s0[15]); pf[1] = __builtin_bit_cast(bf16x8, w);
              w.x = pk2(s1[0], s1[1]); w.y = pk2(s1[2], s1[3]); w.z = pk2(s1[4], s1[5]); w.w = pk2(s1[6], s1[7]); pf[2] = __builtin_bit_cast(bf16x8, w);
              w.x = pk2(s1[8], s1[9]); w.y = pk2(s1[10], s1[11]); w.z = pk2(s1[12], s1[13]); w.w = pk2(s1[14], s1[15]); pf[3] = __builtin_bit_cast(bf16x8, w); }
            if constexpr (HD == 64) {
                bf16x8 vfr[HD / 32][4];
#pragma unroll
                for (int d0 = 0; d0 < HD / 32; ++d0)
#pragma unroll
                    for (int kk = 0; kk < 4; ++kk) vfr[d0][kk] = *(const LAS bf16x8*)(vb + d0 * 32 * VROW + kk * 32);
                __builtin_amdgcn_sched_barrier(0);
#pragma unroll
                for (int d0 = 0; d0 < HD / 32; ++d0)
#pragma unroll
                    for (int kk = 0; kk < 4; ++kk) o[d0] = __builtin_amdgcn_mfma_f32_32x32x16_bf16(vfr[d0][kk], pf[kk], o[d0], 0, 0, 0);
            } else {
#pragma unroll
            for (int d0 = 0; d0 < HD / 32; ++d0)
#pragma unroll
                for (int kk = 0; kk < 4; ++kk) {
                    const bf16x8 vf = *(const LAS bf16x8*)(vb + d0 * 32 * VROW + kk * 32);
                    o[d0] = __builtin_amdgcn_mfma_f32_32x32x16_bf16(vf, pf[kk], o[d0], 0, 0, 0);
                } }
        }
        if (more) ATT_STORE(cur ^ 1);
        cur ^= 1;
    }
    float l_tot; { auto rr = __builtin_amdgcn_permlane32_swap(__float_as_uint(l_run), __float_as_uint(l_run), false, false); l_tot = __uint_as_float(rr[0]) + __uint_as_float(rr[1]); }
    const float inv = 1.0f / l_tot;
    gbf16* orow = Og + (size_t)(wid * 32 + r32) * o_pitch + 4 * hi;
#pragma unroll
    for (int d0 = 0; d0 < HD / 32; ++d0)
#pragma unroll
        for (int rq = 0; rq < 4; ++rq) { u32x2 w; w.x = pk2(o[d0][4 * rq] * inv, o[d0][4 * rq + 1] * inv); w.y = pk2(o[d0][4 * rq + 2] * inv, o[d0][4 * rq + 3] * inv);
            *(gu32x2*)(orow + 32 * d0 + 8 * rq) = w; }
#undef ATT_LOAD
#undef ATT_STORE
}

__device__ __forceinline__ void rms_row_bf16(const gfloat* src, const gfloat* gain, gbf16* dst, int lane) {
    const gf32x4* xr = (const gf32x4*)src + lane; const gf32x4* gr = (const gf32x4*)gain + lane;
    f32x4 v[4]; float s = 0.f;
#pragma unroll
    for (int j = 0; j < 4; ++j) { v[j] = xr[64 * j]; s += (v[j].x * v[j].x + v[j].y * v[j].y) + (v[j].z * v[j].z + v[j].w * v[j].w); }
    const float rstd = 1.0f / sqrtf(wave_sum(s) * (1.0f / DM) + EPS);
    gu32x2* o8 = (gu32x2*)dst + lane;
#pragma unroll
    for (int j = 0; j < 4; ++j) { const f32x4 g = gr[64 * j]; u32x2 w; w.x = pk2(v[j].x * rstd * g.x, v[j].y * rstd * g.y); w.y = pk2(v[j].z * rstd * g.z, v[j].w * rstd * g.w); o8[64 * j] = w; }
}
__device__ __forceinline__ void rms_row2_bf16(const gfloat* src0, const gfloat* src1, const gfloat* gain, gbf16* dst0, gbf16* dst1, int lane) {
    const gf32x4* x0 = (const gf32x4*)src0 + lane; const gf32x4* x1 = (const gf32x4*)src1 + lane; const gf32x4* gr = (const gf32x4*)gain + lane;
    f32x4 v[4], w[4], g[4]; float s = 0.f, t = 0.f;
#pragma unroll
    for (int j = 0; j < 4; ++j) { v[j] = x0[64 * j]; w[j] = x1[64 * j]; g[j] = gr[64 * j]; }
    asm volatile("" ::: "memory");
#pragma unroll
    for (int j = 0; j < 4; ++j) { s += (v[j].x * v[j].x + v[j].y * v[j].y) + (v[j].z * v[j].z + v[j].w * v[j].w); t += (w[j].x * w[j].x + w[j].y * w[j].y) + (w[j].z * w[j].z + w[j].w * w[j].w); }
#pragma unroll
    for (int o = 1; o < 64; o <<= 1) { s += __shfl_xor(s, o); t += __shfl_xor(t, o); }
    const float r0 = __builtin_amdgcn_rsqf(s * (1.0f / DM) + EPS), r1 = __builtin_amdgcn_rsqf(t * (1.0f / DM) + EPS);
    gu32x2* o0 = (gu32x2*)dst0 + lane; gu32x2* o1 = (gu32x2*)dst1 + lane;
#pragma unroll
    for (int j = 0; j < 4; ++j) { u32x2 a, b;
        a.x = pk2(v[j].x * r0 * g[j].x, v[j].y * r0 * g[j].y); a.y = pk2(v[j].z * r0 * g[j].z, v[j].w * r0 * g[j].w); o0[64 * j] = a;
        b.x = pk2(w[j].x * r1 * g[j].x, w[j].y * r1 * g[j].y); b.y = pk2(w[j].z * r1 * g[j].z, w[j].w * r1 * g[j].w); o1[64 * j] = b; }
}
__device__ __forceinline__ void final_row2(gfloat* p0, gfloat* p1, const gfloat* gain, float rs0, float rs1, int lane) {
    gf32x4* x0 = (gf32x4*)p0 + lane; gf32x4* x1 = (gf32x4*)p1 + lane; const gf32x4* gr = (const gf32x4*)gain + lane;
    f32x4 v[4], w[4];
#pragma unroll
    for (int j = 0; j < 4; ++j) { v[j] = x0[64 * j]; w[j] = x1[64 * j]; }
#pragma unroll
    for (int j = 0; j < 4; ++j) { const f32x4 g = gr[64 * j]; x0[64 * j] = v[j] * rs0 * g; x1[64 * j] = w[j] * rs1 * g; }
}
__device__ __forceinline__ float rstd_row(const gfloat* ssq, int row) { const f32x4 p = *(const gf32x4*)(ssq + (size_t)row * 4); return 1.0f / sqrtf(((p.x + p.y) + (p.z + p.w)) * (1.0f / DM) + EPS); }
__device__ __forceinline__ void final_row(gfloat* p, const gfloat* gain, float rstd, int lane) {
    gf32x4* xr = (gf32x4*)p + lane; const gf32x4* gr = (const gf32x4*)gain + lane;
    f32x4 v[4];
#pragma unroll
    for (int j = 0; j < 4; ++j) v[j] = xr[64 * j];
#pragma unroll
    for (int j = 0; j < 4; ++j) { const f32x4 g = gr[64 * j]; xr[64 * j] = v[j] * rstd * g; }
}
__device__ __forceinline__ void transpose_item(const gfloat* W, int K, int N, gbf16* WT, int mode, LAS float* scr, int item, int lane, const gfloat* gain = nullptr) {
    const int nblk = N / 32, kb = item / nblk, nb = item % nblk, k0 = 64 * kb, n0 = 32 * nb;
#pragma unroll 8
    for (int i = 0; i < 32; ++i) { const int kk = 2 * i + (lane >> 5); float w = W[(size_t)(k0 + kk) * N + n0 + (lane & 31)]; if (gain) w *= gain[k0 + kk]; scr[kk * 33 + (lane & 31)] = w; }
    asm volatile("s_waitcnt lgkmcnt(0)" ::: "memory");
    int r0 = n0;
    if (mode == 1) { const int half = n0 >= FF ? 1 : 0, np = n0 - FF * half; r0 = 256 * (np / 128) + 128 * half + (np % 128); }
    const int c = lane & 7;
#pragma unroll
    for (int j = 0; j < 4; ++j) { const int n = (lane >> 3) + 8 * j; const LAS float* s = scr + (8 * c) * 33 + n;
        u32x4 o; o.x = pk2(s[0 * 33], s[1 * 33]); o.y = pk2(s[2 * 33], s[3 * 33]); o.z = pk2(s[4 * 33], s[5 * 33]); o.w = pk2(s[6 * 33], s[7 * 33]);
        *(gu32x4*)(WT + (size_t)(r0 + n) * K + k0 + 8 * c) = o; }
    asm volatile("s_waitcnt lgkmcnt(0)" ::: "memory");
}
__device__ __forceinline__ void transpose64_bf16(const gbf16* src, size_t src_pitch, gbf16* dst, size_t dst_pitch, LAS unsigned short* scr, int lane) {
#pragma unroll
    for (int p = 0; p < 8; ++p) { const int row = 8 * p + (lane >> 3), ch = lane & 7; const u32x4 v = *(const gu32x4*)(src + (size_t)row * src_pitch + 8 * ch);
        LAS unsigned short* d = scr + row * 66 + 8 * ch;
        d[0] = (unsigned short)v.x; d[1] = (unsigned short)(v.x >> 16); d[2] = (unsigned short)v.y; d[3] = (unsigned short)(v.y >> 16);
        d[4] = (unsigned short)v.z; d[5] = (unsigned short)(v.z >> 16); d[6] = (unsigned short)v.w; d[7] = (unsigned short)(v.w >> 16); }
    asm volatile("s_waitcnt lgkmcnt(0)" ::: "memory");
#pragma unroll
    for (int p = 0; p < 8; ++p) { const int j = 8 * p + (lane >> 3), i0 = 8 * (lane & 7); const LAS unsigned short* s = scr + i0 * 66 + j;
        u32x4 o; o.x = (unsigned)s[0] | ((unsigned)s[66] << 16); o.y = (unsigned)s[2 * 66] | ((unsigned)s[3 * 66] << 16);
        o.z = (unsigned)s[4 * 66] | ((unsigned)s[5 * 66] << 16); o.w = (unsigned)s[6 * 66] | ((unsigned)s[7 * 66] << 16);
        *(gu32x4*)(dst + (size_t)j * dst_pitch + i0) = o; }
    asm volatile("s_waitcnt lgkmcnt(0)" ::: "memory");
}
__device__ __forceinline__ void sincos_d(double a, float& sn, float& cs) {
    const double k = rint(a * 0.63661977236758134308);
    const double r = (a - k * 1.57079632679489655800) - k * 6.123233995736766036e-17;
    const double r2 = r * r;
    const double s = r * (1.0 + r2 * (-1.0 / 6 + r2 * (1.0 / 120 + r2 * (-1.0 / 5040 + r2 * (1.0 / 362880 + r2 * (-1.0 / 39916800 + r2 * (1.0 / 6227020800.0)))))));
    const double c = 1.0 + r2 * (-0.5 + r2 * (1.0 / 24 + r2 * (-1.0 / 720 + r2 * (1.0 / 40320 + r2 * (-1.0 / 3628800 + r2 * (1.0 / 479001600.0 + r2 * (-1.0 / 87178291200.0)))))));
    const int q = ((int)k) & 3;
    const double ss = (q == 0) ? s : (q == 1) ? c : (q == 2) ? -s : -c;
    const double cc = (q == 0) ? c : (q == 1) ? -s : (q == 2) ? -c : s;
    sn = (float)ss; cs = (float)cc;
}

#define XB_TMO      128
#define XB_XCNT(j)  (256  + 64 * (j))
#define XB_XSUB(j)  (1280 + 64 * (j))
#define XB_XGEN(j)  (2304 + 64 * (j))
#define XB_TOP      3328
#define XB_TOPGEN   3392
#define XCD_BAR_WORDS 3456
#define XB_SPIN_CAP (1u << 18)

__device__ __forceinline__ unsigned xb_ld(unsigned* p)              { return __hip_atomic_load(p, __ATOMIC_RELAXED, __HIP_MEMORY_SCOPE_AGENT); }
__device__ __forceinline__ unsigned xb_add(unsigned* p, unsigned v) { return __hip_atomic_fetch_add(p, v, __ATOMIC_RELAXED, __HIP_MEMORY_SCOPE_AGENT); }
__device__ __forceinline__ unsigned xb_xcc_id() { return (unsigned)__builtin_amdgcn_s_getreg((3 << 11) | 20) & 0xFu; }
#define XB_SPIN(cond, bar) do { unsigned _sp = 0; while (cond) { __builtin_amdgcn_s_sleep(1); \
    if ((++_sp & 255u) == 0u) { if (xb_ld(&(bar)[XB_TMO])) break; if (_sp > XB_SPIN_CAP) { atomicAdd(&(bar)[XB_TMO], 1u); break; } } } } while (0)

struct XcdBarrier {
    unsigned* bar; unsigned x;
    volatile LAS unsigned* st;
};

__device__ __forceinline__ XcdBarrier xcd_barrier_post(unsigned* bar, volatile LAS unsigned* st) {
    XcdBarrier b; b.bar = bar; b.x = xb_xcc_id(); b.st = st;
    if (threadIdx.x == 0) (void)xb_add(&bar[XB_XCNT(b.x)], 1u);
    return b;
}
__device__ __forceinline__ void xcd_barrier_complete(unsigned* bar, unsigned x, unsigned& nloc, unsigned& nx) {
    const unsigned G = gridDim.x * gridDim.y * gridDim.z;
    unsigned sum, cnt, mine, sp = 0u;
    for (;;) {
        sum = 0u; cnt = 0u; mine = 0u;
#pragma unroll
        for (unsigned j = 0; j < 16; ++j) { const unsigned c = xb_ld(&bar[XB_XCNT(j)]); sum += c; cnt += (c > 0u) ? 1u : 0u; mine = (j == x) ? c : mine; }
        if (sum == G) break;
        __builtin_amdgcn_s_sleep(1);
        if ((++sp & 255u) == 0u) { if (xb_ld(&bar[XB_TMO])) break; if (sp > XB_SPIN_CAP) { atomicAdd(&bar[XB_TMO], 1u); break; } }
    }
    nloc = mine > 0u ? mine : 1u; nx = cnt > 0u ? cnt : 1u;
}

__device__ __forceinline__ void xcd_barrier(const XcdBarrier& b) {
    asm volatile("s_waitcnt vmcnt(0)" ::: "memory");
    __syncthreads();
    if (threadIdx.x == 0) {
        unsigned* bar = b.bar; const unsigned bx_ = xb_xcc_id();
        __builtin_amdgcn_s_waitcnt(0);
        unsigned nloc = b.st[0], nx = b.st[1];
        if (nloc == 0u) { xcd_barrier_complete(bar, bx_, nloc, nx); b.st[0] = nloc; b.st[1] = nx; }
        const unsigned old = xb_add(&bar[XB_XSUB(bx_)], 1u);
        const unsigned gen = old / nloc;
        if (old + 1u == (gen + 1u) * nloc) {
            __builtin_amdgcn_fence(__ATOMIC_RELEASE, "agent");
            asm volatile("s_waitcnt vmcnt(0)" ::: "memory");
            const unsigned og = xb_add(&bar[XB_TOP], 1u);
            const unsigned tg = og / nx;
            if (og + 1u == (tg + 1u) * nx) xb_add(&bar[XB_TOPGEN], 1u);
            else XB_SPIN(xb_ld(&bar[XB_TOPGEN]) == tg, bar);
            __builtin_amdgcn_fence(__ATOMIC_ACQUIRE, "agent");
            xb_add(&bar[XB_XGEN(bx_)], 1u);
            asm volatile("s_waitcnt vmcnt(0)" ::: "memory");
        } else {
            XB_SPIN(xb_ld(&bar[XB_XGEN(bx_)]) == gen, bar);
            __builtin_amdgcn_fence(__ATOMIC_ACQUIRE, "agent");
            asm volatile("s_waitcnt vmcnt(0)" ::: "memory");
        }
    }
    __syncthreads();
}


#define XL_SUB(j)  (4096 + 64 * (j))
#define XL_GEN(j)  (5120 + 64 * (j))
#define XL_RANK(j) (6144 + 64 * (j))
#define XL_BAD     7168
__device__ __forceinline__ void xcd_local_barrier(const XcdBarrier& b) {
    asm volatile("s_waitcnt vmcnt(0)" ::: "memory");
    __syncthreads();
    if (threadIdx.x == 0) {
        unsigned* bar = b.bar; const unsigned x_ = xb_xcc_id();
        __builtin_amdgcn_s_waitcnt(0);
        const unsigned nloc = b.st[0];
        const unsigned old = xb_add(&bar[XL_SUB(x_)], 1u);
        const unsigned gen = old / nloc;
        if (old + 1u == (gen + 1u) * nloc) xb_add(&bar[XL_GEN(x_)], 1u);
        else XB_SPIN(xb_ld(&bar[XL_GEN(x_)]) == gen, bar);
        __builtin_amdgcn_fence(__ATOMIC_ACQUIRE, "agent");
        asm volatile("s_waitcnt vmcnt(0)" ::: "memory");
    }
    __syncthreads();
}

struct Args { const float* in[23]; float* out; unsigned char* ws; int ph_lo, ph_hi; };
enum { I_XP = 0, I_XS, I_MP, I_MS, I_RELB, I_NFF1, I_FF1I, I_FF1O, I_NMIX, I_WIN, I_QN, I_KN, I_SINK, I_NMEM, I_WMEM, I_BRA, I_BRB, I_BRC, I_WOUT, I_NFF2, I_FF2I, I_FF2O, I_NFIN };
constexpr int N_PRO = 3, N_PER = 10, N_STEPS = N_PRO + N_PER * NCH + 1;

constexpr int LDS_XB = 136192 + 256;
constexpr int LDS_PTRS = 136192;
__device__ __forceinline__ const gfloat* ldsptr(LAS unsigned char* lds, int i) {
    const unsigned long long v = ((const LAS unsigned long long*)(lds + LDS_PTRS))[i];
    const unsigned lo = __builtin_amdgcn_readfirstlane((unsigned)v), hi = __builtin_amdgcn_readfirstlane((unsigned)(v >> 32));
    return (const gfloat*)(((unsigned long long)hi << 32) | lo);
}
#define INP(i) ldsptr(lds, (i))
__global__ void __launch_bounds__(512, 2) mega_fwd(Args a) {
    extern __shared__ __attribute__((aligned(16))) unsigned char lds_raw[];
    LAS unsigned char* lds = (LAS unsigned char*)lds_raw;
    cg::grid_group grid = cg::this_grid();
    if (threadIdx.x < 23) ((LAS unsigned long long*)(lds + LDS_PTRS))[threadIdx.x] = (unsigned long long)a.in[threadIdx.x];
    if (threadIdx.x == 23) ((LAS unsigned long long*)(lds + LDS_PTRS))[23] = (unsigned long long)a.out;
    if (threadIdx.x == 24) ((LAS unsigned long long*)(lds + LDS_PTRS))[24] = (unsigned long long)a.ws;
    if (threadIdx.x == 25) { ((volatile LAS unsigned*)(lds + LDS_XB))[0] = 0u; ((volatile LAS unsigned*)(lds + LDS_XB))[1] = 0u; }
    __syncthreads();
    const XcdBarrier xbar = xcd_barrier_post((unsigned*)(a.ws + WS_BAR), (volatile LAS unsigned*)(lds + LDS_XB));
    if (threadIdx.x == 0) { const unsigned x_ = xb_xcc_id(); ((volatile LAS unsigned*)(lds + LDS_XB))[2] = x_; ((volatile LAS unsigned*)(lds + LDS_XB))[3] = xb_add((unsigned*)(a.ws + WS_BAR) + XL_RANK(x_), 1u); ((volatile LAS unsigned*)(lds + LDS_XB))[4] = 0u; }
    __syncthreads();
    const int wave_s = __builtin_amdgcn_readfirstlane((int)threadIdx.x >> 6);
#define STEP_LOCALS \
        int tid = wave_s * 64 + (int)__builtin_amdgcn_mbcnt_hi(~0u, __builtin_amdgcn_mbcnt_lo(~0u, 0u)); asm volatile("" : "+v"(tid)); \
        const int lane = tid & 63, wave = __builtin_amdgcn_readfirstlane(tid >> 6); \
        const int G = gridDim.x, bx = blockIdx.x; \
        const int vcu = (G % 8 == 0) ? (bx % 8) * (G / 8) + bx / 8 : bx; \
        const int gw = vcu * 8 + wave, NGW = G * 8; \
        guchar* ws = (guchar*)INP(24); \
        gfloat* const outp = (gfloat*)INP(23); \
        gbf16* const W_ff1i = (gbf16*)(ws + WS_WFF1I); gbf16* const W_ff1o = (gbf16*)(ws + WS_WFF1O); gbf16* const W_in = (gbf16*)(ws + WS_WIN); \
        gbf16* const W_mem = (gbf16*)(ws + WS_WMEM); gbf16* const W_br = (gbf16*)(ws + WS_WBR); gbf16* const W_out = (gbf16*)(ws + WS_WOUT); \
        gbf16* const W_ff2i = (gbf16*)(ws + WS_WFF2I); gbf16* const W_ff2o = (gbf16*)(ws + WS_WFF2O); \
        gbf16* const memn = (gbf16*)(ws + WS_MEMN); gbf16* const kvm = (gbf16*)(ws + WS_KVM); gbf16* const vtc = (gbf16*)(ws + WS_VTC); \
        gf32x2* const rope = (gf32x2*)(ws + WS_ROPE); gfloat* const biast = (gfloat*)(ws + WS_BIAS); \
        gbf16* const xn = (gbf16*)(ws + WS_XN); gbf16* const hid = (gbf16*)(ws + WS_HID); gbf16* const proj = (gbf16*)(ws + WS_PROJ); \
        gbf16* const vta = (gbf16*)(ws + WS_VTA); gbf16* const vtb = (gbf16*)(ws + WS_VTB); gbf16* const yb3 = (gbf16*)(ws + WS_Y); \
        gbf16* const part = (gbf16*)(ws + WS_PART); gbf16* const mrg = (gbf16*)(ws + WS_MRG); gfloat* const ssq = (gfloat*)(ws + WS_SSQ);
    if (PH_EN(0)) { STEP_LOCALS
            LAS float* scr = (LAS float*)(lds + wave * 16384);
            constexpr int I_FI = (DM / 64) * (2 * FF / 32), I_FO = (FF / 64) * (DM / 32), I_IN = (DM / 64) * (PROJ / 32), I_SQ = (DM / 64) * (DM / 32), I_BR = (512 / 64) * (DM / 32);
            constexpr int NITEMS = 2 * I_FI + 2 * I_FO + I_IN + 2 * I_SQ + 3 * I_BR;
            for (int it = gw; it < NITEMS; it += NGW) {
                int r = it;
                if (r < I_FI) { transpose_item(INP(I_FF1I), DM, 2 * FF, W_ff1i, 1, scr, r, lane); continue; } r -= I_FI;
                if (r < I_FI) { transpose_item(INP(I_FF2I), DM, 2 * FF, W_ff2i, 1, scr, r, lane, INP(I_NFF2)); continue; } r -= I_FI;
                if (r < I_FO) { transpose_item(INP(I_FF1O), FF, DM, W_ff1o, 0, scr, r, lane); continue; } r -= I_FO;
                if (r < I_FO) { transpose_item(INP(I_FF2O), FF, DM, W_ff2o, 0, scr, r, lane); continue; } r -= I_FO;
                if (r < I_IN) { transpose_item(INP(I_WIN), DM, PROJ, W_in, 0, scr, r, lane, INP(I_NMIX)); continue; } r -= I_IN;
                if (r < I_SQ) { transpose_item(INP(I_WMEM), DM, DM, W_mem, 0, scr, r, lane); continue; } r -= I_SQ;
                if (r < I_SQ) { transpose_item(INP(I_WOUT), DM, DM, W_out, 0, scr, r, lane); continue; } r -= I_SQ;
                if (r < I_BR) { transpose_item(INP(I_BRA), 512, DM, W_br, 0, scr, r, lane); continue; } r -= I_BR;
                if (r < I_BR) { transpose_item(INP(I_BRB), 512, DM, W_br + (size_t)DM * 512, 0, scr, r, lane); continue; } r -= I_BR;
                transpose_item(INP(I_BRC), 512, DM, W_br + (size_t)2 * DM * 512, 0, scr, r, lane);
            }
            const gfloat* mp_p = INP(I_MP); const gfloat* ms_p = INP(I_MS); const gfloat* nmem_p = INP(I_NMEM);
            for (int m = gw; m < NMEM; m += NGW) {
                const gfloat* src = (m < 2048) ? mp_p + (size_t)m * DM : ms_p + (size_t)(m - 2048) * DM;
                rms_row_bf16(src, nmem_p, memn + (size_t)m * DM, lane);
            }
            for (int i = vcu * 512 + tid; i < 2048; i += G * 512) {
                const int n = i >> 4, j = i & 15;
                const int jl = j & 3, jh = j >> 2;
                const float b = (jl == 0) ? 1.0f : (jl == 1) ? 0.5623413251903491f : (jl == 2) ? 0.31622776601683794f : 0.1778279410038923f;
                const float s = (jh == 0) ? 1.0f : (jh == 1) ? 0.1f : (jh == 2) ? 0.01f : 0.001f;
                const float inv = b * s;
                const float ang = (float)n * inv;
                float sn, cs; sincos_d((double)ang, sn, cs);
                rope[i] = (f32x2){cs, sn};
            }
            const gfloat* relb_p = INP(I_RELB);
            for (int i = vcu * 512 + tid; i < 8 * 768; i += G * 512) {
                const int h = i / 768, rel = (i % 768) - 384;
                if (rel < -128 || rel > 128) { biast[i] = -1e30f; continue; }
                const int n = rel < 0 ? -rel : rel;
                int large = 33 - __clz(n * n > 0 ? n * n : 1); if (large > 15) large = 15;
                const int bucket = (rel > 0 ? 16 : 0) + (n < 8 ? n : large);
                biast[i] = relb_p[bucket * 8 + h] * LOG2E;
            }
    }
    grid.sync();
    if (PH_EN(1)) { STEP_LOCALS
            pg8::Gemm g{memn, W_mem, NMEM, DM, DM, 0, 0}; pg8::StaticOrder S; S.init(NMEM, DM, G, bx);
            pg8::EpiPlain E{kvm, DM};
            pg8::gemm_phase(lds, tid, g, S, E);
    }
    xcd_barrier(xbar);
    if (threadIdx.x == 0) { volatile LAS unsigned* w_ = (volatile LAS unsigned*)(lds + LDS_XB);
        if (w_[0] * 8u != gridDim.x || w_[1] != 8u || w_[2] >= 8u || w_[3] >= gridDim.x / 8u) __hip_atomic_store((unsigned*)(a.ws + WS_BAR) + XL_BAD, 1u, __ATOMIC_RELAXED, __HIP_MEMORY_SCOPE_AGENT); }
    if (PH_EN(2)) { STEP_LOCALS
            LAS unsigned short* scr = (LAS unsigned short*)(lds + wave * 16384);
            for (int it = gw; it < 40 * 4 * 4 * 2; it += NGW) {
                const int db = it & 1, h = (it >> 1) & 3, mb = (it >> 3) & 3, seq = it >> 5;
                transpose64_bf16(kvm + (size_t)(seq * 256 + 64 * mb) * DM + 512 + 128 * h + 64 * db, DM,
                                 vtc + ((size_t)(seq * 4 + h) * 128 + 64 * db) * 256 + 64 * mb, 256, scr, lane);
            }
    }
    xcd_barrier(xbar);
    if (threadIdx.x == 0) ((volatile LAS unsigned*)(lds + LDS_XB))[4] = (__hip_atomic_load((unsigned*)(a.ws + WS_BAR) + XL_BAD, __ATOMIC_RELAXED, __HIP_MEMORY_SCOPE_AGENT) == 0u) ? 1u : 0u;
    __syncthreads();
    constexpr int NS = N_PER * NCH;
    for (int step2 = 0; step2 < 2 * NS; ++step2) {
        const int step = step2 >> 1;
        const bool dup_ = ((PH_DUP >> (step % N_PER)) & 1);
        if ((step2 & 1) && !dup_) continue;
        STEP_LOCALS
        const int xl_good = __builtin_amdgcn_readfirstlane((int)((volatile LAS unsigned*)(lds + LDS_XB))[4]);
        const int xl_x = __builtin_amdgcn_readfirstlane((int)((volatile LAS unsigned*)(lds + LDS_XB))[2]), xl_r = __builtin_amdgcn_readfirstlane((int)((volatile LAS unsigned*)(lds + LDS_XB))[3]);
        const int cx = xl_good ? (xl_x + 8 * xl_r) : bx;
        {
            const int c = step / N_PER, k = step % N_PER;
            const bool prompt = c < NCH_P;
#define XIN() (INP(prompt ? I_XP : I_XS) + (size_t)(prompt ? c : c - NCH_P) * CH * DM)
#define HOUT() ((gfloat*)INP(23) + (size_t)c * CH * DM)
            const int S_ = prompt ? 8192 : 2048, nseq = CH / S_, NQB = S_ / 256;
            const int memseq0 = prompt ? (CH / 8192) * c : 8 + (CH / 2048) * (c - NCH_P);
            gfloat* const ssq1 = ssq; gfloat* const ssq2 = ssq + CH * 4; gfloat* const ssq3 = ssq + 2 * CH * 4;
            if (PH_EN(3) && k == 0) {
                const gfloat* gain = INP(I_NFF1);
                const gfloat* xin_ = XIN();
                if (xl_good && (CH / 8) % (2 * G) == 0) {
                    const int m0 = (CH / 8) * xl_x + xl_r * 8 + wave;
                    for (int i0 = 0; i0 < CH / 8; i0 += 2 * G) { const size_t ra = (size_t)(m0 + i0) * DM, rb = (size_t)(m0 + i0 + G) * DM; rms_row2_bf16(xin_ + ra, xin_ + rb, gain, xn + ra, xn + rb, lane); }
                } else
                for (int m = gw; m < CH; m += 2 * NGW) { const int m1 = (m + NGW < CH) ? m + NGW : m; rms_row2_bf16(xin_ + (size_t)m * DM, xin_ + (size_t)m1 * DM, gain, xn + (size_t)m * DM, xn + (size_t)m1 * DM, lane); }
            } else if (PH_EN(4) && k == 1) {
                pg8::Gemm g{xn, W_ff1i, CH, 2 * FF, DM, 0, 0}; pg8::StaticOrder S; S.init(CH, 2 * FF, G, cx);
                pg8::EpiSwiglu E{hid};
                pg8::gemm_phase(lds, tid, g, S, E);
            } else if (PH_EN(5) && k == 2) {
                pg8::Gemm g{hid, W_ff1o, CH, DM, FF, 0, 0}; pg8::StaticOrder S; S.init(CH, DM, G, cx);
                pg8::EpiResidStats<false> E{XIN(), nullptr, xn, ssq1, 0.5f};
                pg8::gemm_phase(lds, tid, g, S, E);
            } else if (PH_EN(5) && k == 9) {
                pg8::Gemm g{hid, W_ff2o, CH, DM, FF, 0, 0}; pg8::StaticOrder S; S.init(CH, DM, G, cx);
                pg8::EpiResidFinal E{xn, HOUT(), ssq3, (unsigned*)(ws + WS_CNT), INP(I_NFIN), 0.5f, 4u * (unsigned)(c + 1)};
                pg8::gemm_phase(lds, tid, g, S, E);
            } else if (PH_EN(6) && k == 3) {
                pg8::Gemm g{xn, W_in, CH, PROJ, DM, 0, 0}; pg8::StaticOrder S; S.init(CH, PROJ, G, cx);
                pg8::EpiPlainRstd E{proj, PROJ, ssq1, 1};
                pg8::gemm_phase(lds, tid, g, S, E);
            } else if (PH_EN(7) && k == 4) {
                const gfloat* qn_p = INP(I_QN); const gfloat* kn_p = INP(I_KN);
                for (int wi = gw; wi < CH * 2 / 8; wi += 2 * NGW) {
                    const int sub = lane & 7;
                    gbf16* pp[2]; u32x4 vv[2]; int posv[2], hhv[2];
#pragma unroll
                    for (int q = 0; q < 2; ++q) { const int item = (wi + q * NGW) * 8 + (lane >> 3); const int tok = item / 2, hh = 8 + (item & 1);
                        pp[q] = proj + (size_t)tok * PROJ + 64 * hh + 8 * sub; vv[q] = *(const gu32x4*)pp[q]; posv[q] = tok % S_; hhv[q] = hh; }
#pragma unroll
                    for (int q = 0; q < 2; ++q) {
                        const u32x4 v = vv[q]; const int hh = hhv[q], pos = posv[q];
                        float x[8] = {bflo(v.x), bfhi(v.x), bflo(v.y), bfhi(v.y), bflo(v.z), bfhi(v.z), bflo(v.w), bfhi(v.w)};
                        float ss = 0.f;
#pragma unroll
                        for (int e = 0; e < 8; ++e) ss += x[e] * x[e];
                        ss += __shfl_xor(ss, 1); ss += __shfl_xor(ss, 2); ss += __shfl_xor(ss, 4);
                        const float rstd = (1.0f / sqrtf(ss * (1.0f / 64) + EPS)) * ((hh < 8) ? 0.125f * LOG2E : 1.0f);
                        const gfloat* gn = ((hh < 8) ? qn_p : kn_p) + 8 * sub;
                        const f32x4 g0 = *(const gf32x4*)gn, g1 = *(const gf32x4*)(gn + 4);
                        x[0] *= rstd * g0.x; x[1] *= rstd * g0.y; x[2] *= rstd * g0.z; x[3] *= rstd * g0.w;
                        x[4] *= rstd * g1.x; x[5] *= rstd * g1.y; x[6] *= rstd * g1.z; x[7] *= rstd * g1.w;
                        const int nidx = (sub < 4) ? (pos >> 6) : (pos & 63);
                        const gf32x4* rt = (const gf32x4*)(rope + nidx * 16 + 4 * (sub & 3));
                        const f32x4 c01 = rt[0], c23 = rt[1];
                        float y[8];
                        y[0] = x[0] * c01.x - x[1] * c01.y; y[1] = x[0] * c01.y + x[1] * c01.x;
                        y[2] = x[2] * c01.z - x[3] * c01.w; y[3] = x[2] * c01.w + x[3] * c01.z;
                        y[4] = x[4] * c23.x - x[5] * c23.y; y[5] = x[4] * c23.y + x[5] * c23.x;
                        y[6] = x[6] * c23.z - x[7] * c23.w; y[7] = x[6] * c23.w + x[7] * c23.z;
                        u32x4 w; w.x = pk2(y[0], y[1]); w.y = pk2(y[2], y[3]); w.z = pk2(y[4], y[5]); w.w = pk2(y[6], y[7]);
                        *(gu32x4*)pp[q] = w;
                    }
                }
                LAS unsigned short* scr = (LAS unsigned short*)(lds + wave * 16384);
                for (int it = gw; it < (CH / 64) * 4; it += NGW) {
                    const int kvh = it & 1, which = (it >> 1) & 1, tt = it >> 2;
                    const int tok = 64 * tt, seq = tok / S_, pos = tok % S_;
                    transpose64_bf16(proj + (size_t)tok * PROJ + (which ? 1408 : 640) + 64 * kvh, PROJ,
                                     (which ? vtb : vta) + ((size_t)(seq * 2 + kvh) * 64) * S_ + pos, S_, scr, lane);
                }
            } else if (PH_EN(8) && k == 5) {
                const gfloat* qn_att = INP(I_QN);
                for (int u = vcu; ATT_EN(0) && u < (CH / 256) * 8; u += G) {
                    const int qb = u % NQB, g4 = (u / NQB) % 4, kvh = (u / NQB / 4) % 2, seq = u / (NQB * 8), head = kvh * 4 + g4;
                    const size_t tokq = (size_t)seq * S_ + (size_t)qb * 256;
                    attn_unit<64, 0>(lds, tid, proj + tokq * PROJ + 64 * head, PROJ, proj + (size_t)seq * S_ * PROJ + 512 + 64 * kvh, PROJ,
                                     vta + ((size_t)(seq * 2 + kvh) * 64) * S_, S_, yb3 + tokq * 512 + 64 * head, 512, 0, S_ / 64,
                                     0.125f * LOG2E, qb * 256, nullptr, -1e30f, 0.f, qn_att, rope);
                }
                for (int u = vcu; ATT_EN(1) && u < (CH / 256) * 8; u += G) {
                    const int qb = u % NQB, g4 = (u / NQB) % 4, kvh = (u / NQB / 4) % 2, seq = u / (NQB * 8), head = kvh * 4 + g4;
                    const size_t tokq = (size_t)seq * S_ + (size_t)qb * 256;
                    const int q0 = qb * 256;
                    const int t0 = (q0 >= 128) ? (q0 - 128) / 64 : 0, t1 = min(S_, q0 + 384) / 64;
                    attn_unit_np<64, 1>(lds, tid, proj + tokq * PROJ + 768 + 64 * head, PROJ, proj + (size_t)seq * S_ * PROJ + 1280 + 64 * kvh, PROJ,
                                     vtb + ((size_t)(seq * 2 + kvh) * 64) * S_, S_, yb3 + (size_t)CH * 512 + tokq * 512 + 64 * head, 512, t0, t1,
                                     0.125f * LOG2E, q0, biast + head * 768, INP(I_SINK)[head] * LOG2E, 1.0f);
                }
                for (int u = vcu; ATT_EN(2) && u < (CH / 256) * 4; u += G) {
                    const int qb = u % NQB, h = (u / NQB) % 4, seq = u / (NQB * 4);
                    const size_t tokq = (size_t)seq * S_ + (size_t)qb * 256;
                    const int ms = memseq0 + seq;
                    attn_unit_np<128, 0>(lds, tid, proj + tokq * PROJ + 1536 + 128 * h, PROJ, kvm + (size_t)ms * 256 * DM + 128 * h, DM,
                                      vtc + ((size_t)(ms * 4 + h) * 128) * 256, 256, yb3 + (size_t)2 * CH * 512 + tokq * 512 + 128 * h, 512, 0, 4,
                                      0.08838834764831845f * LOG2E, 0, nullptr, -1e30f, 0.f);
                }
                __syncthreads();
            } else if (PH_EN(9) && k == 6) {
                pg8::Gemm g{yb3, W_br, CH, DM, 512, (size_t)CH * 512 * 2, (size_t)DM * 512 * 2}; pg8::BranchOrder S; S.b.init(CH, DM, G, cx);
                pg8::EpiGate E{proj, part, mrg};
                pg8::gemm_phase(lds, tid, g, S, E);
            } else if (PH_EN(10) && k == 7) {
                pg8::Gemm g{mrg, W_out, CH, DM, DM, 0, 0}; pg8::StaticOrder S; S.init(CH, DM, G, cx);
                pg8::EpiResidStats<true> E{nullptr, xn, xn, ssq2, 1.0f};
                pg8::gemm_phase(lds, tid, g, S, E);
            } else if (PH_EN(11) && k == 8) {
                pg8::Gemm g{xn, W_ff2i, CH, 2 * FF, DM, 0, 0}; pg8::StaticOrder S; S.init(CH, 2 * FF, G, cx);
                pg8::EpiSwigluRstd E{hid, ssq2};
                pg8::gemm_phase(lds, tid, g, S, E);
            }
        }
        if ((step2 & 1) || !dup_) {
            if (step + 1 < NS) { const int k_ = step % N_PER;
                if (xl_good && PH_DUP == 0 && (k_ <= 2 || k_ >= 6)) xcd_local_barrier(xbar);
                else xcd_barrier(xbar); }
        } else xcd_barrier(xbar);
    }
}

extern "C" void kernel_launch(void* const* d_in, const int* in_sizes, int n_in, void* d_out, int out_size, void* d_ws, size_t ws_size, hipStream_t stream) {
    static int grid = 0;
    if (grid == 0) {
        if (n_in != 23 || ws_size < WS_END) { fprintf(stderr, "kernel_launch: unexpected n_in %d or ws_size %zu (need %zu)\n", n_in, ws_size, (size_t)WS_END); grid = -1; return; }
        int dev = 0, cus = 0, per_cu = 0;
        hipGetDevice(&dev);
        hipDeviceGetAttribute(&cus, hipDeviceAttributeMultiprocessorCount, dev);
        if (hipFuncSetAttribute((const void*)mega_fwd, hipFuncAttributeMaxDynamicSharedMemorySize, LDS_BYTES) != hipSuccess) { fprintf(stderr, "kernel_launch: hipFuncSetAttribute failed\n"); }
        if (hipOccupancyMaxActiveBlocksPerMultiprocessor(&per_cu, (const void*)mega_fwd, 512, LDS_BYTES) != hipSuccess || per_cu < 1) { fprintf(stderr, "kernel_launch: occupancy query gave %d\n", per_cu); per_cu = 1; }
        (void)hipGetLastError();
        grid = cus * 1;
        fprintf(stderr, "kernel_launch: cus %d per_cu %d grid %d ws %zu\n", cus, per_cu, grid, ws_size);
    }
    if (grid < 0) return;
    Args a{};
    for (int i = 0; i < 23; ++i) a.in[i] = (const float*)d_in[i];
    a.out = (float*)d_out; a.ws = (unsigned char*)d_ws;
    a.ph_lo = 0; a.ph_hi = 0;
    if (hipMemsetAsync((char*)d_ws + WS_BAR, 0, 32768 + 32768, stream) != hipSuccess) { fprintf(stderr, "kernel_launch: hipMemsetAsync failed\n"); return; }
    void* args[] = {&a};
    hipError_t e = hipLaunchCooperativeKernel((const void*)mega_fwd, dim3(grid), dim3(512), args, LDS_BYTES, stream);
    if (e != hipSuccess) fprintf(stderr, "cooperative launch failed: %s (grid %d)\n", hipGetErrorString(e), grid);
}
```

```cpp
#include <hip/hip_runtime.h>
#include <hip/hip_cooperative_groups.h>
#include <cstdio>
#include <cstdint>
namespace cg = cooperative_groups;

#ifndef MK_MULTI_LAUNCH
#define MK_MULTI_LAUNCH 0
#endif

#ifndef PH_MASK
#define PH_MASK 0xFFFF
#endif
#define PH_EN(i) ((PH_MASK >> (i)) & 1)
#ifndef ATT_MASK
#define ATT_MASK 7
#endif
#define ATT_EN(i) ((ATT_MASK >> (i)) & 1)
#ifndef PH_DUP
#define PH_DUP 0
#endif
#define LAS __attribute__((address_space(3)))
typedef unsigned short bf16_t;
typedef short bf16x8 __attribute__((ext_vector_type(8)));
typedef float f32x4 __attribute__((ext_vector_type(4)));
typedef float f32x2 __attribute__((ext_vector_type(2)));
typedef float f32x16 __attribute__((ext_vector_type(16)));
typedef unsigned u32x4 __attribute__((ext_vector_type(4)));
typedef unsigned u32x2 __attribute__((ext_vector_type(2)));
typedef __bf16 bf16x2_t __attribute__((ext_vector_type(2)));
#define GAS __attribute__((address_space(1)))
typedef GAS float gfloat; typedef GAS bf16_t gbf16; typedef GAS f32x4 gf32x4; typedef GAS f32x2 gf32x2; typedef GAS u32x4 gu32x4; typedef GAS u32x2 gu32x2;
typedef GAS bf16x8 gbf16x8; typedef GAS unsigned char guchar; typedef GAS char gchar; typedef GAS unsigned gunsigned;

constexpr int DM = 1024, FF = 2816, PROJ = 5120, CH = 32768, NCH = 131072 / CH, NCH_P = NCH / 2;
constexpr int NMEM = 40 * 256;
constexpr float EPS = 1e-6f;
constexpr float LOG2E = 1.4426950408889634f;

constexpr size_t al(size_t x) { return (x + 4095) & ~(size_t)4095; }
constexpr size_t WS_WFF1I = 0;
constexpr size_t WS_WFF1O = WS_WFF1I + al((size_t)2 * FF * DM * 2);
constexpr size_t WS_WIN   = WS_WFF1O + al((size_t)DM * FF * 2);
constexpr size_t WS_WMEM  = WS_WIN + al((size_t)PROJ * DM * 2);
constexpr size_t WS_WBR   = WS_WMEM + al((size_t)DM * DM * 2);
constexpr size_t WS_WOUT  = WS_WBR + al((size_t)3 * DM * 512 * 2);
constexpr size_t WS_WFF2I = WS_WOUT + al((size_t)DM * DM * 2);
constexpr size_t WS_WFF2O = WS_WFF2I + al((size_t)2 * FF * DM * 2);
constexpr size_t WS_MEMN  = WS_WFF2O + al((size_t)DM * FF * 2);
constexpr size_t WS_KVM   = WS_MEMN + al((size_t)NMEM * DM * 2);
constexpr size_t WS_VTC   = WS_KVM + al((size_t)NMEM * DM * 2);
constexpr size_t WS_ROPE  = WS_VTC + al((size_t)NMEM * 512 * 2);
constexpr size_t WS_BIAS  = WS_ROPE + al((size_t)128 * 16 * 8);
constexpr size_t WS_XN    = WS_BIAS + al((size_t)8 * 768 * 4);
constexpr size_t WS_HID   = WS_XN + al((size_t)CH * DM * 2);
constexpr size_t WS_PROJ  = WS_HID + al((size_t)CH * FF * 2);
constexpr size_t WS_VTA   = WS_PROJ + al((size_t)CH * PROJ * 2);
constexpr size_t WS_VTB   = WS_VTA + al((size_t)CH * 128 * 2);
constexpr size_t WS_Y     = WS_VTB + al((size_t)CH * 128 * 2);
constexpr size_t WS_PART  = WS_Y + al((size_t)3 * CH * 512 * 2);
constexpr size_t WS_MRG   = WS_PART + al((size_t)CH * DM * 4);
constexpr size_t WS_SSQ   = WS_MRG + al((size_t)CH * DM * 2);
constexpr size_t WS_BAR   = WS_SSQ + al((size_t)3 * CH * 4 * 4);
constexpr size_t WS_CNT   = WS_BAR + 32768;
constexpr size_t WS_END   = WS_CNT + 32768;

constexpr int LDS_RED = 131072;
constexpr int LDS_BYTES = 138240;

__device__ __forceinline__ unsigned pk2(float lo, float hi) { f32x2 v = {lo, hi}; bf16x2_t b = __builtin_convertvector(v, bf16x2_t); return __builtin_bit_cast(unsigned, b); }
__device__ __forceinline__ float bflo(unsigned w) { return __uint_as_float(w << 16); }
__device__ __forceinline__ float bfhi(unsigned w) { return __uint_as_float(w & 0xffff0000u); }
__device__ __forceinline__ float wave_sum(float v) {
#pragma unroll
    for (int o = 1; o < 64; o <<= 1) v += __shfl_xor(v, o);
    return v;
}
__device__ __forceinline__ float sigmoidf_(float x) { return __builtin_amdgcn_rcpf(1.0f + __builtin_amdgcn_exp2f(-x * LOG2E)); }

namespace pg8 {
constexpr int BM = 256, BK = 64, HALF = 128, HTB = HALF * BK * 2, STAGE_BYTES = 8 * HTB, NXCD = 8, WGM = 8;
__host__ __device__ __forceinline__ int lds_byte(int r, int c) { const int st = (r >> 4) * 2 + (c >> 5), rr = r & 15, cc = c & 31, ob = rr * 64 + cc * 2; return st * 1024 + (ob ^ (((ob >> 9) & 1) << 5)); }
__host__ __device__ __forceinline__ void stage_rc(int b, int& R, int& C) { const int st = b / 1024, sb = b % 1024, swz = sb ^ (((sb >> 9) & 1) << 5); R = (st >> 1) * 16 + swz / 64; C = (st & 1) * 32 + (swz % 64) / 2; }
__host__ __device__ __forceinline__ int perm32(int rho) { const int n = rho >> 4, i = rho & 15; return 8 * (i >> 2) + 4 * n + (i & 3); }

struct Unit { int pm, pn, pz; };
struct Gemm { const gbf16* A; const gbf16* Bt; int M, N, K; size_t zA, zB; };

struct StaticOrder {
    int nM, nN, nwg, G, c;
    __device__ void init(int M, int N, int G_, int c_) { nM = M / BM; nN = N / BM; nwg = nM * nN; G = G_; c = c_; }
    __device__ bool next(int i, Unit& u) const {
        const long L = (long)i * G + c; if (L >= nwg) return false;
        int wgid = (int)L; { const int q = nwg / NXCD, r = nwg % NXCD, xcd = wgid % NXCD, off = wgid / NXCD; wgid = (xcd < r ? xcd * (q + 1) : r * (q + 1) + (xcd - r) * q) + off; }
        const int nig = WGM * nN, gid = wgid / nig, fm = gid * WGM, gsz = (nM - fm) < WGM ? (nM - fm) : WGM;
        u.pm = fm + ((wgid % nig) % gsz); u.pn = (wgid % nig) / gsz; u.pz = 0; return true;
    }
};
struct BranchOrder {
    StaticOrder b;
    __device__ bool next(int i, Unit& u) const { if (!b.next(i / 3, u)) return false; u.pz = i % 3; return true; }
};

struct EpiPlain {
    static constexpr bool PERM = true;
    gbf16* O; int ldc;
    __device__ __forceinline__ void operator()(const f32x4 (&acc)[2][2][4][2], const Unit& u, int wr, int wc, int fr, int fq, LAS unsigned char* lds, int tid) const {
        const int row0 = u.pm * BM + wr * 64 + fr, col0 = u.pn * BM + wc * 32 + 8 * fq;
#pragma unroll
        for (int ai = 0; ai < 2; ++ai)
#pragma unroll
            for (int m = 0; m < 4; ++m) { gbf16* rowp = O + (size_t)(row0 + ai * HALF + m * 16) * ldc + col0;
#pragma unroll
                for (int bj = 0; bj < 2; ++bj) { const f32x4 v0 = acc[ai][bj][m][0], v1 = acc[ai][bj][m][1];
                    u32x4 w; w.x = pk2(v0[0], v0[1]); w.y = pk2(v0[2], v0[3]); w.z = pk2(v1[0], v1[1]); w.w = pk2(v1[2], v1[3]);
                    *(gu32x4*)(rowp + bj * HALF) = w; } }
    }
};
struct EpiSwiglu {
    static constexpr bool PERM = true;
    gbf16* O;
    __device__ __forceinline__ void operator()(const f32x4 (&acc)[2][2][4][2], const Unit& u, int wr, int wc, int fr, int fq, LAS unsigned char* lds, int tid) const {
        const int row0 = u.pm * BM + wr * 64 + fr, col0 = u.pn * HALF + wc * 32 + 8 * fq;
#pragma unroll
        for (int ai = 0; ai < 2; ++ai)
#pragma unroll
            for (int m = 0; m < 4; ++m) { gbf16* rowp = O + (size_t)(row0 + ai * HALF + m * 16) * FF + col0;
                float h[8];
#pragma unroll
                for (int n = 0; n < 2; ++n)
#pragma unroll
                    for (int e = 0; e < 4; ++e) { const float g = acc[ai][0][m][n][e], uu = acc[ai][1][m][n][e]; h[n * 4 + e] = g * sigmoidf_(g) * uu; }
                u32x4 w; w.x = pk2(h[0], h[1]); w.y = pk2(h[2], h[3]); w.z = pk2(h[4], h[5]); w.w = pk2(h[6], h[7]);
                *(gu32x4*)rowp = w; }
    }
};
struct EpiGate {
    static constexpr bool PERM = true;
    const gbf16* proj; gbf16* part; gbf16* merged;
    __device__ __forceinline__ void operator()(const f32x4 (&acc)[2][2][4][2], const Unit& u, int wr, int wc, int fr, int fq, LAS unsigned char* lds, int tid) const {
        const int row0 = u.pm * BM + wr * 64 + fr, col0 = u.pn * BM + wc * 32 + 8 * fq;
        const int pz = u.pz;
        gbf16* dst = (pz == 2) ? merged : part;
#pragma unroll
        for (int ai = 0; ai < 2; ++ai) {
            u32x4 gv[4][2], pv[4][2];
#pragma unroll
            for (int m = 0; m < 4; ++m) { const size_t row = (size_t)(row0 + ai * HALF + m * 16);
#pragma unroll
                for (int bj = 0; bj < 2; ++bj) { const int col = col0 + bj * HALF;
                    gv[m][bj] = *(const gu32x4*)(proj + row * PROJ + 2048 + 1024 * pz + col);
                    if (pz != 0) pv[m][bj] = *(const gu32x4*)(part + row * DM + col); else pv[m][bj] = (u32x4){0u, 0u, 0u, 0u}; } }
            asm volatile("" ::: "memory");
#pragma unroll
            for (int m = 0; m < 4; ++m) { const size_t row = (size_t)(row0 + ai * HALF + m * 16);
#pragma unroll
                for (int bj = 0; bj < 2; ++bj) { const int col = col0 + bj * HALF; const u32x4 gw = gv[m][bj], pw = pv[m][bj];
                    f32x4 z0, z1;
                    z0[0] = sigmoidf_(bflo(gw.x)); z0[1] = sigmoidf_(bfhi(gw.x)); z0[2] = sigmoidf_(bflo(gw.y)); z0[3] = sigmoidf_(bfhi(gw.y));
                    z1[0] = sigmoidf_(bflo(gw.z)); z1[1] = sigmoidf_(bfhi(gw.z)); z1[2] = sigmoidf_(bflo(gw.w)); z1[3] = sigmoidf_(bfhi(gw.w));
                    const f32x4 q0 = {bflo(pw.x), bfhi(pw.x), bflo(pw.y), bfhi(pw.y)}, q1 = {bflo(pw.z), bfhi(pw.z), bflo(pw.w), bfhi(pw.w)};
                    z0 = z0 * acc[ai][bj][m][0] + q0; z1 = z1 * acc[ai][bj][m][1] + q1;
                    u32x4 w; w.x = pk2(z0[0], z0[1]); w.y = pk2(z0[2], z0[3]); w.z = pk2(z1[0], z1[1]); w.w = pk2(z1[2], z1[3]);
                    *(gu32x4*)(dst + row * DM + col) = w; } }
            asm volatile("" ::: "memory");
        }
    }
};


__device__ __forceinline__ float rstd_from(const gfloat* ssq, size_t row) { const f32x4 p = *(const gf32x4*)(ssq + row * 4); return 1.0f / sqrtf(((p.x + p.y) + (p.z + p.w)) * (1.0f / DM) + EPS); }
struct EpiPlainRstd {
    static constexpr bool PERM = true;
    gbf16* O; int ldc; const gfloat* ssq; int qscale;
    __device__ __forceinline__ void operator()(const f32x4 (&acc)[2][2][4][2], const Unit& u, int wr, int wc, int fr, int fq, LAS unsigned char* lds, int tid) const {
        const int row0 = u.pm * BM + wr * 64 + fr, col0 = u.pn * BM + wc * 32 + 8 * fq;
        const float tsc = !qscale ? 1.0f : (u.pn == 3 || u.pn == 4) ? 0.125f * LOG2E : (u.pn == 6 || u.pn == 7) ? 0.08838834764831845f * LOG2E : 1.0f;
        float rsv[2][4];
        { f32x4 pv_[2][4];
#pragma unroll
          for (int ai = 0; ai < 2; ++ai)
#pragma unroll
              for (int m = 0; m < 4; ++m) pv_[ai][m] = *(const gf32x4*)(ssq + (size_t)(row0 + ai * HALF + m * 16) * 4);
          asm volatile("" ::: "memory");
#pragma unroll
          for (int ai = 0; ai < 2; ++ai)
#pragma unroll
              for (int m = 0; m < 4; ++m) { const f32x4 p = pv_[ai][m]; rsv[ai][m] = __builtin_amdgcn_rsqf(((p.x + p.y) + (p.z + p.w)) * (1.0f / DM) + EPS) * tsc; } }
#pragma unroll
        for (int ai = 0; ai < 2; ++ai)
#pragma unroll
            for (int m = 0; m < 4; ++m) { const size_t row = (size_t)(row0 + ai * HALF + m * 16); const float rs = rsv[ai][m]; gbf16* rowp = O + row * ldc + col0;
#pragma unroll
                for (int bj = 0; bj < 2; ++bj) { const f32x4 v0 = acc[ai][bj][m][0] * rs, v1 = acc[ai][bj][m][1] * rs;
                    u32x4 w; w.x = pk2(v0[0], v0[1]); w.y = pk2(v0[2], v0[3]); w.z = pk2(v1[0], v1[1]); w.w = pk2(v1[2], v1[3]);
                    *(gu32x4*)(rowp + bj * HALF) = w; } }
    }
};
struct EpiSwigluRstd {
    static constexpr bool PERM = true;
    gbf16* O; const gfloat* ssq;
    __device__ __forceinline__ void operator()(const f32x4 (&acc)[2][2][4][2], const Unit& u, int wr, int wc, int fr, int fq, LAS unsigned char* lds, int tid) const {
        const int row0 = u.pm * BM + wr * 64 + fr, col0 = u.pn * HALF + wc * 32 + 8 * fq;
        float rsv[2][4];
        { f32x4 pv_[2][4];
#pragma unroll
          for (int ai = 0; ai < 2; ++ai)
#pragma unroll
              for (int m = 0; m < 4; ++m) pv_[ai][m] = *(const gf32x4*)(ssq + (size_t)(row0 + ai * HALF + m * 16) * 4);
          asm volatile("" ::: "memory");
#pragma unroll
          for (int ai = 0; ai < 2; ++ai)
#pragma unroll
              for (int m = 0; m < 4; ++m) { const f32x4 p = pv_[ai][m]; rsv[ai][m] = __builtin_amdgcn_rsqf(((p.x + p.y) + (p.z + p.w)) * (1.0f / DM) + EPS); } }
#pragma unroll
        for (int ai = 0; ai < 2; ++ai)
#pragma unroll
            for (int m = 0; m < 4; ++m) { const size_t row = (size_t)(row0 + ai * HALF + m * 16); const float rs = rsv[ai][m]; gbf16* rowp = O + row * FF + col0;
                float h[8];
#pragma unroll
                for (int n = 0; n < 2; ++n)
#pragma unroll
                    for (int e = 0; e < 4; ++e) { const float g = acc[ai][0][m][n][e] * rs, uu = acc[ai][1][m][n][e] * rs; h[n * 4 + e] = g * sigmoidf_(g) * uu; }
                u32x4 w; w.x = pk2(h[0], h[1]); w.y = pk2(h[2], h[3]); w.z = pk2(h[4], h[5]); w.w = pk2(h[6], h[7]);
                *(gu32x4*)rowp = w; }
    }
};
template <bool RES_BF16>
struct EpiResidStats {
    static constexpr bool PERM = true;
    const gfloat* resf; const gbf16* resb; gbf16* xb; gfloat* ssq; float scale;
    __device__ __forceinline__ void operator()(const f32x4 (&acc)[2][2][4][2], const Unit& u, int wr, int wc, int fr, int fq, LAS unsigned char* lds, int tid) const {
        const int row0 = u.pm * BM + wr * 64 + fr, col0 = u.pn * BM + wc * 32 + 8 * fq;
        LAS float* red = (LAS float*)(lds + LDS_RED);
#pragma unroll
        for (int ai = 0; ai < 2; ++ai) {
            f32x4 rv[4][2][2]; u32x4 rw[4][2];
#pragma unroll
            for (int m = 0; m < 4; ++m) { const size_t off = (size_t)(row0 + ai * HALF + m * 16) * DM + col0;
#pragma unroll
                for (int bj = 0; bj < 2; ++bj) {
                    if (RES_BF16) rw[m][bj] = *(const gu32x4*)(resb + off + bj * HALF);
                    else { rv[m][bj][0] = *(const gf32x4*)(resf + off + bj * HALF); rv[m][bj][1] = *(const gf32x4*)(resf + off + bj * HALF + 4); } } }
            asm volatile("" ::: "memory");
            if (RES_BF16) {
#pragma unroll
                for (int m = 0; m < 4; ++m)
#pragma unroll
                    for (int bj = 0; bj < 2; ++bj) { const u32x4 w = rw[m][bj];
                        rv[m][bj][0] = (f32x4){bflo(w.x), bfhi(w.x), bflo(w.y), bfhi(w.y)}; rv[m][bj][1] = (f32x4){bflo(w.z), bfhi(w.z), bflo(w.w), bfhi(w.w)}; } }
#pragma unroll
            for (int m = 0; m < 4; ++m) { const size_t off = (size_t)(row0 + ai * HALF + m * 16) * DM + col0; float ss = 0.f;
#pragma unroll
                for (int bj = 0; bj < 2; ++bj) { const f32x4 v0 = rv[m][bj][0] + acc[ai][bj][m][0] * scale, v1 = rv[m][bj][1] + acc[ai][bj][m][1] * scale;
                    u32x4 w; w.x = pk2(v0[0], v0[1]); w.y = pk2(v0[2], v0[3]); w.z = pk2(v1[0], v1[1]); w.w = pk2(v1[2], v1[3]);
                    *(gu32x4*)(xb + off + bj * HALF) = w;
                    ss += ((v0[0] * v0[0] + v0[1] * v0[1]) + (v0[2] * v0[2] + v0[3] * v0[3])) + ((v1[0] * v1[0] + v1[1] * v1[1]) + (v1[2] * v1[2] + v1[3] * v1[3])); }
                ss += __shfl_xor(ss, 16); ss += __shfl_xor(ss, 32);
                if (fq == 0) red[wc * 256 + ai * HALF + wr * 64 + m * 16 + fr] = ss; }
            asm volatile("" ::: "memory"); }
        asm volatile("s_waitcnt lgkmcnt(0)" ::: "memory"); __builtin_amdgcn_s_barrier(); asm volatile("" ::: "memory");
        if (tid < 256) ssq[(size_t)(u.pm * BM + tid) * 4 + u.pn] = (red[tid] + red[256 + tid]) + (red[512 + tid] + red[768 + tid]);
    }
};


struct EpiResidFinal {
    static constexpr bool PERM = true;
    const gbf16* res; gfloat* out; gfloat* ssq; unsigned* cnt; const gfloat* gain; float scale; unsigned want;
    __device__ __forceinline__ void operator()(f32x4 (&acc)[2][2][4][2], const Unit& u, int wr, int wc, int fr, int fq, LAS unsigned char* lds, int tid) const {
        const int row0 = u.pm * BM + wr * 64 + fr, col0 = u.pn * BM + wc * 32 + 8 * fq;
        LAS float* red = (LAS float*)(lds + LDS_RED);
        LAS float* rsl = (LAS float*)(lds + LDS_RED) + 1024;
#pragma unroll
        for (int ai = 0; ai < 2; ++ai) {
            f32x4 rv[4][2][2]; u32x4 rw[4][2];
#pragma unroll
            for (int m = 0; m < 4; ++m) { const size_t off = (size_t)(row0 + ai * HALF + m * 16) * DM + col0;
#pragma unroll
                for (int bj = 0; bj < 2; ++bj) rw[m][bj] = *(const gu32x4*)(res + off + bj * HALF); }
            asm volatile("" ::: "memory");
#pragma unroll
            for (int m = 0; m < 4; ++m)
#pragma unroll
                for (int bj = 0; bj < 2; ++bj) { const u32x4 w = rw[m][bj];
                    rv[m][bj][0] = (f32x4){bflo(w.x), bfhi(w.x), bflo(w.y), bfhi(w.y)}; rv[m][bj][1] = (f32x4){bflo(w.z), bfhi(w.z), bflo(w.w), bfhi(w.w)}; }
#pragma unroll
            for (int m = 0; m < 4; ++m) { float ss = 0.f;
#pragma unroll
                for (int bj = 0; bj < 2; ++bj)
#pragma unroll
                    for (int n = 0; n < 2; ++n) { const f32x4 v = rv[m][bj][n] + acc[ai][bj][m][n] * scale; acc[ai][bj][m][n] = v;
                        ss += (v[0] * v[0] + v[1] * v[1]) + (v[2] * v[2] + v[3] * v[3]); }
                ss += __shfl_xor(ss, 16); ss += __shfl_xor(ss, 32);
                if (fq == 0) red[wc * 256 + ai * HALF + wr * 64 + m * 16 + fr] = ss; }
            asm volatile("" ::: "memory"); }
        asm volatile("s_waitcnt lgkmcnt(0)" ::: "memory"); __builtin_amdgcn_s_barrier(); asm volatile("" ::: "memory");
        if (tid < 256) __hip_atomic_store(ssq + (size_t)(u.pm * BM + tid) * 4 + u.pn, (red[tid] + red[256 + tid]) + (red[512 + tid] + red[768 + tid]), __ATOMIC_RELAXED, __HIP_MEMORY_SCOPE_AGENT);
        asm volatile("s_waitcnt vmcnt(0)" ::: "memory"); __builtin_amdgcn_s_barrier(); asm volatile("" ::: "memory");
        if (tid == 0) {
            unsigned* c = cnt + 64 * u.pm;
            __hip_atomic_fetch_add(c, 1u, __ATOMIC_RELAXED, __HIP_MEMORY_SCOPE_AGENT);
            unsigned sp = 0;
            while (__hip_atomic_load(c, __ATOMIC_RELAXED, __HIP_MEMORY_SCOPE_AGENT) < want) { __builtin_amdgcn_s_sleep(1); if (++sp > (1u << 22)) break; }
            __builtin_amdgcn_fence(__ATOMIC_ACQUIRE, "agent");
        }
        asm volatile("s_waitcnt vmcnt(0) lgkmcnt(0)" ::: "memory"); __builtin_amdgcn_s_barrier(); asm volatile("" ::: "memory");
        if (tid < 256) { const gfloat* p = ssq + (size_t)(u.pm * BM + tid) * 4; f32x4 pv4;
            asm volatile("global_load_dwordx4 %0, %1, off sc0 sc1\n\ts_waitcnt vmcnt(0)" : "=v"(pv4) : "v"(p) : "memory");
            rsl[tid] = __builtin_amdgcn_rsqf(((pv4.x + pv4.y) + (pv4.z + pv4.w)) * (1.0f / DM) + EPS); }
        asm volatile("s_waitcnt vmcnt(0) lgkmcnt(0)" ::: "memory"); __builtin_amdgcn_s_barrier(); asm volatile("" ::: "memory");
        f32x4 gv[2][2];
#pragma unroll
        for (int bj = 0; bj < 2; ++bj)
#pragma unroll
            for (int n = 0; n < 2; ++n) gv[bj][n] = *(const gf32x4*)(gain + col0 + bj * HALF + n * 4);
#pragma unroll
        for (int ai = 0; ai < 2; ++ai)
#pragma unroll
            for (int m = 0; m < 4; ++m) { const int rl = ai * HALF + wr * 64 + m * 16 + fr; const float rs = rsl[rl]; const size_t off = (size_t)(u.pm * BM + rl) * DM + col0;
#pragma unroll
                for (int bj = 0; bj < 2; ++bj)
#pragma unroll
                    for (int n = 0; n < 2; ++n) *(gf32x4*)(out + off + bj * HALF + n * 4) = acc[ai][bj][m][n] * rs * gv[bj][n]; }
    }
};

template <class Epi, class Sched>
__device__ __forceinline__ void gemm_phase(LAS unsigned char* lds, const int tid, const Gemm g, const Sched& S, const Epi& E) {
    const int wid = __builtin_amdgcn_readfirstlane(tid >> 6), lane = tid & 63, wr = wid >> 2, wc = wid & 3, fr = lane & 15, fq = lane >> 4;
    const int K = g.K, nt = K / BK;
    unsigned voffA[2], voffB[2];
#pragma unroll
    for (int i = 0; i < 2; ++i) { int R, C; stage_rc(tid * 16 + i * 8192, R, C); const int Rb = Epi::PERM ? ((R & ~31) + perm32(R & 31)) : R;
        voffA[i] = (unsigned)(R * K + C) * 2u; voffB[i] = (unsigned)(Rb * K + C) * 2u; }
    const size_t kstep = (size_t)(BK * 2);
    const size_t hstep = (size_t)HALF * K * 2;
    const size_t tstep = 2 * hstep;
    const unsigned ldsw = (unsigned)wid * 1024u;
    const int aoff = lds_byte(wr * 64 + fr, fq * 8), boff = lds_byte(wc * 32 + fr, fq * 8);
#define PG8_SA(b, h) (((b) * 2 + (h)) * HTB)
#define PG8_SB(b, h) ((4 + (b) * 2 + (h)) * HTB)
#define PG8_STAGE(bufoff, gbase, voff) do { _Pragma("unroll") for (int _i = 0; _i < 2; ++_i) \
        __builtin_amdgcn_global_load_lds((const gunsigned*)((const gchar*)(gbase) + (voff)[_i]), (LAS unsigned*)(lds + (bufoff) + ldsw + _i * 8192), 16, 0, 0); } while (0)
#define PG8_LDA(dst, b, h) do { _Pragma("unroll") for (int m = 0; m < 4; ++m) _Pragma("unroll") for (int k = 0; k < 2; ++k) dst[m][k] = *(const LAS bf16x8*)(lds + PG8_SA(b, h) + aoff + m * 2048 + k * 1024); } while (0)
#define PG8_LDB(dst, b, h) do { _Pragma("unroll") for (int n = 0; n < 2; ++n) _Pragma("unroll") for (int k = 0; k < 2; ++k) dst[n][k] = *(const LAS bf16x8*)(lds + PG8_SB(b, h) + boff + n * 2048 + k * 1024); } while (0)
#define PG8_MMA(ai, bj, At, Bt) do { __builtin_amdgcn_s_setprio(1); _Pragma("unroll") for (int m = 0; m < 4; ++m) _Pragma("unroll") for (int n = 0; n < 2; ++n) _Pragma("unroll") for (int k = 0; k < 2; ++k) \
        acc[ai][bj][m][n] = __builtin_amdgcn_mfma_f32_16x16x32_bf16(Bt[n][k], At[m][k], acc[ai][bj][m][n], 0, 0, 0); __builtin_amdgcn_s_setprio(0); } while (0)
#define PG8_WAIT_V(n) asm volatile("s_waitcnt vmcnt(" #n ")" ::: "memory")
#define PG8_WAIT_L(n) asm volatile("s_waitcnt lgkmcnt(" #n ")" ::: "memory")
#define PG8_BAR __builtin_amdgcn_s_barrier()
#define PG8_SCHED __builtin_amdgcn_sched_barrier(0)
    Unit cur, nxt; int ui = 0;
    if (!S.next(0, cur)) return;
    f32x4 acc[2][2][4][2];
#pragma unroll
    for (int a = 0; a < 2; ++a)
#pragma unroll
        for (int b = 0; b < 2; ++b)
#pragma unroll
            for (int m = 0; m < 4; ++m)
#pragma unroll
                for (int n = 0; n < 2; ++n) acc[a][b][m][n] = (f32x4){0.f, 0.f, 0.f, 0.f};
    bf16x8 At[4][2], B0[2][2], B1[2][2];
    const gchar* cA = (const gchar*)g.A + (size_t)cur.pm * tstep + (size_t)cur.pz * g.zA; const gchar* cB = (const gchar*)g.Bt + (size_t)cur.pn * tstep + (size_t)cur.pz * g.zB;
    PG8_STAGE(PG8_SB(0, 0), cB, voffB); PG8_STAGE(PG8_SB(0, 1), cB + hstep, voffB); PG8_STAGE(PG8_SA(0, 0), cA, voffA); PG8_STAGE(PG8_SA(0, 1), cA + hstep, voffA);
    if (wr == 1) PG8_BAR;
    PG8_WAIT_V(2); PG8_BAR;
    PG8_STAGE(PG8_SB(1, 0), cB + kstep, voffB); PG8_STAGE(PG8_SA(1, 0), cA + kstep, voffA); PG8_STAGE(PG8_SB(1, 1), cB + hstep + kstep, voffB);
    PG8_WAIT_V(6); PG8_BAR;
    for (;;) {
        const bool has_next = S.next(ui + 1, nxt);
        const gchar* nA = has_next ? (const gchar*)g.A + (size_t)nxt.pm * tstep + (size_t)nxt.pz * g.zA : cA;
        const gchar* nB = has_next ? (const gchar*)g.Bt + (size_t)nxt.pn * tstep + (size_t)nxt.pz * g.zB : cB;
        for (int t = 0; t < nt; t += 2) {
            const bool last = (t == nt - 2);
            const gchar* a1 = cA + (size_t)(t + 1) * kstep;
            const gchar* a2 = last ? nA : cA + (size_t)(t + 2) * kstep; const gchar* b2 = last ? nB : cB + (size_t)(t + 2) * kstep;
            const gchar* a3 = a2 + kstep; const gchar* b3 = b2 + kstep;
            PG8_LDB(B0, 0, 0); PG8_LDB(B1, 0, 1); PG8_SCHED; PG8_LDA(At, 0, 0); PG8_STAGE(PG8_SA(1, 1), a1 + hstep, voffA);
            PG8_WAIT_V(8); PG8_WAIT_L(0); PG8_BAR; PG8_MMA(0, 0, At, B0); PG8_MMA(0, 1, At, B1); PG8_BAR; PG8_SCHED;
            PG8_LDA(At, 0, 1); PG8_STAGE(PG8_SB(0, 0), b2, voffB); PG8_STAGE(PG8_SB(0, 1), b2 + hstep, voffB); PG8_STAGE(PG8_SA(0, 0), a2, voffA);
            PG8_WAIT_V(8); PG8_WAIT_L(0); PG8_BAR; PG8_MMA(1, 0, At, B0); PG8_MMA(1, 1, At, B1); PG8_BAR; PG8_SCHED;
            PG8_LDB(B0, 1, 0); PG8_LDB(B1, 1, 1); PG8_SCHED; PG8_LDA(At, 1, 0); PG8_STAGE(PG8_SA(0, 1), a2 + hstep, voffA);
            PG8_WAIT_V(8); PG8_WAIT_L(0); PG8_BAR; PG8_MMA(0, 0, At, B0); PG8_MMA(0, 1, At, B1); PG8_BAR; PG8_SCHED;
            PG8_LDA(At, 1, 1); PG8_STAGE(PG8_SB(1, 0), b3, voffB); PG8_STAGE(PG8_SB(1, 1), b3 + hstep, voffB); PG8_STAGE(PG8_SA(1, 0), a3, voffA);
            PG8_WAIT_V(8); PG8_WAIT_L(0); PG8_BAR; PG8_MMA(1, 0, At, B0); PG8_MMA(1, 1, At, B1); PG8_BAR; PG8_SCHED;
        }
        if (wr == 0) PG8_BAR;
        E(acc, cur, wr, wc, fr, fq, lds, tid);
        if (!has_next) break;
#pragma unroll
        for (int a = 0; a < 2; ++a)
#pragma unroll
            for (int b = 0; b < 2; ++b)
#pragma unroll
                for (int m = 0; m < 4; ++m)
#pragma unroll
                    for (int n = 0; n < 2; ++n) acc[a][b][m][n] = (f32x4){0.f, 0.f, 0.f, 0.f};
        cur = nxt; cA = nA; cB = nB; ++ui;
        if (wr == 1) PG8_BAR;
    }
    PG8_WAIT_V(0);
    PG8_BAR;
#undef PG8_SA
#undef PG8_SB
#undef PG8_STAGE
#undef PG8_LDA
#undef PG8_LDB
#undef PG8_MMA
#undef PG8_WAIT_V
#undef PG8_WAIT_L
#undef PG8_BAR
#undef PG8_SCHED
}
}

constexpr int ATT_BIAS_OFF = 110592;
template <int HD, int MODE>
__device__ __forceinline__ void attn_unit(LAS unsigned char* lds, const int tid_in, const gbf16* Qg, int q_pitch, const gbf16* Kg, int k_pitch,
                                          const gbf16* Vtg, int vt_pitch, gbf16* Og, int o_pitch, int t0, int t1, float c,
                                          int q0, const gfloat* biasg, float m_init, float l_init, const gfloat* qgain, const gf32x2* ropet) {
    constexpr int KROW = HD * 2 + 16, VROW = 144, KBYTES = 64 * KROW, VBYTES = HD * VROW, BUF = KBYTES + VBYTES, NP = HD / 64;
    static_assert(3 * BUF <= ATT_BIAS_OFF, "attention LDS");
    int tid = tid_in; asm volatile("" : "+v"(tid));
    const int lane = tid & 63, wid = __builtin_amdgcn_readfirstlane(tid >> 6), r32 = lane & 31, hi = lane >> 5;
    bf16x8 qf[HD / 16];
    { const gbf16* qrow = Qg + (size_t)(wid * 32 + r32) * q_pitch + hi * 8;
      u32x4 qraw[HD / 16]; f32x4 gq[HD / 16][2], cs[HD / 16][2];
      const int pos = q0 + wid * 32 + r32;
#pragma unroll
      for (int d0 = 0; d0 < HD / 16; ++d0) { qraw[d0] = *(const gu32x4*)(qrow + d0 * 16);
          const gf32x4* gp_ = (const gf32x4*)(qgain + 16 * d0 + 8 * hi); gq[d0][0] = gp_[0]; gq[d0][1] = gp_[1];
          const gf32x4* rp_ = (const gf32x4*)(ropet + ((d0 < HD / 32) ? (pos >> 6) : (pos & 63)) * 16 + 8 * (d0 % (HD / 32)) + 4 * hi); cs[d0][0] = rp_[0]; cs[d0][1] = rp_[1]; }
      float x[HD / 16][8]; float ss = 0.f;
#pragma unroll
      for (int d0 = 0; d0 < HD / 16; ++d0) { const u32x4 v = qraw[d0];
          x[d0][0] = bflo(v.x); x[d0][1] = bfhi(v.x); x[d0][2] = bflo(v.y); x[d0][3] = bfhi(v.y); x[d0][4] = bflo(v.z); x[d0][5] = bfhi(v.z); x[d0][6] = bflo(v.w); x[d0][7] = bfhi(v.w);
#pragma unroll
          for (int e = 0; e < 8; ++e) ss += x[d0][e] * x[d0][e]; }
      { auto rr = __builtin_amdgcn_permlane32_swap(__float_as_uint(ss), __float_as_uint(ss), false, false); ss = __uint_as_float(rr[0]) + __uint_as_float(rr[1]); }
      const float rstd = (1.0f / sqrtf(ss * (1.0f / HD) + EPS)) * c;
#pragma unroll
      for (int d0 = 0; d0 < HD / 16; ++d0) {
          float y[8];
#pragma unroll
          for (int p = 0; p < 4; ++p) { const float a = x[d0][2 * p] * rstd * gq[d0][p >> 1][2 * (p & 1)], b = x[d0][2 * p + 1] * rstd * gq[d0][p >> 1][2 * (p & 1) + 1];
              const float co = cs[d0][p >> 1][2 * (p & 1)], si = cs[d0][p >> 1][2 * (p & 1) + 1];
              y[2 * p] = a * co - b * si; y[2 * p + 1] = a * si + b * co; }
          u32x4 w; w.x = pk2(y[0], y[1]); w.y = pk2(y[2], y[3]); w.z = pk2(y[4], y[5]); w.w = pk2(y[6], y[7]); qf[d0] = __builtin_bit_cast(bf16x8, w); } }
    u32x4 kstA[NP], vstA[NP], kstB[NP], vstB[NP];
    unsigned kgo[NP], vgo[NP], kl[NP], vl[NP];
#pragma unroll
    for (int p = 0; p < NP; ++p) { const int idx = tid + 512 * p; const int krow = idx / (HD / 8), kch = idx % (HD / 8), vd = idx >> 3, vch = idx & 7;
        kgo[p] = (unsigned)(krow * k_pitch + kch * 8) * 2u; vgo[p] = (unsigned)(vd * vt_pitch + vch * 8) * 2u;
        kl[p] = krow * KROW + kch * 16; vl[p] = KBYTES + vd * VROW + vch * 16; }
#define ATT_LOAD(t, KS, VS) do { const gchar* kb0_ = (const gchar*)(Kg + (size_t)(t) * 64 * k_pitch); const gchar* vb0_ = (const gchar*)(Vtg + (t) * 64); \
        _Pragma("unroll") for (int p = 0; p < NP; ++p) { KS[p] = *(const gu32x4*)(kb0_ + kgo[p]); VS[p] = *(const gu32x4*)(vb0_ + vgo[p]); } } while (0)
#define ATT_STORE(boff, KS, VS) do { _Pragma("unroll") for (int p = 0; p < NP; ++p) { *(LAS u32x4*)(lds + (boff) + kl[p]) = KS[p]; *(LAS u32x4*)(lds + (boff) + vl[p]) = VS[p]; } } while (0)
#define ATT_QK(S0, S1, boff) do { const LAS unsigned char* kb_ = lds + (boff) + krd; \
        _Pragma("unroll") for (int r = 0; r < 16; ++r) { S0[r] = 0.f; S1[r] = 0.f; } \
        _Pragma("unroll") for (int d0 = 0; d0 < HD / 16; ++d0) { \
            const bf16x8 k0_ = *(const LAS bf16x8*)(kb_ + d0 * 32); const bf16x8 k1_ = *(const LAS bf16x8*)(kb_ + 32 * KROW + d0 * 32); \
            S0 = __builtin_amdgcn_mfma_f32_32x32x16_bf16(k0_, qf[d0], S0, 0, 0, 0); S1 = __builtin_amdgcn_mfma_f32_32x32x16_bf16(k1_, qf[d0], S1, 0, 0, 0); } } while (0)
    const int pr = (r32 & 0x13) | ((r32 & 4) << 1) | ((r32 & 8) >> 1);
    const unsigned krd = pr * KROW + hi * 16, vrd = KBYTES + r32 * VROW + hi * 16;
    f32x16 o[HD / 32];
#pragma unroll
    for (int d0 = 0; d0 < HD / 32; ++d0)
#pragma unroll
        for (int r = 0; r < 16; ++r) o[d0][r] = 0.f;
    float m_run = m_init, l_run = l_init;
    const LAS float* biasl = (const LAS float*)(lds + ATT_BIAS_OFF);
    const int qpos = q0 + wid * 32 + r32;
    __syncthreads();
    ATT_LOAD(t0, kstA, vstA); if (t0 + 1 < t1) ATT_LOAD(t0 + 1, kstB, vstB);
    ATT_STORE(0, kstA, vstA); if (t0 + 1 < t1) ATT_STORE(BUF, kstB, vstB);
    if (t0 + 2 < t1) ATT_LOAD(t0 + 2, kstA, vstA);
    if (MODE == 1) { if (tid < 257) ((LAS float*)(lds + ATT_BIAS_OFF))[tid] = biasg[tid]; }
    __syncthreads();
    int bc = 0, bn = BUF, bw = 2 * BUF;
    f32x16 sa0, sa1, sb0, sb1, negm;
    ATT_QK(sa0, sa1, 0);
    { float mx0 = fmaxf(sa0[0], sa1[0]);
#pragma unroll
      for (int r = 1; r < 16; ++r) mx0 = fmaxf(fmaxf(mx0, sa0[r]), sa1[r]);
      { auto rr = __builtin_amdgcn_permlane32_swap(__float_as_uint(mx0), __float_as_uint(mx0), false, false); mx0 = fmaxf(__uint_as_float(rr[0]), __uint_as_float(rr[1])); }
      m_run = mx0;
#pragma unroll
      for (int r = 0; r < 16; ++r) { sa0[r] -= mx0; sa1[r] -= mx0; negm[r] = -mx0; } }
#define ATT_SB() __builtin_amdgcn_sched_barrier(0)
#define ATT_STEP(SC0, SC1, SN0, SN1, t, KL, VL, KSt, VSt) do { \
        const bool has2_ = ((t) + 2 < t1); \
        if ((t) > t0) __syncthreads(); \
        if ((t) + 3 < t1) ATT_LOAD((t) + 3, KL, VL); \
        ATT_SB(); \
          \
        bf16x8 kf0_[HD / 16], kf1_[HD / 16]; \
        { const LAS unsigned char* kb_ = lds + bn + krd; \
          _Pragma("unroll") for (int d0 = 0; d0 < HD / 16; ++d0) { kf0_[d0] = *(const LAS bf16x8*)(kb_ + d0 * 32); kf1_[d0] = *(const LAS bf16x8*)(kb_ + 32 * KROW + d0 * 32); } } \
        ATT_SB(); \
          \
        float mx_ = fmaxf(SC0[0], SC1[0]); \
        _Pragma("unroll") for (int r = 1; r < 16; ++r) mx_ = fmaxf(fmaxf(mx_, SC0[r]), SC1[r]); \
        { auto rr = __builtin_amdgcn_permlane32_swap(__float_as_uint(mx_), __float_as_uint(mx_), false, false); mx_ = fmaxf(__uint_as_float(rr[0]), __uint_as_float(rr[1])); } \
        if (__any(mx_ > 4.0f)) { \
            const float dl_ = fmaxf(mx_, 0.f); const float al_ = __builtin_amdgcn_exp2f(-dl_); \
            m_run += dl_; l_run *= al_; \
            _Pragma("unroll") for (int r = 0; r < 16; ++r) { SC0[r] -= dl_; SC1[r] -= dl_; } \
            _Pragma("unroll") for (int d0 = 0; d0 < HD / 32; ++d0) _Pragma("unroll") for (int r = 0; r < 16; ++r) o[d0][r] *= al_; \
            _Pragma("unroll") for (int r = 0; r < 16; ++r) negm[r] = -m_run; } \
        ATT_SB(); \
          \
        __builtin_amdgcn_s_setprio(1); \
        SN0 = __builtin_amdgcn_mfma_f32_32x32x16_bf16(kf0_[0], qf[0], negm, 0, 0, 0); SN1 = __builtin_amdgcn_mfma_f32_32x32x16_bf16(kf1_[0], qf[0], negm, 0, 0, 0); \
        _Pragma("unroll") for (int d0 = 1; d0 < HD / 16; ++d0) { \
            SN0 = __builtin_amdgcn_mfma_f32_32x32x16_bf16(kf0_[d0], qf[d0], SN0, 0, 0, 0); SN1 = __builtin_amdgcn_mfma_f32_32x32x16_bf16(kf1_[d0], qf[d0], SN1, 0, 0, 0); } \
        float rs_ = 0.f; \
        _Pragma("unroll") for (int r = 0; r < 16; ++r) { SC0[r] = __builtin_amdgcn_exp2f(SC0[r]); rs_ += SC0[r]; } \
        bf16x8 pf_[4]; \
        { u32x4 w; \
          w.x = pk2(SC0[0], SC0[1]); w.y = pk2(SC0[2], SC0[3]); w.z = pk2(SC0[4], SC0[5]); w.w = pk2(SC0[6], SC0[7]); pf_[0] = __builtin_bit_cast(bf16x8, w); \
          w.x = pk2(SC0[8], SC0[9]); w.y = pk2(SC0[10], SC0[11]); w.z = pk2(SC0[12], SC0[13]); w.w = pk2(SC0[14], SC0[15]); pf_[1] = __builtin_bit_cast(bf16x8, w); } \
        _Pragma("unroll") for (int g_ = 0; g_ < HD / 8; ++g_) { \
            __builtin_amdgcn_sched_group_barrier(0x008, 1, 0); __builtin_amdgcn_sched_group_barrier(0x400, 2, 0); __builtin_amdgcn_sched_group_barrier(0x002, 5, 0); } \
        ATT_SB(); \
        __builtin_amdgcn_s_setprio(0); \
          \
        bf16x8 vf_[HD / 32][4]; \
        { const LAS unsigned char* vb_ = lds + bc + vrd; \
          _Pragma("unroll") for (int d0 = 0; d0 < HD / 32; ++d0) _Pragma("unroll") for (int kk = 0; kk < 4; ++kk) vf_[d0][kk] = *(const LAS bf16x8*)(vb_ + d0 * 32 * VROW + kk * 32); } \
        ATT_SB(); \
          \
        _Pragma("unroll") for (int r = 0; r < 16; ++r) { SC1[r] = __builtin_amdgcn_exp2f(SC1[r]); rs_ += SC1[r]; } \
        { u32x4 w; \
          w.x = pk2(SC1[0], SC1[1]); w.y = pk2(SC1[2], SC1[3]); w.z = pk2(SC1[4], SC1[5]); w.w = pk2(SC1[6], SC1[7]); pf_[2] = __builtin_bit_cast(bf16x8, w); \
          w.x = pk2(SC1[8], SC1[9]); w.y = pk2(SC1[10], SC1[11]); w.z = pk2(SC1[12], SC1[13]); w.w = pk2(SC1[14], SC1[15]); pf_[3] = __builtin_bit_cast(bf16x8, w); } \
        l_run += rs_; \
        ATT_SB(); \
          \
        __builtin_amdgcn_s_setprio(1); \
        _Pragma("unroll") for (int d0 = 0; d0 < HD / 32; ++d0) _Pragma("unroll") for (int kk = 0; kk < 4; ++kk) \
            o[d0] = __builtin_amdgcn_mfma_f32_32x32x16_bf16(vf_[d0][kk], pf_[kk], o[d0], 0, 0, 0); \
        ATT_SB(); \
        __builtin_amdgcn_s_setprio(0); \
        if (has2_) ATT_STORE(bw, KSt, VSt); \
        { const int tmp_ = bc; bc = bn; bn = bw; bw = tmp_; } \
    } while (0)
    int t = t0;
    for (; t + 1 < t1; t += 2) { ATT_STEP(sa0, sa1, sb0, sb1, t, kstB, vstB, kstA, vstA); ATT_STEP(sb0, sb1, sa0, sa1, t + 1, kstA, vstA, kstB, vstB); }
    if (t < t1) ATT_STEP(sa0, sa1, sb0, sb1, t, kstB, vstB, kstA, vstA);
    float l_tot; { auto rr = __builtin_amdgcn_permlane32_swap(__float_as_uint(l_run), __float_as_uint(l_run), false, false); l_tot = __uint_as_float(rr[0]) + __uint_as_float(rr[1]); }
    const float inv = 1.0f / l_tot;
    gbf16* orow = Og + (size_t)(wid * 32 + r32) * o_pitch + 4 * hi;
#pragma unroll
    for (int d0 = 0; d0 < HD / 32; ++d0)
#pragma unroll
        for (int rq = 0; rq < 4; ++rq) { u32x2 w; w.x = pk2(o[d0][4 * rq] * inv, o[d0][4 * rq + 1] * inv); w.y = pk2(o[d0][4 * rq + 2] * inv, o[d0][4 * rq + 3] * inv);
            *(gu32x2*)(orow + 32 * d0 + 8 * rq) = w; }
#undef ATT_STEP
#undef ATT_SB
#undef ATT_QK
#undef ATT_LOAD
#undef ATT_STORE
}

template <int HD, int MODE>
__device__ __forceinline__ void attn_unit_np(LAS unsigned char* lds, const int tid_in, const gbf16* Qg, int q_pitch, const gbf16* Kg, int k_pitch,
                                          const gbf16* Vtg, int vt_pitch, gbf16* Og, int o_pitch, int t0, int t1, float c,
                                          int q0, const gfloat* biasg, float m_init, float l_init) {
    constexpr int KROW = HD * 2 + 16, VROW = 144, KBYTES = 64 * KROW, VBYTES = HD * VROW, BUF = KBYTES + VBYTES, NP = HD / 64;
    static_assert(2 * BUF <= ATT_BIAS_OFF, "attention LDS");
    int tid = tid_in; asm volatile("" : "+v"(tid));
    const int lane = tid & 63, wid = __builtin_amdgcn_readfirstlane(tid >> 6), r32 = lane & 31, hi = lane >> 5;
    bf16x8 qf[HD / 16];
    { const gbf16* qrow = Qg + (size_t)(wid * 32 + r32) * q_pitch + hi * 8;
#pragma unroll
      for (int d0 = 0; d0 < HD / 16; ++d0) qf[d0] = *(const gbf16x8*)(qrow + d0 * 16); }
    u32x4 kst[NP], vst[NP];
    const gbf16* kg[NP]; const gbf16* vg[NP]; unsigned kl[NP], vl[NP];
#pragma unroll
    for (int p = 0; p < NP; ++p) { const int idx = tid + 512 * p; const int krow = idx / (HD / 8), kch = idx % (HD / 8), vd = idx >> 3, vch = idx & 7;
        kg[p] = Kg + (size_t)krow * k_pitch + kch * 8; vg[p] = Vtg + (size_t)vd * vt_pitch + vch * 8;
        kl[p] = krow * KROW + kch * 16; vl[p] = KBYTES + vd * VROW + vch * 16; }
#define ATT_LOAD(t) do { _Pragma("unroll") for (int p = 0; p < NP; ++p) { kst[p] = *(const gu32x4*)(kg[p] + (size_t)(t) * 64 * k_pitch); vst[p] = *(const gu32x4*)(vg[p] + (t) * 64); } } while (0)
#define ATT_STORE(b) do { _Pragma("unroll") for (int p = 0; p < NP; ++p) { *(LAS u32x4*)(lds + (b) * BUF + kl[p]) = kst[p]; *(LAS u32x4*)(lds + (b) * BUF + vl[p]) = vst[p]; } } while (0)
    const int pr = (r32 & 0x13) | ((r32 & 4) << 1) | ((r32 & 8) >> 1);
    const unsigned krd = pr * KROW + hi * 16, vrd = KBYTES + r32 * VROW + hi * 16;
    f32x16 o[HD / 32];
#pragma unroll
    for (int d0 = 0; d0 < HD / 32; ++d0)
#pragma unroll
        for (int r = 0; r < 16; ++r) o[d0][r] = 0.f;
    float m_run = m_init, l_run = l_init;
    const LAS float* biasl = (const LAS float*)(lds + ATT_BIAS_OFF);
    __syncthreads();
    ATT_LOAD(t0); ATT_STORE(0);
    if (MODE == 1) { ((LAS float*)(lds + ATT_BIAS_OFF))[tid] = biasg[tid]; if (tid < 256) ((LAS float*)(lds + ATT_BIAS_OFF))[512 + tid] = biasg[512 + tid]; }
    int cur = 0;
    const int qlo = q0 + wid * 32;
    for (int t = t0; t < t1; ++t) {
        __syncthreads();
        const bool more = (t + 1 < t1);
        if (more) ATT_LOAD(t + 1);
        bool active = true;
        if (MODE == 1) active = !(64 * t + 63 < qlo - 128 || 64 * t > qlo + 31 + 128);
        if (active) {
            const LAS unsigned char* kb = lds + cur * BUF + krd;
            const LAS unsigned char* vb = lds + cur * BUF + vrd;
            f32x16 s0, s1;
#pragma unroll
            for (int r = 0; r < 16; ++r) { s0[r] = 0.f; s1[r] = 0.f; }
            if constexpr (HD == 64) {
                bf16x8 kf0[HD / 16], kf1[HD / 16];
#pragma unroll
                for (int d0 = 0; d0 < HD / 16; ++d0) { kf0[d0] = *(const LAS bf16x8*)(kb + d0 * 32); kf1[d0] = *(const LAS bf16x8*)(kb + 32 * KROW + d0 * 32); }
                __builtin_amdgcn_sched_barrier(0);
#pragma unroll
                for (int d0 = 0; d0 < HD / 16; ++d0) { s0 = __builtin_amdgcn_mfma_f32_32x32x16_bf16(kf0[d0], qf[d0], s0, 0, 0, 0); s1 = __builtin_amdgcn_mfma_f32_32x32x16_bf16(kf1[d0], qf[d0], s1, 0, 0, 0); }
            } else {
#pragma unroll
            for (int d0 = 0; d0 < HD / 16; ++d0) {
                const bf16x8 k0 = *(const LAS bf16x8*)(kb + d0 * 32);
                const bf16x8 k1 = *(const LAS bf16x8*)(kb + 32 * KROW + d0 * 32);
                s0 = __builtin_amdgcn_mfma_f32_32x32x16_bf16(k0, qf[d0], s0, 0, 0, 0);
                s1 = __builtin_amdgcn_mfma_f32_32x32x16_bf16(k1, qf[d0], s1, 0, 0, 0);
            } }
            if (MODE == 1) {
                const LAS float* bl = biasl + (64 * t + 8 * hi - (qlo + r32) + 384);
#pragma unroll
                for (int r = 0; r < 16; ++r) { s0[r] += bl[16 * (r >> 3) + (r & 7)]; s1[r] += bl[32 + 16 * (r >> 3) + (r & 7)]; }
            }
            float mx = fmaxf(s0[0], s1[0]);
#pragma unroll
            for (int r = 1; r < 16; ++r) mx = fmaxf(mx, fmaxf(s0[r], s1[r]));
            { auto rr = __builtin_amdgcn_permlane32_swap(__float_as_uint(mx), __float_as_uint(mx), false, false); mx = fmaxf(__uint_as_float(rr[0]), __uint_as_float(rr[1])); }
            const float m_new = fmaxf(m_run, mx);
            const bool grew = __any(m_new > m_run);
            const float alpha = __builtin_amdgcn_exp2f(m_run - m_new);
            m_run = m_new;
            float rs = 0.f;
#pragma unroll
            for (int r = 0; r < 16; ++r) { s0[r] = __builtin_amdgcn_exp2f(s0[r] - m_new); s1[r] = __builtin_amdgcn_exp2f(s1[r] - m_new); rs += s0[r] + s1[r]; }
            l_run = l_run * alpha + rs;
            if (grew) {
#pragma unroll
                for (int d0 = 0; d0 < HD / 32; ++d0)
#pragma unroll
                    for (int r = 0; r < 16; ++r) o[d0][r] *= alpha;
            }
            bf16x8 pf[4];
            { u32x4 w;
              w.x = pk2(s0[0], s0[1]); w.y = pk2(s0[2], s0[3]); w.z = pk2(s0[4], s0[5]); w.w = pk2(s0[6], s0[7]); pf[0] = __builtin_bit_cast(bf16x8, w);
              w.x = pk2(s0[8], s0[9]); w.y = pk2(s0[10], s0[11]); w.z = pk2(s0[12], s0[13]); w.w = pk2(s0[14], s0[15]); pf[1] = __builtin_bit_cast(bf16x8, w);
              w.x = pk2(s1[0], s1[1]); w.y = pk2(s1[2], s1[3]); w.z = pk2(s1[4], s1[5]); w.w = pk2(s1[6], s1[7]); pf[2] = __builtin_bit_cast(bf16x8, w);
              w.x = pk2(s1[8], s1[9]); w.y = pk2(s1[10], s1[11]); w.z = pk2(s1[12], s1[13]); w.w = pk2(s1[14], s1[15]); pf[3] = __builtin_bit_cast(bf16x8, w); }
            if constexpr (HD == 64) {
                bf16x8 vfr[HD / 32][4];
#pragma unroll
                for (int d0 = 0; d0 < HD / 32; ++d0)
#pragma unroll
                    for (int kk = 0; kk < 4; ++kk) vfr[d0][kk] = *(const LAS bf16x8*)(vb + d0 * 32 * VROW + kk * 32);
                __builtin_amdgcn_sched_barrier(0);
#pragma unroll
                for (int d0 = 0; d0 < HD / 32; ++d0)
#pragma unroll
                    for (int kk = 0; kk < 4; ++kk) o[d0] = __builtin_amdgcn_mfma_f32_32x32x16_bf16(vfr[d0][kk], pf[kk], o[d0], 0, 0, 0);
            } else {
#pragma unroll
            for (int d0 = 0; d0 < HD / 32; ++d0)
#pragma unroll
                for (int kk = 0; kk < 4; ++kk) {
                    const bf16x8 vf = *(const LAS bf16x8*)(vb + d0 * 32 * VROW + kk * 32);
                    o[d0] = __builtin_amdgcn_mfma_f32_32x32x16_bf16(vf, pf[kk], o[d0], 0, 0, 0);
                } }
        }
        if (more) ATT_STORE(cur ^ 1);
        cur ^= 1;
    }
    float l_tot; { auto rr = __builtin_amdgcn_permlane32_swap(__float_as_uint(l_run), __float_as_uint(l_run), false, false); l_tot = __uint_as_float(rr[0]) + __uint_as_float(rr[1]); }
    const float inv = 1.0f / l_tot;
    gbf16* orow = Og + (size_t)(wid * 32 + r32) * o_pitch + 4 * hi;
#pragma unroll
    for (int d0 = 0; d0 < HD / 32; ++d0)
#pragma unroll
        for (int rq = 0; rq < 4; ++rq) { u32x2 w; w.x = pk2(o[d0][4 * rq] * inv, o[d0][4 * rq + 1] * inv); w.y = pk2(o[d0][4 * rq + 2] * inv, o[d0][4 * rq + 3] * inv);
            *(gu32x2*)(orow + 32 * d0 + 8 * rq) = w; }
#undef ATT_LOAD
#undef ATT_STORE
}

__device__ __forceinline__ void rms_row_bf16(const gfloat* src, const gfloat* gain, gbf16* dst, int lane) {
    const gf32x4* xr = (const gf32x4*)src + lane; const gf32x4* gr = (const gf32x4*)gain + lane;
    f32x4 v[4]; float s = 0.f;
#pragma unroll
    for (int j = 0; j < 4; ++j) { v[j] = xr[64 * j]; s += (v[j].x * v[j].x + v[j].y * v[j].y) + (v[j].z * v[j].z + v[j].w * v[j].w); }
    const float rstd = 1.0f / sqrtf(wave_sum(s) * (1.0f / DM) + EPS);
    gu32x2* o8 = (gu32x2*)dst + lane;
#pragma unroll
    for (int j = 0; j < 4; ++j) { const f32x4 g = gr[64 * j]; u32x2 w; w.x = pk2(v[j].x * rstd * g.x, v[j].y * rstd * g.y); w.y = pk2(v[j].z * rstd * g.z, v[j].w * rstd * g.w); o8[64 * j] = w; }
}
__device__ __forceinline__ void rms_row2_bf16(const gfloat* src0, const gfloat* src1, const gfloat* gain, gbf16* dst0, gbf16* dst1, int lane) {
    const gf32x4* x0 = (const gf32x4*)src0 + lane; const gf32x4* x1 = (const gf32x4*)src1 + lane; const gf32x4* gr = (const gf32x4*)gain + lane;
    f32x4 v[4], w[4], g[4]; float s = 0.f, t = 0.f;
#pragma unroll
    for (int j = 0; j < 4; ++j) { v[j] = x0[64 * j]; w[j] = x1[64 * j]; g[j] = gr[64 * j]; }
    asm volatile("" ::: "memory");
#pragma unroll
    for (int j = 0; j < 4; ++j) { s += (v[j].x * v[j].x + v[j].y * v[j].y) + (v[j].z * v[j].z + v[j].w * v[j].w); t += (w[j].x * w[j].x + w[j].y * w[j].y) + (w[j].z * w[j].z + w[j].w * w[j].w); }
#pragma unroll
    for (int o = 1; o < 64; o <<= 1) { s += __shfl_xor(s, o); t += __shfl_xor(t, o); }
    const float r0 = __builtin_amdgcn_rsqf(s * (1.0f / DM) + EPS), r1 = __builtin_amdgcn_rsqf(t * (1.0f / DM) + EPS);
    gu32x2* o0 = (gu32x2*)dst0 + lane; gu32x2* o1 = (gu32x2*)dst1 + lane;
#pragma unroll
    for (int j = 0; j < 4; ++j) { u32x2 a, b;
        a.x = pk2(v[j].x * r0 * g[j].x, v[j].y * r0 * g[j].y); a.y = pk2(v[j].z * r0 * g[j].z, v[j].w * r0 * g[j].w); o0[64 * j] = a;
        b.x = pk2(w[j].x * r1 * g[j].x, w[j].y * r1 * g[j].y); b.y = pk2(w[j].z * r1 * g[j].z, w[j].w * r1 * g[j].w); o1[64 * j] = b; }
}
__device__ __forceinline__ void final_row2(gfloat* p0, gfloat* p1, const gfloat* gain, float rs0, float rs1, int lane) {
    gf32x4* x0 = (gf32x4*)p0 + lane; gf32x4* x1 = (gf32x4*)p1 + lane; const gf32x4* gr = (const gf32x4*)gain + lane;
    f32x4 v[4], w[4];
#pragma unroll
    for (int j = 0; j < 4; ++j) { v[j] = x0[64 * j]; w[j] = x1[64 * j]; }
#pragma unroll
    for (int j = 0; j < 4; ++j) { const f32x4 g = gr[64 * j]; x0[64 * j] = v[j] * rs0 * g; x1[64 * j] = w[j] * rs1 * g; }
}
__device__ __forceinline__ float rstd_row(const gfloat* ssq, int row) { const f32x4 p = *(const gf32x4*)(ssq + (size_t)row * 4); return 1.0f / sqrtf(((p.x + p.y) + (p.z + p.w)) * (1.0f / DM) + EPS); }
__device__ __forceinline__ void final_row(gfloat* p, const gfloat* gain, float rstd, int lane) {
    gf32x4* xr = (gf32x4*)p + lane; const gf32x4* gr = (const gf32x4*)gain + lane;
    f32x4 v[4];
#pragma unroll
    for (int j = 0; j < 4; ++j) v[j] = xr[64 * j];
#pragma unroll
    for (int j = 0; j < 4; ++j) { const f32x4 g = gr[64 * j]; xr[64 * j] = v[j] * rstd * g; }
}
__device__ __forceinline__ void transpose_item(const gfloat* W, int K, int N, gbf16* WT, int mode, LAS float* scr, int item, int lane, const gfloat* gain = nullptr) {
    const int nblk = N / 32, kb = item / nblk, nb = item % nblk, k0 = 64 * kb, n0 = 32 * nb;
#pragma unroll 8
    for (int i = 0; i < 32; ++i) { const int kk = 2 * i + (lane >> 5); float w = W[(size_t)(k0 + kk) * N + n0 + (lane & 31)]; if (gain) w *= gain[k0 + kk]; scr[kk * 33 + (lane & 31)] = w; }
    asm volatile("s_waitcnt lgkmcnt(0)" ::: "memory");
    int r0 = n0;
    if (mode == 1) { const int half = n0 >= FF ? 1 : 0, np = n0 - FF * half; r0 = 256 * (np / 128) + 128 * half + (np % 128); }
    const int c = lane & 7;
#pragma unroll
    for (int j = 0; j < 4; ++j) { const int n = (lane >> 3) + 8 * j; const LAS float* s = scr + (8 * c) * 33 + n;
        u32x4 o; o.x = pk2(s[0 * 33], s[1 * 33]); o.y = pk2(s[2 * 33], s[3 * 33]); o.z = pk2(s[4 * 33], s[5 * 33]); o.w = pk2(s[6 * 33], s[7 * 33]);
        *(gu32x4*)(WT + (size_t)(r0 + n) * K + k0 + 8 * c) = o; }
    asm volatile("s_waitcnt lgkmcnt(0)" ::: "memory");
}
__device__ __forceinline__ void transpose64_bf16(const gbf16* src, size_t src_pitch, gbf16* dst, size_t dst_pitch, LAS unsigned short* scr, int lane) {
#pragma unroll
    for (int p = 0; p < 8; ++p) { const int row = 8 * p + (lane >> 3), ch = lane & 7; const u32x4 v = *(const gu32x4*)(src + (size_t)row * src_pitch + 8 * ch);
        LAS unsigned short* d = scr + row * 66 + 8 * ch;
        d[0] = (unsigned short)v.x; d[1] = (unsigned short)(v.x >> 16); d[2] = (unsigned short)v.y; d[3] = (unsigned short)(v.y >> 16);
        d[4] = (unsigned short)v.z; d[5] = (unsigned short)(v.z >> 16); d[6] = (unsigned short)v.w; d[7] = (unsigned short)(v.w >> 16); }
    asm volatile("s_waitcnt lgkmcnt(0)" ::: "memory");
#pragma unroll
    for (int p = 0; p < 8; ++p) { const int j = 8 * p + (lane >> 3), i0 = 8 * (lane & 7); const LAS unsigned short* s = scr + i0 * 66 + j;
        u32x4 o; o.x = (unsigned)s[0] | ((unsigned)s[66] << 16); o.y = (unsigned)s[2 * 66] | ((unsigned)s[3 * 66] << 16);
        o.z = (unsigned)s[4 * 66] | ((unsigned)s[5 * 66] << 16); o.w = (unsigned)s[6 * 66] | ((unsigned)s[7 * 66] << 16);
        *(gu32x4*)(dst + (size_t)j * dst_pitch + i0) = o; }
    asm volatile("s_waitcnt lgkmcnt(0)" ::: "memory");
}
__device__ __forceinline__ void sincos_d(double a, float& sn, float& cs) {
    const double k = rint(a * 0.63661977236758134308);
    const double r = (a - k * 1.57079632679489655800) - k * 6.123233995736766036e-17;
    const double r2 = r * r;
    const double s = r * (1.0 + r2 * (-1.0 / 6 + r2 * (1.0 / 120 + r2 * (-1.0 / 5040 + r2 * (1.0 / 362880 + r2 * (-1.0 / 39916800 + r2 * (1.0 / 6227020800.0)))))));
    const double c = 1.0 + r2 * (-0.5 + r2 * (1.0 / 24 + r2 * (-1.0 / 720 + r2 * (1.0 / 40320 + r2 * (-1.0 / 3628800 + r2 * (1.0 / 479001600.0 + r2 * (-1.0 / 87178291200.0)))))));
    const int q = ((int)k) & 3;
    const double ss = (q == 0) ? s : (q == 1) ? c : (q == 2) ? -s : -c;
    const double cc = (q == 0) ? c : (q == 1) ? -s : (q == 2) ? -c : s;
    sn = (float)ss; cs = (float)cc;
}

#define XB_TMO      128
#define XB_XCNT(j)  (256  + 64 * (j))
#define XB_XSUB(j)  (1280 + 64 * (j))
#define XB_XGEN(j)  (2304 + 64 * (j))
#define XB_TOP      3328
#define XB_TOPGEN   3392
#define XCD_BAR_WORDS 3456
#define XB_SPIN_CAP (1u << 18)

__device__ __forceinline__ unsigned xb_ld(unsigned* p)              { return __hip_atomic_load(p, __ATOMIC_RELAXED, __HIP_MEMORY_SCOPE_AGENT); }
__device__ __forceinline__ unsigned xb_add(unsigned* p, unsigned v) { return __hip_atomic_fetch_add(p, v, __ATOMIC_RELAXED, __HIP_MEMORY_SCOPE_AGENT); }
__device__ __forceinline__ unsigned xb_xcc_id() { return (unsigned)__builtin_amdgcn_s_getreg((3 << 11) | 20) & 0xFu; }
#define XB_SPIN(cond, bar) do { unsigned _sp = 0; while (cond) { __builtin_amdgcn_s_sleep(1); \
    if ((++_sp & 255u) == 0u) { if (xb_ld(&(bar)[XB_TMO])) break; if (_sp > XB_SPIN_CAP) { atomicAdd(&(bar)[XB_TMO], 1u); break; } } } } while (0)

struct XcdBarrier {
    unsigned* bar; unsigned x;
    volatile LAS unsigned* st;
};

__device__ __forceinline__ XcdBarrier xcd_barrier_post(unsigned* bar, volatile LAS unsigned* st) {
    XcdBarrier b; b.bar = bar; b.x = xb_xcc_id(); b.st = st;
    if (threadIdx.x == 0) (void)xb_add(&bar[XB_XCNT(b.x)], 1u);
    return b;
}
__device__ __forceinline__ void xcd_barrier_complete(unsigned* bar, unsigned x, unsigned& nloc, unsigned& nx) {
    const unsigned G = gridDim.x * gridDim.y * gridDim.z;
    unsigned sum, cnt, mine, sp = 0u;
    for (;;) {
        sum = 0u; cnt = 0u; mine = 0u;
#pragma unroll
        for (unsigned j = 0; j < 16; ++j) { const unsigned c = xb_ld(&bar[XB_XCNT(j)]); sum += c; cnt += (c > 0u) ? 1u : 0u; mine = (j == x) ? c : mine; }
        if (sum == G) break;
        __builtin_amdgcn_s_sleep(1);
        if ((++sp & 255u) == 0u) { if (xb_ld(&bar[XB_TMO])) break; if (sp > XB_SPIN_CAP) { atomicAdd(&bar[XB_TMO], 1u); break; } }
    }
    nloc = mine > 0u ? mine : 1u; nx = cnt > 0u ? cnt : 1u;
}

__device__ __forceinline__ void xcd_barrier(const XcdBarrier& b) {
    asm volatile("s_waitcnt vmcnt(0)" ::: "memory");
    __syncthreads();
    if (threadIdx.x == 0) {
        unsigned* bar = b.bar; const unsigned bx_ = xb_xcc_id();
        __builtin_amdgcn_s_waitcnt(0);
        unsigned nloc = b.st[0], nx = b.st[1];
        if (nloc == 0u) { xcd_barrier_complete(bar, bx_, nloc, nx); b.st[0] = nloc; b.st[1] = nx; }
        const unsigned old = xb_add(&bar[XB_XSUB(bx_)], 1u);
        const unsigned gen = old / nloc;
        if (old + 1u == (gen + 1u) * nloc) {
            __builtin_amdgcn_fence(__ATOMIC_RELEASE, "agent");
            asm volatile("s_waitcnt vmcnt(0)" ::: "memory");
            const unsigned og = xb_add(&bar[XB_TOP], 1u);
            const unsigned tg = og / nx;
            if (og + 1u == (tg + 1u) * nx) xb_add(&bar[XB_TOPGEN], 1u);
            else XB_SPIN(xb_ld(&bar[XB_TOPGEN]) == tg, bar);
            __builtin_amdgcn_fence(__ATOMIC_ACQUIRE, "agent");
            xb_add(&bar[XB_XGEN(bx_)], 1u);
            asm volatile("s_waitcnt vmcnt(0)" ::: "memory");
        } else {
            XB_SPIN(xb_ld(&bar[XB_XGEN(bx_)]) == gen, bar);
            __builtin_amdgcn_fence(__ATOMIC_ACQUIRE, "agent");
            asm volatile("s_waitcnt vmcnt(0)" ::: "memory");
        }
    }
    __syncthreads();
}


#define XL_SUB(j)  (4096 + 64 * (j))
#define XL_GEN(j)  (5120 + 64 * (j))
#define XL_RANK(j) (6144 + 64 * (j))
#define XL_BAD     7168
__device__ __forceinline__ void xcd_local_barrier(const XcdBarrier& b) {
    asm volatile("s_waitcnt vmcnt(0)" ::: "memory");
    __syncthreads();
    if (threadIdx.x == 0) {
        unsigned* bar = b.bar; const unsigned x_ = xb_xcc_id();
        __builtin_amdgcn_s_waitcnt(0);
        const unsigned nloc = b.st[0];
        const unsigned old = xb_add(&bar[XL_SUB(x_)], 1u);
        const unsigned gen = old / nloc;
        if (old + 1u == (gen + 1u) * nloc) xb_add(&bar[XL_GEN(x_)], 1u);
        else XB_SPIN(xb_ld(&bar[XL_GEN(x_)]) == gen, bar);
        __builtin_amdgcn_fence(__ATOMIC_ACQUIRE, "agent");
        asm volatile("s_waitcnt vmcnt(0)" ::: "memory");
    }
    __syncthreads();
}

struct Args { const float* in[23]; float* out; unsigned char* ws; int ph_lo, ph_hi; };
enum { I_XP = 0, I_XS, I_MP, I_MS, I_RELB, I_NFF1, I_FF1I, I_FF1O, I_NMIX, I_WIN, I_QN, I_KN, I_SINK, I_NMEM, I_WMEM, I_BRA, I_BRB, I_BRC, I_WOUT, I_NFF2, I_FF2I, I_FF2O, I_NFIN };
constexpr int N_PRO = 3, N_PER = 10, N_STEPS = N_PRO + N_PER * NCH + 1;

constexpr int LDS_XB = 136192 + 256;
constexpr int LDS_PTRS = 136192;
__device__ __forceinline__ const gfloat* ldsptr(LAS unsigned char* lds, int i) {
    const unsigned long long v = ((const LAS unsigned long long*)(lds + LDS_PTRS))[i];
    const unsigned lo = __builtin_amdgcn_readfirstlane((unsigned)v), hi = __builtin_amdgcn_readfirstlane((unsigned)(v >> 32));
    return (const gfloat*)(((unsigned long long)hi << 32) | lo);
}
#define INP(i) ldsptr(lds, (i))
__global__ void __launch_bounds__(512, 2) mega_fwd(Args a) {
    extern __shared__ __attribute__((aligned(16))) unsigned char lds_raw[];
    LAS unsigned char* lds = (LAS unsigned char*)lds_raw;
    cg::grid_group grid = cg::this_grid();
    if (threadIdx.x < 23) ((LAS unsigned long long*)(lds + LDS_PTRS))[threadIdx.x] = (unsigned long long)a.in[threadIdx.x];
    if (threadIdx.x == 23) ((LAS unsigned long long*)(lds + LDS_PTRS))[23] = (unsigned long long)a.out;
    if (threadIdx.x == 24) ((LAS unsigned long long*)(lds + LDS_PTRS))[24] = (unsigned long long)a.ws;
    if (threadIdx.x == 25) { ((volatile LAS unsigned*)(lds + LDS_XB))[0] = 0u; ((volatile LAS unsigned*)(lds + LDS_XB))[1] = 0u; }
    __syncthreads();
    const XcdBarrier xbar = xcd_barrier_post((unsigned*)(a.ws + WS_BAR), (volatile LAS unsigned*)(lds + LDS_XB));
    if (threadIdx.x == 0) { const unsigned x_ = xb_xcc_id(); ((volatile LAS unsigned*)(lds + LDS_XB))[2] = x_; ((volatile LAS unsigned*)(lds + LDS_XB))[3] = xb_add((unsigned*)(a.ws + WS_BAR) + XL_RANK(x_), 1u); ((volatile LAS unsigned*)(lds + LDS_XB))[4] = 0u; }
    __syncthreads();
    const int wave_s = __builtin_amdgcn_readfirstlane((int)threadIdx.x >> 6);
#define STEP_LOCALS \
        int tid = wave_s * 64 + (int)__builtin_amdgcn_mbcnt_hi(~0u, __builtin_amdgcn_mbcnt_lo(~0u, 0u)); asm volatile("" : "+v"(tid)); \
        const int lane = tid & 63, wave = __builtin_amdgcn_readfirstlane(tid >> 6); \
        const int G = gridDim.x, bx = blockIdx.x; \
        const int vcu = (G % 8 == 0) ? (bx % 8) * (G / 8) + bx / 8 : bx; \
        const int gw = vcu * 8 + wave, NGW = G * 8; \
        guchar* ws = (guchar*)INP(24); \
        gfloat* const outp = (gfloat*)INP(23); \
        gbf16* const W_ff1i = (gbf16*)(ws + WS_WFF1I); gbf16* const W_ff1o = (gbf16*)(ws + WS_WFF1O); gbf16* const W_in = (gbf16*)(ws + WS_WIN); \
        gbf16* const W_mem = (gbf16*)(ws + WS_WMEM); gbf16* const W_br = (gbf16*)(ws + WS_WBR); gbf16* const W_out = (gbf16*)(ws + WS_WOUT); \
        gbf16* const W_ff2i = (gbf16*)(ws + WS_WFF2I); gbf16* const W_ff2o = (gbf16*)(ws + WS_WFF2O); \
        gbf16* const memn = (gbf16*)(ws + WS_MEMN); gbf16* const kvm = (gbf16*)(ws + WS_KVM); gbf16* const vtc = (gbf16*)(ws + WS_VTC); \
        gf32x2* const rope = (gf32x2*)(ws + WS_ROPE); gfloat* const biast = (gfloat*)(ws + WS_BIAS); \
        gbf16* const xn = (gbf16*)(ws + WS_XN); gbf16* const hid = (gbf16*)(ws + WS_HID); gbf16* const proj = (gbf16*)(ws + WS_PROJ); \
        gbf16* const vta = (gbf16*)(ws + WS_VTA); gbf16* const vtb = (gbf16*)(ws + WS_VTB); gbf16* const yb3 = (gbf16*)(ws + WS_Y); \
        gbf16* const part = (gbf16*)(ws + WS_PART); gbf16* const mrg = (gbf16*)(ws + WS_MRG); gfloat* const ssq = (gfloat*)(ws + WS_SSQ);
    if (PH_EN(0)) { STEP_LOCALS
            LAS float* scr = (LAS float*)(lds + wave * 16384);
            constexpr int I_FI = (DM / 64) * (2 * FF / 32), I_FO = (FF / 64) * (DM / 32), I_IN = (DM / 64) * (PROJ / 32), I_SQ = (DM / 64) * (DM / 32), I_BR = (512 / 64) * (DM / 32);
            constexpr int NITEMS = 2 * I_FI + 2 * I_FO + I_IN + 2 * I_SQ + 3 * I_BR;
            for (int it = gw; it < NITEMS; it += NGW) {
                int r = it;
                if (r < I_FI) { transpose_item(INP(I_FF1I), DM, 2 * FF, W_ff1i, 1, scr, r, lane); continue; } r -= I_FI;
                if (r < I_FI) { transpose_item(INP(I_FF2I), DM, 2 * FF, W_ff2i, 1, scr, r, lane, INP(I_NFF2)); continue; } r -= I_FI;
                if (r < I_FO) { transpose_item(INP(I_FF1O), FF, DM, W_ff1o, 0, scr, r, lane); continue; } r -= I_FO;
                if (r < I_FO) { transpose_item(INP(I_FF2O), FF, DM, W_ff2o, 0, scr, r, lane); continue; } r -= I_FO;
                if (r < I_IN) { transpose_item(INP(I_WIN), DM, PROJ, W_in, 0, scr, r, lane, INP(I_NMIX)); continue; } r -= I_IN;
                if (r < I_SQ) { transpose_item(INP(I_WMEM), DM, DM, W_mem, 0, scr, r, lane); continue; } r -= I_SQ;
                if (r < I_SQ) { transpose_item(INP(I_WOUT), DM, DM, W_out, 0, scr, r, lane); continue; } r -= I_SQ;
                if (r < I_BR) { transpose_item(INP(I_BRA), 512, DM, W_br, 0, scr, r, lane); continue; } r -= I_BR;
                if (r < I_BR) { transpose_item(INP(I_BRB), 512, DM, W_br + (size_t)DM * 512, 0, scr, r, lane); continue; } r -= I_BR;
                transpose_item(INP(I_BRC), 512, DM, W_br + (size_t)2 * DM * 512, 0, scr, r, lane);
            }
            const gfloat* mp_p = INP(I_MP); const gfloat* ms_p = INP(I_MS); const gfloat* nmem_p = INP(I_NMEM);
            for (int m = gw; m < NMEM; m += NGW) {
                const gfloat* src = (m < 2048) ? mp_p + (size_t)m * DM : ms_p + (size_t)(m - 2048) * DM;
                rms_row_bf16(src, nmem_p, memn + (size_t)m * DM, lane);
            }
            for (int i = vcu * 512 + tid; i < 2048; i += G * 512) {
                const int n = i >> 4, j = i & 15;
                const int jl = j & 3, jh = j >> 2;
                const float b = (jl == 0) ? 1.0f : (jl == 1) ? 0.5623413251903491f : (jl == 2) ? 0.31622776601683794f : 0.1778279410038923f;
                const float s = (jh == 0) ? 1.0f : (jh == 1) ? 0.1f : (jh == 2) ? 0.01f : 0.001f;
                const float inv = b * s;
                const float ang = (float)n * inv;
                float sn, cs; sincos_d((double)ang, sn, cs);
                rope[i] = (f32x2){cs, sn};
            }
            const gfloat* relb_p = INP(I_RELB);
            for (int i = vcu * 512 + tid; i < 8 * 768; i += G * 512) {
                const int h = i / 768, rel = (i % 768) - 384;
                if (rel < -128 || rel > 128) { biast[i] = -1e30f; continue; }
                const int n = rel < 0 ? -rel : rel;
                int large = 33 - __clz(n * n > 0 ? n * n : 1); if (large > 15) large = 15;
                const int bucket = (rel > 0 ? 16 : 0) + (n < 8 ? n : large);
                biast[i] = relb_p[bucket * 8 + h] * LOG2E;
            }
    }
    grid.sync();
    if (PH_EN(1)) { STEP_LOCALS
            pg8::Gemm g{memn, W_mem, NMEM, DM, DM, 0, 0}; pg8::StaticOrder S; S.init(NMEM, DM, G, bx);
            pg8::EpiPlain E{kvm, DM};
            pg8::gemm_phase(lds, tid, g, S, E);
    }
    xcd_barrier(xbar);
    if (threadIdx.x == 0) { volatile LAS unsigned* w_ = (volatile LAS unsigned*)(lds + LDS_XB);
        if (w_[0] * 8u != gridDim.x || w_[1] != 8u || w_[2] >= 8u || w_[3] >= gridDim.x / 8u) __hip_atomic_store((unsigned*)(a.ws + WS_BAR) + XL_BAD, 1u, __ATOMIC_RELAXED, __HIP_MEMORY_SCOPE_AGENT); }
    if (PH_EN(2)) { STEP_LOCALS
            LAS unsigned short* scr = (LAS unsigned short*)(lds + wave * 16384);
            for (int it = gw; it < 40 * 4 * 4 * 2; it += NGW) {
                const int db = it & 1, h = (it >> 1) & 3, mb = (it >> 3) & 3, seq = it >> 5;
                transpose64_bf16(kvm + (size_t)(seq * 256 + 64 * mb) * DM + 512 + 128 * h + 64 * db, DM,
                                 vtc + ((size_t)(seq * 4 + h) * 128 + 64 * db) * 256 + 64 * mb, 256, scr, lane);
            }
    }
    xcd_barrier(xbar);
    if (threadIdx.x == 0) ((volatile LAS unsigned*)(lds + LDS_XB))[4] = (__hip_atomic_load((unsigned*)(a.ws + WS_BAR) + XL_BAD, __ATOMIC_RELAXED, __HIP_MEMORY_SCOPE_AGENT) == 0u) ? 1u : 0u;
    __syncthreads();
    constexpr int NS = N_PER * NCH;
    for (int step2 = 0; step2 < 2 * NS; ++step2) {
        const int step = step2 >> 1;
        const bool dup_ = ((PH_DUP >> (step % N_PER)) & 1);
        if ((step2 & 1) && !dup_) continue;
        STEP_LOCALS
        const int xl_good = __builtin_amdgcn_readfirstlane((int)((volatile LAS unsigned*)(lds + LDS_XB))[4]);
        const int xl_x = __builtin_amdgcn_readfirstlane((int)((volatile LAS unsigned*)(lds + LDS_XB))[2]), xl_r = __builtin_amdgcn_readfirstlane((int)((volatile LAS unsigned*)(lds + LDS_XB))[3]);
        const int cx = xl_good ? (xl_x + 8 * xl_r) : bx;
        {
            const int c = step / N_PER, k = step % N_PER;
            const bool prompt = c < NCH_P;
#define XIN() (INP(prompt ? I_XP : I_XS) + (size_t)(prompt ? c : c - NCH_P) * CH * DM)
#define HOUT() ((gfloat*)INP(23) + (size_t)c * CH * DM)
            const int S_ = prompt ? 8192 : 2048, nseq = CH / S_, NQB = S_ / 256;
            const int memseq0 = prompt ? (CH / 8192) * c : 8 + (CH / 2048) * (c - NCH_P);
            gfloat* const ssq1 = ssq; gfloat* const ssq2 = ssq + CH * 4; gfloat* const ssq3 = ssq + 2 * CH * 4;
            if (PH_EN(3) && k == 0) {
                const gfloat* gain = INP(I_NFF1);
                const gfloat* xin_ = XIN();
                if (xl_good && (CH / 8) % (2 * G) == 0) {
                    const int m0 = (CH / 8) * xl_x + xl_r * 8 + wave;
                    for (int i0 = 0; i0 < CH / 8; i0 += 2 * G) { const size_t ra = (size_t)(m0 + i0) * DM, rb = (size_t)(m0 + i0 + G) * DM; rms_row2_bf16(xin_ + ra, xin_ + rb, gain, xn + ra, xn + rb, lane); }
                } else
                for (int m = gw; m < CH; m += 2 * NGW) { const int m1 = (m + NGW < CH) ? m + NGW : m; rms_row2_bf16(xin_ + (size_t)m * DM, xin_ + (size_t)m1 * DM, gain, xn + (size_t)m * DM, xn + (size_t)m1 * DM, lane); }
            } else if (PH_EN(4) && k == 1) {
                pg8::Gemm g{xn, W_ff1i, CH, 2 * FF, DM, 0, 0}; pg8::StaticOrder S; S.init(CH, 2 * FF, G, cx);
                pg8::EpiSwiglu E{hid};
                pg8::gemm_phase(lds, tid, g, S, E);
            } else if (PH_EN(5) && k == 2) {
                pg8::Gemm g{hid, W_ff1o, CH, DM, FF, 0, 0}; pg8::StaticOrder S; S.init(CH, DM, G, cx);
                pg8::EpiResidStats<false> E{XIN(), nullptr, xn, ssq1, 0.5f};
                pg8::gemm_phase(lds, tid, g, S, E);
            } else if (PH_EN(5) && k == 9) {
                pg8::Gemm g{hid, W_ff2o, CH, DM, FF, 0, 0}; pg8::StaticOrder S; S.init(CH, DM, G, cx);
                pg8::EpiResidFinal E{xn, HOUT(), ssq3, (unsigned*)(ws + WS_CNT), INP(I_NFIN), 0.5f, 4u * (unsigned)(c + 1)};
                pg8::gemm_phase(lds, tid, g, S, E);
            } else if (PH_EN(6) && k == 3) {
                pg8::Gemm g{xn, W_in, CH, PROJ, DM, 0, 0}; pg8::StaticOrder S; S.init(CH, PROJ, G, cx);
                pg8::EpiPlainRstd E{proj, PROJ, ssq1, 1};
                pg8::gemm_phase(lds, tid, g, S, E);
            } else if (PH_EN(7) && k == 4) {
                const gfloat* qn_p = INP(I_QN); const gfloat* kn_p = INP(I_KN);
                for (int wi = gw; wi < CH * 2 / 8; wi += 2 * NGW) {
                    const int sub = lane & 7;
                    gbf16* pp[2]; u32x4 vv[2]; int posv[2], hhv[2];
#pragma unroll
                    for (int q = 0; q < 2; ++q) { const int item = (wi + q * NGW) * 8 + (lane >> 3); const int tok = item / 2, hh = 8 + (item & 1);
                        pp[q] = proj + (size_t)tok * PROJ + 64 * hh + 8 * sub; vv[q] = *(const gu32x4*)pp[q]; posv[q] = tok % S_; hhv[q] = hh; }
#pragma unroll
                    for (int q = 0; q < 2; ++q) {
                        const u32x4 v = vv[q]; const int hh = hhv[q], pos = posv[q];
                        float x[8] = {bflo(v.x), bfhi(v.x), bflo(v.y), bfhi(v.y), bflo(v.z), bfhi(v.z), bflo(v.w), bfhi(v.w)};
                        float ss = 0.f;
#pragma unroll
                        for (int e = 0; e < 8; ++e) ss += x[e] * x[e];
                        ss += __shfl_xor(ss, 1); ss += __shfl_xor(ss, 2); ss += __shfl_xor(ss, 4);
                        const float rstd = (1.0f / sqrtf(ss * (1.0f / 64) + EPS)) * ((hh < 8) ? 0.125f * LOG2E : 1.0f);
                        const gfloat* gn = ((hh < 8) ? qn_p : kn_p) + 8 * sub;
                        const f32x4 g0 = *(const gf32x4*)gn, g1 = *(const gf32x4*)(gn + 4);
                        x[0] *= rstd * g0.x; x[1] *= rstd * g0.y; x[2] *= rstd * g0.z; x[3] *= rstd * g0.w;
                        x[4] *= rstd * g1.x; x[5] *= rstd * g1.y; x[6] *= rstd * g1.z; x[7] *= rstd * g1.w;
                        const int nidx = (sub < 4) ? (pos >> 6) : (pos & 63);
                        const gf32x4* rt = (const gf32x4*)(rope + nidx * 16 + 4 * (sub & 3));
                        const f32x4 c01 = rt[0], c23 = rt[1];
                        float y[8];
                        y[0] = x[0] * c01.x - x[1] * c01.y; y[1] = x[0] * c01.y + x[1] * c01.x;
                        y[2] = x[2] * c01.z - x[3] * c01.w; y[3] = x[2] * c01.w + x[3] * c01.z;
                        y[4] = x[4] * c23.x - x[5] * c23.y; y[5] = x[4] * c23.y + x[5] * c23.x;
                        y[6] = x[6] * c23.z - x[7] * c23.w; y[7] = x[6] * c23.w + x[7] * c23.z;
                        u32x4 w; w.x = pk2(y[0], y[1]); w.y = pk2(y[2], y[3]); w.z = pk2(y[4], y[5]); w.w = pk2(y[6], y[7]);
                        *(gu32x4*)pp[q] = w;
                    }
                }
                LAS unsigned short* scr = (LAS unsigned short*)(lds + wave * 16384);
                for (int it = gw; it < (CH / 64) * 4; it += NGW) {
                    const int kvh = it & 1, which = (it >> 1) & 1, tt = it >> 2;
                    const int tok = 64 * tt, seq = tok / S_, pos = tok % S_;
                    transpose64_bf16(proj + (size_t)tok * PROJ + (which ? 1408 : 640) + 64 * kvh, PROJ,
                                     (which ? vtb : vta) + ((size_t)(seq * 2 + kvh) * 64) * S_ + pos, S_, scr, lane);
                }
            } else if (PH_EN(8) && k == 5) {
                const gfloat* qn_att = INP(I_QN);
                for (int u = vcu; ATT_EN(0) && u < (CH / 256) * 8; u += G) {
                    const int qb = u % NQB, g4 = (u / NQB) % 4, kvh = (u / NQB / 4) % 2, seq = u / (NQB * 8), head = kvh * 4 + g4;
                    const size_t tokq = (size_t)seq * S_ + (size_t)qb * 256;
                    attn_unit<64, 0>(lds, tid, proj + tokq * PROJ + 64 * head, PROJ, proj + (size_t)seq * S_ * PROJ + 512 + 64 * kvh, PROJ,
                                     vta + ((size_t)(seq * 2 + kvh) * 64) * S_, S_, yb3 + tokq * 512 + 64 * head, 512, 0, S_ / 64,
                                     0.125f * LOG2E, qb * 256, nullptr, -1e30f, 0.f, qn_att, rope);
                }
                for (int u = vcu; ATT_EN(1) && u < (CH / 256) * 8; u += G) {
                    const int qb = u % NQB, g4 = (u / NQB) % 4, kvh = (u / NQB / 4) % 2, seq = u / (NQB * 8), head = kvh * 4 + g4;
                    const size_t tokq = (size_t)seq * S_ + (size_t)qb * 256;
                    const int q0 = qb * 256;
                    const int t0 = (q0 >= 128) ? (q0 - 128) / 64 : 0, t1 = min(S_, q0 + 384) / 64;
                    attn_unit_np<64, 1>(lds, tid, proj + tokq * PROJ + 768 + 64 * head, PROJ, proj + (size_t)seq * S_ * PROJ + 1280 + 64 * kvh, PROJ,
                                     vtb + ((size_t)(seq * 2 + kvh) * 64) * S_, S_, yb3 + (size_t)CH * 512 + tokq * 512 + 64 * head, 512, t0, t1,
                                     0.125f * LOG2E, q0, biast + head * 768, INP(I_SINK)[head] * LOG2E, 1.0f);
                }
                for (int u = vcu; ATT_EN(2) && u < (CH / 256) * 4; u += G) {
                    const int qb = u % NQB, h = (u / NQB) % 4, seq = u / (NQB * 4);
                    const size_t tokq = (size_t)seq * S_ + (size_t)qb * 256;
                    const int ms = memseq0 + seq;
                    attn_unit_np<128, 0>(lds, tid, proj + tokq * PROJ + 1536 + 128 * h, PROJ, kvm + (size_t)ms * 256 * DM + 128 * h, DM,
                                      vtc + ((size_t)(ms * 4 + h) * 128) * 256, 256, yb3 + (size_t)2 * CH * 512 + tokq * 512 + 128 * h, 512, 0, 4,
                                      0.08838834764831845f * LOG2E, 0, nullptr, -1e30f, 0.f);
                }
                __syncthreads();
            } else if (PH_EN(9) && k == 6) {
                pg8::Gemm g{yb3, W_br, CH, DM, 512, (size_t)CH * 512 * 2, (size_t)DM * 512 * 2}; pg8::BranchOrder S; S.b.init(CH, DM, G, cx);
                pg8::EpiGate E{proj, part, mrg};
                pg8::gemm_phase(lds, tid, g, S, E);
            } else if (PH_EN(10) && k == 7) {
                pg8::Gemm g{mrg, W_out, CH, DM, DM, 0, 0}; pg8::StaticOrder S; S.init(CH, DM, G, cx);
                pg8::EpiResidStats<true> E{nullptr, xn, xn, ssq2, 1.0f};
                pg8::gemm_phase(lds, tid, g, S, E);
            } else if (PH_EN(11) && k == 8) {
                pg8::Gemm g{xn, W_ff2i, CH, 2 * FF, DM, 0, 0}; pg8::StaticOrder S; S.init(CH, 2 * FF, G, cx);
                pg8::EpiSwigluRstd E{hid, ssq2};
                pg8::gemm_phase(lds, tid, g, S, E);
            }
        }
        if ((step2 & 1) || !dup_) {
            if (step + 1 < NS) { const int k_ = step % N_PER;
                if (xl_good && PH_DUP == 0 && (k_ <= 2 || k_ >= 6)) xcd_local_barrier(xbar);
                else xcd_barrier(xbar); }
        } else xcd_barrier(xbar);
    }
}

extern "C" void kernel_launch(void* const* d_in, const int* in_sizes, int n_in, void* d_out, int out_size, void* d_ws, size_t ws_size, hipStream_t stream) {
    static int grid = 0;
    if (grid == 0) {
        if (n_in != 23 || ws_size < WS_END) { fprintf(stderr, "kernel_launch: unexpected n_in %d or ws_size %zu (need %zu)\n", n_in, ws_size, (size_t)WS_END); grid = -1; return; }
        int dev = 0, cus = 0, per_cu = 0;
        hipGetDevice(&dev);
        hipDeviceGetAttribute(&cus, hipDeviceAttributeMultiprocessorCount, dev);
        if (hipFuncSetAttribute((const void*)mega_fwd, hipFuncAttributeMaxDynamicSharedMemorySize, LDS_BYTES) != hipSuccess) { fprintf(stderr, "kernel_launch: hipFuncSetAttribute failed\n"); }
        if (hipOccupancyMaxActiveBlocksPerMultiprocessor(&per_cu, (const void*)mega_fwd, 512, LDS_BYTES) != hipSuccess || per_cu < 1) { fprintf(stderr, "kernel_launch: occupancy query gave %d\n", per_cu); per_cu = 1; }
        (void)hipGetLastError();
        grid = cus * 1;
        fprintf(stderr, "kernel_launch: cus %d per_cu %d grid %d ws %zu\n", cus, per_cu, grid, ws_size);
    }
    if (grid < 0) return;
    Args a{};
    for (int i = 0; i < 23; ++i) a.in[i] = (const float*)d_in[i];
    a.out = (float*)d_out; a.ws = (unsigned char*)d_ws;
    a.ph_lo = 0; a.ph_hi = 0;
    if (hipMemsetAsync((char*)d_ws + WS_BAR, 0, 32768 + 32768, stream) != hipSuccess) { fprintf(stderr, "kernel_launch: hipMemsetAsync failed\n"); return; }
    void* args[] = {&a};
    hipError_t e = hipLaunchCooperativeKernel((const void*)mega_fwd, dim3(grid), dim3(512), args, LDS_BYTES, stream);
    if (e != hipSuccess) fprintf(stderr, "cooperative launch failed: %s (grid %d)\n", hipGetErrorString(e), grid);
}
```

```cpp
#include <hip/hip_runtime.h>
#include <hip/hip_cooperative_groups.h>
#include <cstdio>
#include <cstdint>
namespace cg = cooperative_groups;

#ifndef MK_MULTI_LAUNCH
#define MK_MULTI_LAUNCH 0
#endif

#ifndef PH_MASK
#define PH_MASK 0xFFFF
#endif
#define PH_EN(i) ((PH_MASK >> (i)) & 1)
#ifndef ATT_MASK
#define ATT_MASK 7
#endif
#define ATT_EN(i) ((ATT_MASK >> (i)) & 1)
#ifndef PH_DUP
#define PH_DUP 0
#endif
#define LAS __attribute__((address_space(3)))
typedef unsigned short bf16_t;
typedef short bf16x8 __attribute__((ext_vector_type(8)));
typedef float f32x4 __attribute__((ext_vector_type(4)));
typedef float f32x2 __attribute__((ext_vector_type(2)));
typedef float f32x16 __attribute__((ext_vector_type(16)));
typedef unsigned u32x4 __attribute__((ext_vector_type(4)));
typedef unsigned u32x2 __attribute__((ext_vector_type(2)));
typedef __bf16 bf16x2_t __attribute__((ext_vector_type(2)));
#define GAS __attribute__((address_space(1)))
typedef GAS float gfloat; typedef GAS bf16_t gbf16; typedef GAS f32x4 gf32x4; typedef GAS f32x2 gf32x2; typedef GAS u32x4 gu32x4; typedef GAS u32x2 gu32x2;
typedef GAS bf16x8 gbf16x8; typedef GAS unsigned char guchar; typedef GAS char gchar; typedef GAS unsigned gunsigned;

constexpr int DM = 1024, FF = 2816, PROJ = 5120, CH = 32768, NCH = 131072 / CH, NCH_P = NCH / 2;
constexpr int NMEM = 40 * 256;
constexpr float EPS = 1e-6f;
constexpr float LOG2E = 1.4426950408889634f;

constexpr size_t al(size_t x) { return (x + 4095) & ~(size_t)4095; }
constexpr size_t WS_WFF1I = 0;
constexpr size_t WS_WFF1O = WS_WFF1I + al((size_t)2 * FF * DM * 2);
constexpr size_t WS_WIN   = WS_WFF1O + al((size_t)DM * FF * 2);
constexpr size_t WS_WMEM  = WS_WIN + al((size_t)PROJ * DM * 2);
constexpr size_t WS_WBR   = WS_WMEM + al((size_t)DM * DM * 2);
constexpr size_t WS_WOUT  = WS_WBR + al((size_t)3 * DM * 512 * 2);
constexpr size_t WS_WFF2I = WS_WOUT + al((size_t)DM * DM * 2);
constexpr size_t WS_WFF2O = WS_WFF2I + al((size_t)2 * FF * DM * 2);
constexpr size_t WS_MEMN  = WS_WFF2O + al((size_t)DM * FF * 2);
constexpr size_t WS_KVM   = WS_MEMN + al((size_t)NMEM * DM * 2);
constexpr size_t WS_VTC   = WS_KVM + al((size_t)NMEM * DM * 2);
constexpr size_t WS_ROPE  = WS_VTC + al((size_t)NMEM * 512 * 2);
constexpr size_t WS_BIAS  = WS_ROPE + al((size_t)128 * 16 * 8);
constexpr size_t WS_XN    = WS_BIAS + al((size_t)8 * 768 * 4);
constexpr size_t WS_HID   = WS_XN + al((size_t)CH * DM * 2);
constexpr size_t WS_PROJ  = WS_HID + al((size_t)CH * FF * 2);
constexpr size_t WS_VTA   = WS_PROJ + al((size_t)CH * PROJ * 2);
constexpr size_t WS_VTB   = WS_VTA + al((size_t)CH * 128 * 2);
constexpr size_t WS_Y     = WS_VTB + al((size_t)CH * 128 * 2);
constexpr size_t WS_PART  = WS_Y + al((size_t)3 * CH * 512 * 2);
constexpr size_t WS_MRG   = WS_PART + al((size_t)CH * DM * 4);
constexpr size_t WS_SSQ   = WS_MRG + al((size_t)CH * DM * 2);
constexpr size_t WS_BAR   = WS_SSQ + al((size_t)3 * CH * 4 * 4);
constexpr size_t WS_CNT   = WS_BAR + 32768;
constexpr size_t WS_END   = WS_CNT + 32768;

constexpr int LDS_RED = 131072;
constexpr int LDS_BYTES = 138240;

__device__ __forceinline__ unsigned pk2(float lo, float hi) { f32x2 v = {lo, hi}; bf16x2_t b = __builtin_convertvector(v, bf16x2_t); return __builtin_bit_cast(unsigned, b); }
__device__ __forceinline__ float bflo(unsigned w) { return __uint_as_float(w << 16); }
__device__ __forceinline__ float bfhi(unsigned w) { return __uint_as_float(w & 0xffff0000u); }
__device__ __forceinline__ float wave_sum(float v) {
#pragma unroll
    for (int o = 1; o < 64; o <<= 1) v += __shfl_xor(v, o);
    return v;
}
__device__ __forceinline__ float sigmoidf_(float x) { return __builtin_amdgcn_rcpf(1.0f + __builtin_amdgcn_exp2f(-x * LOG2E)); }

namespace pg8 {
constexpr int BM = 256, BK = 64, HALF = 128, HTB = HALF * BK * 2, STAGE_BYTES = 8 * HTB, NXCD = 8, WGM = 8;
__host__ __device__ __forceinline__ int lds_byte(int r, int c) { const int st = (r >> 4) * 2 + (c >> 5), rr = r & 15, cc = c & 31, ob = rr * 64 + cc * 2; return st * 1024 + (ob ^ (((ob >> 9) & 1) << 5)); }
__host__ __device__ __forceinline__ void stage_rc(int b, int& R, int& C) { const int st = b / 1024, sb = b % 1024, swz = sb ^ (((sb >> 9) & 1) << 5); R = (st >> 1) * 16 + swz / 64; C = (st & 1) * 32 + (swz % 64) / 2; }
__host__ __device__ __forceinline__ int perm32(int rho) { const int n = rho >> 4, i = rho & 15; return 8 * (i >> 2) + 4 * n + (i & 3); }

struct Unit { int pm, pn, pz; };
struct Gemm { const gbf16* A; const gbf16* Bt; int M, N, K; size_t zA, zB; };

struct StaticOrder {
    int nM, nN, nwg, G, c;
    __device__ void init(int M, int N, int G_, int c_) { nM = M / BM; nN = N / BM; nwg = nM * nN; G = G_; c = c_; }
    __device__ bool next(int i, Unit& u) const {
        const long L = (long)i * G + c; if (L >= nwg) return false;
        int wgid = (int)L; { const int q = nwg / NXCD, r = nwg % NXCD, xcd = wgid % NXCD, off = wgid / NXCD; wgid = (xcd < r ? xcd * (q + 1) : r * (q + 1) + (xcd - r) * q) + off; }
        const int nig = WGM * nN, gid = wgid / nig, fm = gid * WGM, gsz = (nM - fm) < WGM ? (nM - fm) : WGM;
        u.pm = fm + ((wgid % nig) % gsz); u.pn = (wgid % nig) / gsz; u.pz = 0; return true;
    }
};
struct BranchOrder {
    StaticOrder b;
    __device__ bool next(int i, Unit& u) const { if (!b.next(i / 3, u)) return false; u.pz = i % 3; return true; }
};

struct EpiPlain {
    static constexpr bool PERM = true;
    gbf16* O; int ldc;
    __device__ __forceinline__ void operator()(const f32x4 (&acc)[2][2][4][2], const Unit& u, int wr, int wc, int fr, int fq, LAS unsigned char* lds, int tid) const {
        const int row0 = u.pm * BM + wr * 64 + fr, col0 = u.pn * BM + wc * 32 + 8 * fq;
#pragma unroll
        for (int ai = 0; ai < 2; ++ai)
#pragma unroll
            for (int m = 0; m < 4; ++m) { gbf16* rowp = O + (size_t)(row0 + ai * HALF + m * 16) * ldc + col0;
#pragma unroll
                for (int bj = 0; bj < 2; ++bj) { const f32x4 v0 = acc[ai][bj][m][0], v1 = acc[ai][bj][m][1];
                    u32x4 w; w.x = pk2(v0[0], v0[1]); w.y = pk2(v0[2], v0[3]); w.z = pk2(v1[0], v1[1]); w.w = pk2(v1[2], v1[3]);
                    *(gu32x4*)(rowp + bj * HALF) = w; } }
    }
};
struct EpiSwiglu {
    static constexpr bool PERM = true;
    gbf16* O;
    __device__ __forceinline__ void operator()(const f32x4 (&acc)[2][2][4][2], const Unit& u, int wr, int wc, int fr, int fq, LAS unsigned char* lds, int tid) const {
        const int row0 = u.pm * BM + wr * 64 + fr, col0 = u.pn * HALF + wc * 32 + 8 * fq;
#pragma unroll
        for (int ai = 0; ai < 2; ++ai)
#pragma unroll
            for (int m = 0; m < 4; ++m) { gbf16* rowp = O + (size_t)(row0 + ai * HALF + m * 16) * FF + col0;
                float h[8];
#pragma unroll
                for (int n = 0; n < 2; ++n)
#pragma unroll
                    for (int e = 0; e < 4; ++e) { const float g = acc[ai][0][m][n][e], uu = acc[ai][1][m][n][e]; h[n * 4 + e] = g * sigmoidf_(g) * uu; }
                u32x4 w; w.x = pk2(h[0], h[1]); w.y = pk2(h[2], h[3]); w.z = pk2(h[4], h[5]); w.w = pk2(h[6], h[7]);
                *(gu32x4*)rowp = w; }
    }
};
struct EpiGate {
    static constexpr bool PERM = true;
    const gbf16* proj; gbf16* part; gbf16* merged;
    __device__ __forceinline__ void operator()(const f32x4 (&acc)[2][2][4][2], const Unit& u, int wr, int wc, int fr, int fq, LAS unsigned char* lds, int tid) const {
        const int row0 = u.pm * BM + wr * 64 + fr, col0 = u.pn * BM + wc * 32 + 8 * fq;
        const int pz = u.pz;
        gbf16* dst = (pz == 2) ? merged : part;
#pragma unroll
        for (int ai = 0; ai < 2; ++ai) {
            u32x4 gv[4][2], pv[4][2];
#pragma unroll
            for (int m = 0; m < 4; ++m) { const size_t row = (size_t)(row0 + ai * HALF + m * 16);
#pragma unroll
                for (int bj = 0; bj < 2; ++bj) { const int col = col0 + bj * HALF;
                    gv[m][bj] = *(const gu32x4*)(proj + row * PROJ + 2048 + 1024 * pz + col);
                    if (pz != 0) pv[m][bj] = *(const gu32x4*)(part + row * DM + col); else pv[m][bj] = (u32x4){0u, 0u, 0u, 0u}; } }
            asm volatile("" ::: "memory");
#pragma unroll
            for (int m = 0; m < 4; ++m) { const size_t row = (size_t)(row0 + ai * HALF + m * 16);
#pragma unroll
                for (int bj = 0; bj < 2; ++bj) { const int col = col0 + bj * HALF; const u32x4 gw = gv[m][bj], pw = pv[m][bj];
                    f32x4 z0, z1;
                    z0[0] = sigmoidf_(bflo(gw.x)); z0[1] = sigmoidf_(bfhi(gw.x)); z0[2] = sigmoidf_(bflo(gw.y)); z0[3] = sigmoidf_(bfhi(gw.y));
                    z1[0] = sigmoidf_(bflo(gw.z)); z1[1] = sigmoidf_(bfhi(gw.z)); z1[2] = sigmoidf_(bflo(gw.w)); z1[3] = sigmoidf_(bfhi(gw.w));
                    const f32x4 q0 = {bflo(pw.x), bfhi(pw.x), bflo(pw.y), bfhi(pw.y)}, q1 = {bflo(pw.z), bfhi(pw.z), bflo(pw.w), bfhi(pw.w)};
                    z0 = z0 * acc[ai][bj][m][0] + q0; z1 = z1 * acc[ai][bj][m][1] + q1;
                    u32x4 w; w.x = pk2(z0[0], z0[1]); w.y = pk2(z0[2], z0[3]); w.z = pk2(z1[0], z1[1]); w.w = pk2(z1[2], z1[3]);
                    *(gu32x4*)(dst + row * DM + col) = w; } }
            asm volatile("" ::: "memory");
        }
    }
};


__device__ __forceinline__ float rstd_from(const gfloat* ssq, size_t row) { const f32x4 p = *(const gf32x4*)(ssq + row * 4); return 1.0f / sqrtf(((p.x + p.y) + (p.z + p.w)) * (1.0f / DM) + EPS); }
struct EpiPlainRstd {
    static constexpr bool PERM = true;
    gbf16* O; int ldc; const gfloat* ssq; int qscale;
    __device__ __forceinline__ void operator()(const f32x4 (&acc)[2][2][4][2], const Unit& u, int wr, int wc, int fr, int fq, LAS unsigned char* lds, int tid) const {
        const int row0 = u.pm * BM + wr * 64 + fr, col0 = u.pn * BM + wc * 32 + 8 * fq;
        const float tsc = !qscale ? 1.0f : (u.pn == 3 || u.pn == 4) ? 0.125f * LOG2E : (u.pn == 6 || u.pn == 7) ? 0.08838834764831845f * LOG2E : 1.0f;
        float rsv[2][4];
        { f32x4 pv_[2][4];
#pragma unroll
          for (int ai = 0; ai < 2; ++ai)
#pragma unroll
              for (int m = 0; m < 4; ++m) pv_[ai][m] = *(const gf32x4*)(ssq + (size_t)(row0 + ai * HALF + m * 16) * 4);
          asm volatile("" ::: "memory");
#pragma unroll
          for (int ai = 0; ai < 2; ++ai)
#pragma unroll
              for (int m = 0; m < 4; ++m) { const f32x4 p = pv_[ai][m]; rsv[ai][m] = __builtin_amdgcn_rsqf(((p.x + p.y) + (p.z + p.w)) * (1.0f / DM) + EPS) * tsc; } }
#pragma unroll
        for (int ai = 0; ai < 2; ++ai)
#pragma unroll
            for (int m = 0; m < 4; ++m) { const size_t row = (size_t)(row0 + ai * HALF + m * 16); const float rs = rsv[ai][m]; gbf16* rowp = O + row * ldc + col0;
#pragma unroll
                for (int bj = 0; bj < 2; ++bj) { const f32x4 v0 = acc[ai][bj][m][0] * rs, v1 = acc[ai][bj][m][1] * rs;
                    u32x4 w; w.x = pk2(v0[0], v0[1]); w.y = pk2(v0[2], v0[3]); w.z = pk2(v1[0], v1[1]); w.w = pk2(v1[2], v1[3]);
                    *(gu32x4*)(rowp + bj * HALF) = w; } }
    }
};
struct EpiSwigluRstd {
    static constexpr bool PERM = true;
    gbf16* O; const gfloat* ssq;
    __device__ __forceinline__ void operator()(const f32x4 (&acc)[2][2][4][2], const Unit& u, int wr, int wc, int fr, int fq, LAS unsigned char* lds, int tid) const {
        const int row0 = u.pm * BM + wr * 64 + fr, col0 = u.pn * HALF + wc * 32 + 8 * fq;
        float rsv[2][4];
        { f32x4 pv_[2][4];
#pragma unroll
          for (int ai = 0; ai < 2; ++ai)
#pragma unroll
              for (int m = 0; m < 4; ++m) pv_[ai][m] = *(const gf32x4*)(ssq + (size_t)(row0 + ai * HALF + m * 16) * 4);
          asm volatile("" ::: "memory");
#pragma unroll
          for (int ai = 0; ai < 2; ++ai)
#pragma unroll
              for (int m = 0; m < 4; ++m) { const f32x4 p = pv_[ai][m]; rsv[ai][m] = __builtin_amdgcn_rsqf(((p.x + p.y) + (p.z + p.w)) * (1.0f / DM) + EPS); } }
#pragma unroll
        for (int ai = 0; ai < 2; ++ai)
#pragma unroll
            for (int m = 0; m < 4; ++m) { const size_t row = (size_t)(row0 + ai * HALF + m * 16); const float rs = rsv[ai][m]; gbf16* rowp = O + row * FF + col0;
                float h[8];
#pragma unroll
                for (int n = 0; n < 2; ++n)
#pragma unroll
                    for (int e = 0; e < 4; ++e) { const float g = acc[ai][0][m][n][e] * rs, uu = acc[ai][1][m][n][e] * rs; h[n * 4 + e] = g * sigmoidf_(g) * uu; }
                u32x4 w; w.x = pk2(h[0], h[1]); w.y = pk2(h[2], h[3]); w.z = pk2(h[4], h[5]); w.w = pk2(h[6], h[7]);
                *(gu32x4*)rowp = w; }
    }
};
template <bool RES_BF16>
struct EpiResidStats {
    static constexpr bool PERM = true;
    const gfloat* resf; const gbf16* resb; gbf16* xb; gfloat* ssq; float scale;
    __device__ __forceinline__ void operator()(const f32x4 (&acc)[2][2][4][2], const Unit& u, int wr, int wc, int fr, int fq, LAS unsigned char* lds, int tid) const {
        const int row0 = u.pm * BM + wr * 64 + fr, col0 = u.pn * BM + wc * 32 + 8 * fq;
        LAS float* red = (LAS float*)(lds + LDS_RED);
#pragma unroll
        for (int ai = 0; ai < 2; ++ai) {
            f32x4 rv[4][2][2]; u32x4 rw[4][2];
#pragma unroll
            for (int m = 0; m < 4; ++m) { const size_t off = (size_t)(row0 + ai * HALF + m * 16) * DM + col0;
#pragma unroll
                for (int bj = 0; bj < 2; ++bj) {
                    if (RES_BF16) rw[m][bj] = *(const gu32x4*)(resb + off + bj * HALF);
                    else { rv[m][bj][0] = *(const gf32x4*)(resf + off + bj * HALF); rv[m][bj][1] = *(const gf32x4*)(resf + off + bj * HALF + 4); } } }
            asm volatile("" ::: "memory");
            if (RES_BF16) {
#pragma unroll
                for (int m = 0; m < 4; ++m)
#pragma unroll
                    for (int bj = 0; bj < 2; ++bj) { const u32x4 w = rw[m][bj];
                        rv[m][bj][0] = (f32x4){bflo(w.x), bfhi(w.x), bflo(w.y), bfhi(w.y)}; rv[m][bj][1] = (f32x4){bflo(w.z), bfhi(w.z), bflo(w.w), bfhi(w.w)}; } }
#pragma unroll
            for (int m = 0; m < 4; ++m) { const size_t off = (size_t)(row0 + ai * HALF + m * 16) * DM + col0; float ss = 0.f;
#pragma unroll
                for (int bj = 0; bj < 2; ++bj) { const f32x4 v0 = rv[m][bj][0] + acc[ai][bj][m][0] * scale, v1 = rv[m][bj][1] + acc[ai][bj][m][1] * scale;
                    u32x4 w; w.x = pk2(v0[0], v0[1]); w.y = pk2(v0[2], v0[3]); w.z = pk2(v1[0], v1[1]); w.w = pk2(v1[2], v1[3]);
                    *(gu32x4*)(xb + off + bj * HALF) = w;
                    ss += ((v0[0] * v0[0] + v0[1] * v0[1]) + (v0[2] * v0[2] + v0[3] * v0[3])) + ((v1[0] * v1[0] + v1[1] * v1[1]) + (v1[2] * v1[2] + v1[3] * v1[3])); }
                ss += __shfl_xor(ss, 16); ss += __shfl_xor(ss, 32);
                if (fq == 0) red[wc * 256 + ai * HALF + wr * 64 + m * 16 + fr] = ss; }
            asm volatile("" ::: "memory"); }
        asm volatile("s_waitcnt lgkmcnt(0)" ::: "memory"); __builtin_amdgcn_s_barrier(); asm volatile("" ::: "memory");
        if (tid < 256) ssq[(size_t)(u.pm * BM + tid) * 4 + u.pn] = (red[tid] + red[256 + tid]) + (red[512 + tid] + red[768 + tid]);
    }
};


struct EpiResidFinal {
    static constexpr bool PERM = true;
    const gbf16* res; gfloat* out; gfloat* ssq; unsigned* cnt; const gfloat* gain; float scale; unsigned want;
    __device__ __forceinline__ void operator()(f32x4 (&acc)[2][2][4][2], const Unit& u, int wr, int wc, int fr, int fq, LAS unsigned char* lds, int tid) const {
        const int row0 = u.pm * BM + wr * 64 + fr, col0 = u.pn * BM + wc * 32 + 8 * fq;
        LAS float* red = (LAS float*)(lds + LDS_RED);
        LAS float* rsl = (LAS float*)(lds + LDS_RED) + 1024;
#pragma unroll
        for (int ai = 0; ai < 2; ++ai) {
            f32x4 rv[4][2][2]; u32x4 rw[4][2];
#pragma unroll
            for (int m = 0; m < 4; ++m) { const size_t off = (size_t)(row0 + ai * HALF + m * 16) * DM + col0;
#pragma unroll
                for (int bj = 0; bj < 2; ++bj) rw[m][bj] = *(const gu32x4*)(res + off + bj * HALF); }
            asm volatile("" ::: "memory");
#pragma unroll
            for (int m = 0; m < 4; ++m)
#pragma unroll
                for (int bj = 0; bj < 2; ++bj) { const u32x4 w = rw[m][bj];
                    rv[m][bj][0] = (f32x4){bflo(w.x), bfhi(w.x), bflo(w.y), bfhi(w.y)}; rv[m][bj][1] = (f32x4){bflo(w.z), bfhi(w.z), bflo(w.w), bfhi(w.w)}; }
#pragma unroll
            for (int m = 0; m < 4; ++m) { float ss = 0.f;
#pragma unroll
                for (int bj = 0; bj < 2; ++bj)
#pragma unroll
                    for (int n = 0; n < 2; ++n) { const f32x4 v = rv[m][bj][n] + acc[ai][bj][m][n] * scale; acc[ai][bj][m][n] = v;
                        ss += (v[0] * v[0] + v[1] * v[1]) + (v[2] * v[2] + v[3] * v[3]); }
                ss += __shfl_xor(ss, 16); ss += __shfl_xor(ss, 32);
                if (fq == 0) red[wc * 256 + ai * HALF + wr * 64 + m * 16 + fr] = ss; }
            asm volatile("" ::: "memory"); }
        asm volatile("s_waitcnt lgkmcnt(0)" ::: "memory"); __builtin_amdgcn_s_barrier(); asm volatile("" ::: "memory");
        if (tid < 256) __hip_atomic_store(ssq + (size_t)(u.pm * BM + tid) * 4 + u.pn, (red[tid] + red[256 + tid]) + (red[512 + tid] + red[768 + tid]), __ATOMIC_RELAXED, __HIP_MEMORY_SCOPE_AGENT);
        asm volatile("s_waitcnt vmcnt(0)" ::: "memory"); __builtin_amdgcn_s_barrier(); asm volatile("" ::: "memory");
        if (tid == 0) {
            unsigned* c = cnt + 64 * u.pm;
            __hip_atomic_fetch_add(c, 1u, __ATOMIC_RELAXED, __HIP_MEMORY_SCOPE_AGENT);
            unsigned sp = 0;
            while (__hip_atomic_load(c, __ATOMIC_RELAXED, __HIP_MEMORY_SCOPE_AGENT) < want) { __builtin_amdgcn_s_sleep(1); if (++sp > (1u << 22)) break; }
            __builtin_amdgcn_fence(__ATOMIC_ACQUIRE, "agent");
        }
        asm volatile("s_waitcnt vmcnt(0) lgkmcnt(0)" ::: "memory"); __builtin_amdgcn_s_barrier(); asm volatile("" ::: "memory");
        if (tid < 256) { const gfloat* p = ssq + (size_t)(u.pm * BM + tid) * 4; f32x4 pv4;
            asm volatile("global_load_dwordx4 %0, %1, off sc0 sc1\n\ts_waitcnt vmcnt(0)" : "=v"(pv4) : "v"(p) : "memory");
            rsl[tid] = __builtin_amdgcn_rsqf(((pv4.x + pv4.y) + (pv4.z + pv4.w)) * (1.0f / DM) + EPS); }
        asm volatile("s_waitcnt vmcnt(0) lgkmcnt(0)" ::: "memory"); __builtin_amdgcn_s_barrier(); asm volatile("" ::: "memory");
        f32x4 gv[2][2];
#pragma unroll
        for (int bj = 0; bj < 2; ++bj)
#pragma unroll
            for (int n = 0; n < 2; ++n) gv[bj][n] = *(const gf32x4*)(gain + col0 + bj * HALF + n * 4);
#pragma unroll
        for (int ai = 0; ai < 2; ++ai)
#pragma unroll
            for (int m = 0; m < 4; ++m) { const int rl = ai * HALF + wr * 64 + m * 16 + fr; const float rs = rsl[rl]; const size_t off = (size_t)(u.pm * BM + rl) * DM + col0;
#pragma unroll
                for (int bj = 0; bj < 2; ++bj)
#pragma unroll
                    for (int n = 0; n < 2; ++n) *(gf32x4*)(out + off + bj * HALF + n * 4) = acc[ai][bj][m][n] * rs * gv[bj][n]; }
    }
};

template <class Epi, class Sched>
__device__ __forceinline__ void gemm_phase(LAS unsigned char* lds, const int tid, const Gemm g, const Sched& S, const Epi& E) {
    const int wid = __builtin_amdgcn_readfirstlane(tid >> 6), lane = tid & 63, wr = wid >> 2, wc = wid & 3, fr = lane & 15, fq = lane >> 4;
    const int K = g.K, nt = K / BK;
    unsigned voffA[2], voffB[2];
#pragma unroll
    for (int i = 0; i < 2; ++i) { int R, C; stage_rc(tid * 16 + i * 8192, R, C); const int Rb = Epi::PERM ? ((R & ~31) + perm32(R & 31)) : R;
        voffA[i] = (unsigned)(R * K + C) * 2u; voffB[i] = (unsigned)(Rb * K + C) * 2u; }
    const size_t kstep = (size_t)(BK * 2);
    const size_t hstep = (size_t)HALF * K * 2;
    const size_t tstep = 2 * hstep;
    const unsigned ldsw = (unsigned)wid * 1024u;
    const int aoff = lds_byte(wr * 64 + fr, fq * 8), boff = lds_byte(wc * 32 + fr, fq * 8);
#define PG8_SA(b, h) (((b) * 2 + (h)) * HTB)
#define PG8_SB(b, h) ((4 + (b) * 2 + (h)) * HTB)
#define PG8_STAGE(bufoff, gbase, voff) do { _Pragma("unroll") for (int _i = 0; _i < 2; ++_i) \
        __builtin_amdgcn_global_load_lds((const gunsigned*)((const gchar*)(gbase) + (voff)[_i]), (LAS unsigned*)(lds + (bufoff) + ldsw + _i * 8192), 16, 0, 0); } while (0)
#define PG8_LDA(dst, b, h) do { _Pragma("unroll") for (int m = 0; m < 4; ++m) _Pragma("unroll") for (int k = 0; k < 2; ++k) dst[m][k] = *(const LAS bf16x8*)(lds + PG8_SA(b, h) + aoff + m * 2048 + k * 1024); } while (0)
#define PG8_LDB(dst, b, h) do { _Pragma("unroll") for (int n = 0; n < 2; ++n) _Pragma("unroll") for (int k = 0; k < 2; ++k) dst[n][k] = *(const LAS bf16x8*)(lds + PG8_SB(b, h) + boff + n * 2048 + k * 1024); } while (0)
#define PG8_MMA(ai, bj, At, Bt) do { __builtin_amdgcn_s_setprio(1); _Pragma("unroll") for (int m = 0; m < 4; ++m) _Pragma("unroll") for (int n = 0; n < 2; ++n) _Pragma("unroll") for (int k = 0; k < 2; ++k) \
        acc[ai][bj][m][n] = __builtin_amdgcn_mfma_f32_16x16x32_bf16(Bt[n][k], At[m][k], acc[ai][bj][m][n], 0, 0, 0); __builtin_amdgcn_s_setprio(0); } while (0)
#define PG8_WAIT_V(n) asm volatile("s_waitcnt vmcnt(" #n ")" ::: "memory")
#define PG8_WAIT_L(n) asm volatile("s_waitcnt lgkmcnt(" #n ")" ::: "memory")
#define PG8_BAR __builtin_amdgcn_s_barrier()
#define PG8_SCHED __builtin_amdgcn_sched_barrier(0)
    Unit cur, nxt; int ui = 0;
    if (!S.next(0, cur)) return;
    f32x4 acc[2][2][4][2];
#pragma unroll
    for (int a = 0; a < 2; ++a)
#pragma unroll
        for (int b = 0; b < 2; ++b)
#pragma unroll
            for (int m = 0; m < 4; ++m)
#pragma unroll
                for (int n = 0; n < 2; ++n) acc[a][b][m][n] = (f32x4){0.f, 0.f, 0.f, 0.f};
    bf16x8 At[4][2], B0[2][2], B1[2][2];
    const gchar* cA = (const gchar*)g.A + (size_t)cur.pm * tstep + (size_t)cur.pz * g.zA; const gchar* cB = (const gchar*)g.Bt + (size_t)cur.pn * tstep + (size_t)cur.pz * g.zB;
    PG8_STAGE(PG8_SB(0, 0), cB, voffB); PG8_STAGE(PG8_SB(0, 1), cB + hstep, voffB); PG8_STAGE(PG8_SA(0, 0), cA, voffA); PG8_STAGE(PG8_SA(0, 1), cA + hstep, voffA);
    if (wr == 1) PG8_BAR;
    PG8_WAIT_V(2); PG8_BAR;
    PG8_STAGE(PG8_SB(1, 0), cB + kstep, voffB); PG8_STAGE(PG8_SA(1, 0), cA + kstep, voffA); PG8_STAGE(PG8_SB(1, 1), cB + hstep + kstep, voffB);
    PG8_WAIT_V(6); PG8_BAR;
    for (;;) {
        const bool has_next = S.next(ui + 1, nxt);
        const gchar* nA = has_next ? (const gchar*)g.A + (size_t)nxt.pm * tstep + (size_t)nxt.pz * g.zA : cA;
        const gchar* nB = has_next ? (const gchar*)g.Bt + (size_t)nxt.pn * tstep + (size_t)nxt.pz * g.zB : cB;
        for (int t = 0; t < nt; t += 2) {
            const bool last = (t == nt - 2);
            const gchar* a1 = cA + (size_t)(t + 1) * kstep;
            const gchar* a2 = last ? nA : cA + (size_t)(t + 2) * kstep; const gchar* b2 = last ? nB : cB + (size_t)(t + 2) * kstep;
            const gchar* a3 = a2 + kstep; const gchar* b3 = b2 + kstep;
            PG8_LDB(B0, 0, 0); PG8_LDB(B1, 0, 1); PG8_SCHED; PG8_LDA(At, 0, 0); PG8_STAGE(PG8_SA(1, 1), a1 + hstep, voffA);
            PG8_WAIT_V(8); PG8_WAIT_L(0); PG8_BAR; PG8_MMA(0, 0, At, B0); PG8_MMA(0, 1, At, B1); PG8_BAR; PG8_SCHED;
            PG8_LDA(At, 0, 1); PG8_STAGE(PG8_SB(0, 0), b2, voffB); PG8_STAGE(PG8_SB(0, 1), b2 + hstep, voffB); PG8_STAGE(PG8_SA(0, 0), a2, voffA);
            PG8_WAIT_V(8); PG8_WAIT_L(0); PG8_BAR; PG8_MMA(1, 0, At, B0); PG8_MMA(1, 1, At, B1); PG8_BAR; PG8_SCHED;
            PG8_LDB(B0, 1, 0); PG8_LDB(B1, 1, 1); PG8_SCHED; PG8_LDA(At, 1, 0); PG8_STAGE(PG8_SA(0, 1), a2 + hstep, voffA);
            PG8_WAIT_V(8); PG8_WAIT_L(0); PG8_BAR; PG8_MMA(0, 0, At, B0); PG8_MMA(0, 1, At, B1); PG8_BAR; PG8_SCHED;
            PG8_LDA(At, 1, 1); PG8_STAGE(PG8_SB(1, 0), b3, voffB); PG8_STAGE(PG8_SB(1, 1), b3 + hstep, voffB); PG8_STAGE(PG8_SA(1, 0), a3, voffA);
            PG8_WAIT_V(8); PG8_WAIT_L(0); PG8_BAR; PG8_MMA(1, 0, At, B0); PG8_MMA(1, 1, At, B1); PG8_BAR; PG8_SCHED;
        }
        if (wr == 0) PG8_BAR;
        E(acc, cur, wr, wc, fr, fq, lds, tid);
        if (!has_next) break;
#pragma unroll
        for (int a = 0; a < 2; ++a)
#pragma unroll
            for (int b = 0; b < 2; ++b)
#pragma unroll
                for (int m = 0; m < 4; ++m)
#pragma unroll
                    for (int n = 0; n < 2; ++n) acc[a][b][m][n] = (f32x4){0.f, 0.f, 0.f, 0.f};
        cur = nxt; cA = nA; cB = nB; ++ui;
        if (wr == 1) PG8_BAR;
    }
    PG8_WAIT_V(0);
    PG8_BAR;
#undef PG8_SA
#undef PG8_SB
#undef PG8_STAGE
#undef PG8_LDA
#undef PG8_LDB
#undef PG8_MMA
#undef PG8_WAIT_V
#undef PG8_WAIT_L
#undef PG8_BAR
#undef PG8_SCHED
}
}

constexpr int ATT_BIAS_OFF = 110592;
template <int HD, int MODE>
__device__ __forceinline__ void attn_unit(LAS unsigned char* lds, const int tid_in, const gbf16* Qg, int q_pitch, const gbf16* Kg, int k_pitch,
                                          const gbf16* Vtg, int vt_pitch, gbf16* Og, int o_pitch, int t0, int t1, float c,
                                          int q0, const gfloat* biasg, float m_init, float l_init, const gfloat* qgain, const gf32x2* ropet) {
    constexpr int KROW = HD * 2 + 16, VROW = 144, KBYTES = 64 * KROW, VBYTES = HD * VROW, BUF = KBYTES + VBYTES, NP = HD / 64;
    static_assert(3 * BUF <= ATT_BIAS_OFF, "attention LDS");
    int tid = tid_in; asm volatile("" : "+v"(tid));
    const int lane = tid & 63, wid = __builtin_amdgcn_readfirstlane(tid >> 6), r32 = lane & 31, hi = lane >> 5;
    bf16x8 qf[HD / 16];
    { const gbf16* qrow = Qg + (size_t)(wid * 32 + r32) * q_pitch + hi * 8;
      u32x4 qraw[HD / 16]; f32x4 gq[HD / 16][2], cs[HD / 16][2];
      const int pos = q0 + wid * 32 + r32;
#pragma unroll
      for (int d0 = 0; d0 < HD / 16; ++d0) { qraw[d0] = *(const gu32x4*)(qrow + d0 * 16);
          const gf32x4* gp_ = (const gf32x4*)(qgain + 16 * d0 + 8 * hi); gq[d0][0] = gp_[0]; gq[d0][1] = gp_[1];
          const gf32x4* rp_ = (const gf32x4*)(ropet + ((d0 < HD / 32) ? (pos >> 6) : (pos & 63)) * 16 + 8 * (d0 % (HD / 32)) + 4 * hi); cs[d0][0] = rp_[0]; cs[d0][1] = rp_[1]; }
      float x[HD / 16][8]; float ss = 0.f;
#pragma unroll
      for (int d0 = 0; d0 < HD / 16; ++d0) { const u32x4 v = qraw[d0];
          x[d0][0] = bflo(v.x); x[d0][1] = bfhi(v.x); x[d0][2] = bflo(v.y); x[d0][3] = bfhi(v.y); x[d0][4] = bflo(v.z); x[d0][5] = bfhi(v.z); x[d0][6] = bflo(v.w); x[d0][7] = bfhi(v.w);
#pragma unroll
          for (int e = 0; e < 8; ++e) ss += x[d0][e] * x[d0][e]; }
      { auto rr = __builtin_amdgcn_permlane32_swap(__float_as_uint(ss), __float_as_uint(ss), false, false); ss = __uint_as_float(rr[0]) + __uint_as_float(rr[1]); }
      const float rstd = (1.0f / sqrtf(ss * (1.0f / HD) + EPS)) * c;
#pragma unroll
      for (int d0 = 0; d0 < HD / 16; ++d0) {
          float y[8];
#pragma unroll
          for (int p = 0; p < 4; ++p) { const float a = x[d0][2 * p] * rstd * gq[d0][p >> 1][2 * (p & 1)], b = x[d0][2 * p + 1] * rstd * gq[d0][p >> 1][2 * (p & 1) + 1];
              const float co = cs[d0][p >> 1][2 * (p & 1)], si = cs[d0][p >> 1][2 * (p & 1) + 1];
              y[2 * p] = a * co - b * si; y[2 * p + 1] = a * si + b * co; }
          u32x4 w; w.x = pk2(y[0], y[1]); w.y = pk2(y[2], y[3]); w.z = pk2(y[4], y[5]); w.w = pk2(y[6], y[7]); qf[d0] = __builtin_bit_cast(bf16x8, w); } }
    u32x4 kstA[NP], vstA[NP], kstB[NP], vstB[NP];
    unsigned kgo[NP], vgo[NP], kl[NP], vl[NP];
#pragma unroll
    for (int p = 0; p < NP; ++p) { const int idx = tid + 512 * p; const int krow = idx / (HD / 8), kch = idx % (HD / 8), vd = idx >> 3, vch = idx & 7;
        kgo[p] = (unsigned)(krow * k_pitch + kch * 8) * 2u; vgo[p] = (unsigned)(vd * vt_pitch + vch * 8) * 2u;
        kl[p] = krow * KROW + kch * 16; vl[p] = KBYTES + vd * VROW + vch * 16; }
#define ATT_LOAD(t, KS, VS) do { const gchar* kb0_ = (const gchar*)(Kg + (size_t)(t) * 64 * k_pitch); const gchar* vb0_ = (const gchar*)(Vtg + (t) * 64); \
        _Pragma("unroll") for (int p = 0; p < NP; ++p) { KS[p] = *(const gu32x4*)(kb0_ + kgo[p]); VS[p] = *(const gu32x4*)(vb0_ + vgo[p]); } } while (0)
#define ATT_STORE(boff, KS, VS) do { _Pragma("unroll") for (int p = 0; p < NP; ++p) { *(LAS u32x4*)(lds + (boff) + kl[p]) = KS[p]; *(LAS u32x4*)(lds + (boff) + vl[p]) = VS[p]; } } while (0)
#define ATT_QK(S0, S1, boff) do { const LAS unsigned char* kb_ = lds + (boff) + krd; \
        _Pragma("unroll") for (int r = 0; r < 16; ++r) { S0[r] = 0.f; S1[r] = 0.f; } \
        _Pragma("unroll") for (int d0 = 0; d0 < HD / 16; ++d0) { \
            const bf16x8 k0_ = *(const LAS bf16x8*)(kb_ + d0 * 32); const bf16x8 k1_ = *(const LAS bf16x8*)(kb_ + 32 * KROW + d0 * 32); \
            S0 = __builtin_amdgcn_mfma_f32_32x32x16_bf16(k0_, qf[d0], S0, 0, 0, 0); S1 = __builtin_amdgcn_mfma_f32_32x32x16_bf16(k1_, qf[d0], S1, 0, 0, 0); } } while (0)
    const int pr = (r32 & 0x13) | ((r32 & 4) << 1) | ((r32 & 8) >> 1);
    const unsigned krd = pr * KROW + hi * 16, vrd = KBYTES + r32 * VROW + hi * 16;
    f32x16 o[HD / 32];
#pragma unroll
    for (int d0 = 0; d0 < HD / 32; ++d0)
#pragma unroll
        for (int r = 0; r < 16; ++r) o[d0][r] = 0.f;
    float m_run = m_init, l_run = l_init;
    const LAS float* biasl = (const LAS float*)(lds + ATT_BIAS_OFF);
    const int qpos = q0 + wid * 32 + r32;
    __syncthreads();
    ATT_LOAD(t0, kstA, vstA); if (t0 + 1 < t1) ATT_LOAD(t0 + 1, kstB, vstB);
    ATT_STORE(0, kstA, vstA); if (t0 + 1 < t1) ATT_STORE(BUF, kstB, vstB);
    if (t0 + 2 < t1) ATT_LOAD(t0 + 2, kstA, vstA);
    if (MODE == 1) { if (tid < 257) ((LAS float*)(lds + ATT_BIAS_OFF))[tid] = biasg[tid]; }
    __syncthreads();
    int bc = 0, bn = BUF, bw = 2 * BUF;
    f32x16 sa0, sa1, sb0, sb1, negm;
    ATT_QK(sa0, sa1, 0);
    { float mx0 = fmaxf(sa0[0], sa1[0]);
#pragma unroll
      for (int r = 1; r < 16; ++r) mx0 = fmaxf(fmaxf(mx0, sa0[r]), sa1[r]);
      { auto rr = __builtin_amdgcn_permlane32_swap(__float_as_uint(mx0), __float_as_uint(mx0), false, false); mx0 = fmaxf(__uint_as_float(rr[0]), __uint_as_float(rr[1])); }
      m_run = mx0;
#pragma unroll
      for (int r = 0; r < 16; ++r) { sa0[r] -= mx0; sa1[r] -= mx0; negm[r] = -mx0; } }
#define ATT_SB() __builtin_amdgcn_sched_barrier(0)
#define ATT_STEP(SC0, SC1, SN0, SN1, t, KL, VL, KSt, VSt) do { \
        const bool has2_ = ((t) + 2 < t1); \
        if ((t) > t0) __syncthreads(); \
        ATT_LOAD(min((t) + 3, t1 - 1), KL, VL);        \
        ATT_SB(); \
          \
        bf16x8 kf0_[HD / 16], kf1_[HD / 16]; \
        { const LAS unsigned char* kb_ = lds + bn + krd; \
          _Pragma("unroll") for (int d0 = 0; d0 < HD / 16; ++d0) { kf0_[d0] = *(const LAS bf16x8*)(kb_ + d0 * 32); kf1_[d0] = *(const LAS bf16x8*)(kb_ + 32 * KROW + d0 * 32); } } \
        ATT_SB(); \
          \
        float mx_ = fmaxf(SC0[0], SC1[0]); \
        _Pragma("unroll") for (int r = 1; r < 16; ++r) mx_ = fmaxf(fmaxf(mx_, SC0[r]), SC1[r]); \
        { auto rr = __builtin_amdgcn_permlane32_swap(__float_as_uint(mx_), __float_as_uint(mx_), false, false); mx_ = fmaxf(__uint_as_float(rr[0]), __uint_as_float(rr[1])); } \
        if (__any(mx_ > 4.0f)) { \
            const float dl_ = fmaxf(mx_, 0.f); const float al_ = __builtin_amdgcn_exp2f(-dl_); \
            m_run += dl_; l_run *= al_; \
            _Pragma("unroll") for (int r = 0; r < 16; ++r) { SC0[r] -= dl_; SC1[r] -= dl_; } \
            _Pragma("unroll") for (int d0 = 0; d0 < HD / 32; ++d0) _Pragma("unroll") for (int r = 0; r < 16; ++r) o[d0][r] *= al_; \
            _Pragma("unroll") for (int r = 0; r < 16; ++r) negm[r] = -m_run; } \
        ATT_SB(); \
          \
        __builtin_amdgcn_s_setprio(1); \
        SN0 = __builtin_amdgcn_mfma_f32_32x32x16_bf16(kf0_[0], qf[0], negm, 0, 0, 0); SN1 = __builtin_amdgcn_mfma_f32_32x32x16_bf16(kf1_[0], qf[0], negm, 0, 0, 0); \
        _Pragma("unroll") for (int d0 = 1; d0 < HD / 16; ++d0) { \
            SN0 = __builtin_amdgcn_mfma_f32_32x32x16_bf16(kf0_[d0], qf[d0], SN0, 0, 0, 0); SN1 = __builtin_amdgcn_mfma_f32_32x32x16_bf16(kf1_[d0], qf[d0], SN1, 0, 0, 0); } \
        float rs_ = 0.f; \
        _Pragma("unroll") for (int r = 0; r < 16; ++r) { SC0[r] = __builtin_amdgcn_exp2f(SC0[r]); rs_ += SC0[r]; } \
        bf16x8 pf_[4]; \
        { u32x4 w; \
          w.x = pk2(SC0[0], SC0[1]); w.y = pk2(SC0[2], SC0[3]); w.z = pk2(SC0[4], SC0[5]); w.w = pk2(SC0[6], SC0[7]); pf_[0] = __builtin_bit_cast(bf16x8, w); \
          w.x = pk2(SC0[8], SC0[9]); w.y = pk2(SC0[10], SC0[11]); w.z = pk2(SC0[12], SC0[13]); w.w = pk2(SC0[14], SC0[15]); pf_[1] = __builtin_bit_cast(bf16x8, w); } \
        _Pragma("unroll") for (int g_ = 0; g_ < HD / 8; ++g_) { \
            __builtin_amdgcn_sched_group_barrier(0x008, 1, 0); __builtin_amdgcn_sched_group_barrier(0x400, 2, 0); __builtin_amdgcn_sched_group_barrier(0x002, 5, 0); } \
        ATT_SB(); \
        __builtin_amdgcn_s_setprio(0); \
          \
        bf16x8 vf_[HD / 32][4]; \
        { const LAS unsigned char* vb_ = lds + bc + vrd; \
          _Pragma("unroll") for (int d0 = 0; d0 < HD / 32; ++d0) _Pragma("unroll") for (int kk = 0; kk < 4; ++kk) vf_[d0][kk] = *(const LAS bf16x8*)(vb_ + d0 * 32 * VROW + kk * 32); } \
        ATT_SB(); \
          \
        _Pragma("unroll") for (int r = 0; r < 16; ++r) { SC1[r] = __builtin_amdgcn_exp2f(SC1[r]); rs_ += SC1[r]; } \
        { u32x4 w; \
          w.x = pk2(SC1[0], SC1[1]); w.y = pk2(SC1[2], SC1[3]); w.z = pk2(SC1[4], SC1[5]); w.w = pk2(SC1[6], SC1[7]); pf_[2] = __builtin_bit_cast(bf16x8, w); \
          w.x = pk2(SC1[8], SC1[9]); w.y = pk2(SC1[10], SC1[11]); w.z = pk2(SC1[12], SC1[13]); w.w = pk2(SC1[14], SC1[15]); pf_[3] = __builtin_bit_cast(bf16x8, w); } \
        l_run += rs_; \
        ATT_SB(); \
          \
        __builtin_amdgcn_s_setprio(1); \
        _Pragma("unroll") for (int d0 = 0; d0 < HD / 32; ++d0) _Pragma("unroll") for (int kk = 0; kk < 4; ++kk) \
            o[d0] = __builtin_amdgcn_mfma_f32_32x32x16_bf16(vf_[d0][kk], pf_[kk], o[d0], 0, 0, 0); \
        ATT_SB(); \
        __builtin_amdgcn_s_setprio(0); \
        if (has2_) ATT_STORE(bw, KSt, VSt); \
        { const int tmp_ = bc; bc = bn; bn = bw; bw = tmp_; } \
    } while (0)
    int t = t0;
    for (; t + 1 < t1; t += 2) { ATT_STEP(sa0, sa1, sb0, sb1, t, kstB, vstB, kstA, vstA); ATT_STEP(sb0, sb1, sa0, sa1, t + 1, kstA, vstA, kstB, vstB); }
    if (t < t1) ATT_STEP(sa0, sa1, sb0, sb1, t, kstB, vstB, kstA, vstA);
    float l_tot; { auto rr = __builtin_amdgcn_permlane32_swap(__float_as_uint(l_run), __float_as_uint(l_run), false, false); l_tot = __uint_as_float(rr[0]) + __uint_as_float(rr[1]); }
    const float inv = 1.0f / l_tot;
    gbf16* orow = Og + (size_t)(wid * 32 + r32) * o_pitch + 4 * hi;
#pragma unroll
    for (int d0 = 0; d0 < HD / 32; ++d0)
#pragma unroll
        for (int rq = 0; rq < 4; ++rq) { u32x2 w; w.x = pk2(o[d0][4 * rq] * inv, o[d0][4 * rq + 1] * inv); w.y = pk2(o[d0][4 * rq + 2] * inv, o[d0][4 * rq + 3] * inv);
            *(gu32x2*)(orow + 32 * d0 + 8 * rq) = w; }
#undef ATT_STEP
#undef ATT_SB
#undef ATT_QK
#undef ATT_LOAD
#undef ATT_STORE
}

template <int HD, int MODE>
__device__ __forceinline__ void attn_unit_np(LAS unsigned char* lds, const int tid_in, const gbf16* Qg, int q_pitch, const gbf16* Kg, int k_pitch,
                                          const gbf16* Vtg, int vt_pitch, gbf16* Og, int o_pitch, int t0, int t1, float c,
                                          int q0, const gfloat* biasg, float m_init, float l_init) {
    constexpr int KROW = HD * 2 + 16, VROW = 144, KBYTES = 64 * KROW, VBYTES = HD * VROW, BUF = KBYTES + VBYTES, NP = HD / 64;
    static_assert(2 * BUF <= ATT_BIAS_OFF, "attention LDS");
    int tid = tid_in; asm volatile("" : "+v"(tid));
    const int lane = tid & 63, wid = __builtin_amdgcn_readfirstlane(tid >> 6), r32 = lane & 31, hi = lane >> 5;
    bf16x8 qf[HD / 16];
    { const gbf16* qrow = Qg + (size_t)(wid * 32 + r32) * q_pitch + hi * 8;
#pragma unroll
      for (int d0 = 0; d0 < HD / 16; ++d0) qf[d0] = *(const gbf16x8*)(qrow + d0 * 16); }
    u32x4 kst[NP], vst[NP];
    const gbf16* kg[NP]; const gbf16* vg[NP]; unsigned kl[NP], vl[NP];
#pragma unroll
    for (int p = 0; p < NP; ++p) { const int idx = tid + 512 * p; const int krow = idx / (HD / 8), kch = idx % (HD / 8), vd = idx >> 3, vch = idx & 7;
        kg[p] = Kg + (size_t)krow * k_pitch + kch * 8; vg[p] = Vtg + (size_t)vd * vt_pitch + vch * 8;
        kl[p] = krow * KROW + kch * 16; vl[p] = KBYTES + vd * VROW + vch * 16; }
#define ATT_LOAD(t) do { _Pragma("unroll") for (int p = 0; p < NP; ++p) { kst[p] = *(const gu32x4*)(kg[p] + (size_t)(t) * 64 * k_pitch); vst[p] = *(const gu32x4*)(vg[p] + (t) * 64); } } while (0)
#define ATT_STORE(b) do { _Pragma("unroll") for (int p = 0; p < NP; ++p) { *(LAS u32x4*)(lds + (b) * BUF + kl[p]) = kst[p]; *(LAS u32x4*)(lds + (b) * BUF + vl[p]) = vst[p]; } } while (0)
    const int pr = (r32 & 0x13) | ((r32 & 4) << 1) | ((r32 & 8) >> 1);
    const unsigned krd = pr * KROW + hi * 16, vrd = KBYTES + r32 * VROW + hi * 16;
    f32x16 o[HD / 32];
#pragma unroll
    for (int d0 = 0; d0 < HD / 32; ++d0)
#pragma unroll
        for (int r = 0; r < 16; ++r) o[d0][r] = 0.f;
    float m_run = m_init, l_run = l_init;
    const LAS float* biasl = (const LAS float*)(lds + ATT_BIAS_OFF);
    __syncthreads();
    ATT_LOAD(t0); ATT_STORE(0);
    if (MODE == 1) { ((LAS float*)(lds + ATT_BIAS_OFF))[tid] = biasg[tid]; if (tid < 256) ((LAS float*)(lds + ATT_BIAS_OFF))[512 + tid] = biasg[512 + tid]; }
    int cur = 0;
    const int qlo = q0 + wid * 32;
    for (int t = t0; t < t1; ++t) {
        __syncthreads();
        const bool more = (t + 1 < t1);
        if (more) ATT_LOAD(t + 1);
        bool active = true;
        if (MODE == 1) active = !(64 * t + 63 < qlo - 128 || 64 * t > qlo + 31 + 128);
        if (active) {
            const LAS unsigned char* kb = lds + cur * BUF + krd;
            const LAS unsigned char* vb = lds + cur * BUF + vrd;
            f32x16 s0, s1;
#pragma unroll
            for (int r = 0; r < 16; ++r) { s0[r] = 0.f; s1[r] = 0.f; }
            if constexpr (HD == 64) {
                bf16x8 kf0[HD / 16], kf1[HD / 16];
#pragma unroll
                for (int d0 = 0; d0 < HD / 16; ++d0) { kf0[d0] = *(const LAS bf16x8*)(kb + d0 * 32); kf1[d0] = *(const LAS bf16x8*)(kb + 32 * KROW + d0 * 32); }
                __builtin_amdgcn_sched_barrier(0);
                __builtin_amdgcn_s_setprio(1);
#pragma unroll
                for (int d0 = 0; d0 < HD / 16; ++d0) { s0 = __builtin_amdgcn_mfma_f32_32x32x16_bf16(kf0[d0], qf[d0], s0, 0, 0, 0); s1 = __builtin_amdgcn_mfma_f32_32x32x16_bf16(kf1[d0], qf[d0], s1, 0, 0, 0); }
                __builtin_amdgcn_s_setprio(0);
            } else {
            __builtin_amdgcn_s_setprio(1);
#pragma unroll
            for (int d0 = 0; d0 < HD / 16; ++d0) {
                const bf16x8 k0 = *(const LAS bf16x8*)(kb + d0 * 32);
                const bf16x8 k1 = *(const LAS bf16x8*)(kb + 32 * KROW + d0 * 32);
                s0 = __builtin_amdgcn_mfma_f32_32x32x16_bf16(k0, qf[d0], s0, 0, 0, 0);
                s1 = __builtin_amdgcn_mfma_f32_32x32x16_bf16(k1, qf[d0], s1, 0, 0, 0);
            }
            __builtin_amdgcn_s_setprio(0); }
            if (MODE == 1) {
                const LAS float* bl = biasl + (64 * t + 8 * hi - (qlo + r32) + 384);
#pragma unroll
                for (int r = 0; r < 16; ++r) { s0[r] += bl[16 * (r >> 3) + (r & 7)]; s1[r] += bl[32 + 16 * (r >> 3) + (r & 7)]; }
            }
            float mx = fmaxf(s0[0], s1[0]);
#pragma unroll
            for (int r = 1; r < 16; ++r) mx = fmaxf(mx, fmaxf(s0[r], s1[r]));
            { auto rr = __builtin_amdgcn_permlane32_swap(__float_as_uint(mx), __float_as_uint(mx), false, false); mx = fmaxf(__uint_as_float(rr[0]), __uint_as_float(rr[1])); }
            const float m_new = fmaxf(m_run, mx);
            const bool grew = __any(m_new > m_run);
            const float alpha = __builtin_amdgcn_exp2f(m_run - m_new);
            m_run = m_new;
            float rs = 0.f;
#pragma unroll
            for (int r = 0; r < 16; ++r) { s0[r] = __builtin_amdgcn_exp2f(s0[r] - m_new); s1[r] = __builtin_amdgcn_exp2f(s1[r] - m_new); rs += s0[r] + s1[r]; }
            l_run = l_run * alpha + rs;
            if (grew) {
#pragma unroll
                for (int d0 = 0; d0 < HD / 32; ++d0)
#pragma unroll
                    for (int r = 0; r < 16; ++r) o[d0][r] *= alpha;
            }
            bf16x8 pf[4];
            { u32x4 w;
              w.x = pk2(s0[0], s0[1]); w.y = pk2(s0[2], s0[3]); w.z = pk2(s0[4], s0[5]); w.w = pk2(s0[6], s0[7]); pf[0] = __builtin_bit_cast(bf16x8, w);
              w.x = pk2(s0[8], s0[9]); w.y = pk2(s0[10], s0[11]); w.z = pk2(s0[12], s0[13]); w.w = pk2(s0[14], s0[15]); pf[1] = __builtin_bit_cast(bf16x8, w);
              w.x = pk2(s1[0], s1[1]); w.y = pk2(s1[2], s1[3]); w.z = pk2(s1[4], s1[5]); w.w = pk2(s1[6], s1[7]); pf[2] = __builtin_bit_cast(bf16x8, w);
              w.x = pk2(s1[8], s1[9]); w.y = pk2(s1[10], s1[11]); w.z = pk2(s1[12], s1[13]); w.w = pk2(s1[14], s1[15]); pf[3] = __builtin_bit_cast(bf16x8, w); }
            if constexpr (HD == 64) {
                bf16x8 vfr[HD / 32][4];
#pragma unroll
                for (int d0 = 0; d0 < HD / 32; ++d0)
#pragma unroll
                    for (int kk = 0; kk < 4; ++kk) vfr[d0][kk] = *(const LAS bf16x8*)(vb + d0 * 32 * VROW + kk * 32);
                __builtin_amdgcn_sched_barrier(0);
                __builtin_amdgcn_s_setprio(1);
#pragma unroll
                for (int d0 = 0; d0 < HD / 32; ++d0)
#pragma unroll
                    for (int kk = 0; kk < 4; ++kk) o[d0] = __builtin_amdgcn_mfma_f32_32x32x16_bf16(vfr[d0][kk], pf[kk], o[d0], 0, 0, 0);
                __builtin_amdgcn_s_setprio(0);
            } else {
            __builtin_amdgcn_s_setprio(1);
#pragma unroll
            for (int d0 = 0; d0 < HD / 32; ++d0)
#pragma unroll
                for (int kk = 0; kk < 4; ++kk) {
                    const bf16x8 vf = *(const LAS bf16x8*)(vb + d0 * 32 * VROW + kk * 32);
                    o[d0] = __builtin_amdgcn_mfma_f32_32x32x16_bf16(vf, pf[kk], o[d0], 0, 0, 0);
                }
            __builtin_amdgcn_s_setprio(0); }
        }
        if (more) ATT_STORE(cur ^ 1);
        cur ^= 1;
    }
    float l_tot; { auto rr = __builtin_amdgcn_permlane32_swap(__float_as_uint(l_run), __float_as_uint(l_run), false, false); l_tot = __uint_as_float(rr[0]) + __uint_as_float(rr[1]); }
    const float inv = 1.0f / l_tot;
    gbf16* orow = Og + (size_t)(wid * 32 + r32) * o_pitch + 4 * hi;
#pragma unroll
    for (int d0 = 0; d0 < HD / 32; ++d0)
#pragma unroll
        for (int rq = 0; rq < 4; ++rq) { u32x2 w; w.x = pk2(o[d0][4 * rq] * inv, o[d0][4 * rq + 1] * inv); w.y = pk2(o[d0][4 * rq + 2] * inv, o[d0][4 * rq + 3] * inv);
            *(gu32x2*)(orow + 32 * d0 + 8 * rq) = w; }
#undef ATT_LOAD
#undef ATT_STORE
}

__device__ __forceinline__ void rms_row_bf16(const gfloat* src, const gfloat* gain, gbf16* dst, int lane) {
    const gf32x4* xr = (const gf32x4*)src + lane; const gf32x4* gr = (const gf32x4*)gain + lane;
    f32x4 v[4]; float s = 0.f;
#pragma unroll
    for (int j = 0; j < 4; ++j) { v[j] = xr[64 * j]; s += (v[j].x * v[j].x + v[j].y * v[j].y) + (v[j].z * v[j].z + v[j].w * v[j].w); }
    const float rstd = 1.0f / sqrtf(wave_sum(s) * (1.0f / DM) + EPS);
    gu32x2* o8 = (gu32x2*)dst + lane;
#pragma unroll
    for (int j = 0; j < 4; ++j) { const f32x4 g = gr[64 * j]; u32x2 w; w.x = pk2(v[j].x * rstd * g.x, v[j].y * rstd * g.y); w.y = pk2(v[j].z * rstd * g.z, v[j].w * rstd * g.w); o8[64 * j] = w; }
}
__device__ __forceinline__ void rms_row2_bf16(const gfloat* src0, const gfloat* src1, const gfloat* gain, gbf16* dst0, gbf16* dst1, int lane) {
    const gf32x4* x0 = (const gf32x4*)src0 + lane; const gf32x4* x1 = (const gf32x4*)src1 + lane; const gf32x4* gr = (const gf32x4*)gain + lane;
    f32x4 v[4], w[4], g[4]; float s = 0.f, t = 0.f;
#pragma unroll
    for (int j = 0; j < 4; ++j) { v[j] = x0[64 * j]; w[j] = x1[64 * j]; g[j] = gr[64 * j]; }
    asm volatile("" ::: "memory");
#pragma unroll
    for (int j = 0; j < 4; ++j) { s += (v[j].x * v[j].x + v[j].y * v[j].y) + (v[j].z * v[j].z + v[j].w * v[j].w); t += (w[j].x * w[j].x + w[j].y * w[j].y) + (w[j].z * w[j].z + w[j].w * w[j].w); }
#pragma unroll
    for (int o = 1; o < 64; o <<= 1) { s += __shfl_xor(s, o); t += __shfl_xor(t, o); }
    const float r0 = __builtin_amdgcn_rsqf(s * (1.0f / DM) + EPS), r1 = __builtin_amdgcn_rsqf(t * (1.0f / DM) + EPS);
    gu32x2* o0 = (gu32x2*)dst0 + lane; gu32x2* o1 = (gu32x2*)dst1 + lane;
#pragma unroll
    for (int j = 0; j < 4; ++j) { u32x2 a, b;
        a.x = pk2(v[j].x * r0 * g[j].x, v[j].y * r0 * g[j].y); a.y = pk2(v[j].z * r0 * g[j].z, v[j].w * r0 * g[j].w); o0[64 * j] = a;
        b.x = pk2(w[j].x * r1 * g[j].x, w[j].y * r1 * g[j].y); b.y = pk2(w[j].z * r1 * g[j].z, w[j].w * r1 * g[j].w); o1[64 * j] = b; }
}
__device__ __forceinline__ void final_row2(gfloat* p0, gfloat* p1, const gfloat* gain, float rs0, float rs1, int lane) {
    gf32x4* x0 = (gf32x4*)p0 + lane; gf32x4* x1 = (gf32x4*)p1 + lane; const gf32x4* gr = (const gf32x4*)gain + lane;
    f32x4 v[4], w[4];
#pragma unroll
    for (int j = 0; j < 4; ++j) { v[j] = x0[64 * j]; w[j] = x1[64 * j]; }
#pragma unroll
    for (int j = 0; j < 4; ++j) { const f32x4 g = gr[64 * j]; x0[64 * j] = v[j] * rs0 * g; x1[64 * j] = w[j] * rs1 * g; }
}
__device__ __forceinline__ float rstd_row(const gfloat* ssq, int row) { const f32x4 p = *(const gf32x4*)(ssq + (size_t)row * 4); return 1.0f / sqrtf(((p.x + p.y) + (p.z + p.w)) * (1.0f / DM) + EPS); }
__device__ __forceinline__ void final_row(gfloat* p, const gfloat* gain, float rstd, int lane) {
    gf32x4* xr = (gf32x4*)p + lane; const gf32x4* gr = (const gf32x4*)gain + lane;
    f32x4 v[4];
#pragma unroll
    for (int j = 0; j < 4; ++j) v[j] = xr[64 * j];
#pragma unroll
    for (int j = 0; j < 4; ++j) { const f32x4 g = gr[64 * j]; xr[64 * j] = v[j] * rstd * g; }
}
__device__ __forceinline__ void transpose_item(const gfloat* W, int K, int N, gbf16* WT, int mode, LAS float* scr, int item, int lane, const gfloat* gain = nullptr) {
    const int nblk = N / 32, kb = item / nblk, nb = item % nblk, k0 = 64 * kb, n0 = 32 * nb;
#pragma unroll 8
    for (int i = 0; i < 32; ++i) { const int kk = 2 * i + (lane >> 5); float w = W[(size_t)(k0 + kk) * N + n0 + (lane & 31)]; if (gain) w *= gain[k0 + kk]; scr[kk * 33 + (lane & 31)] = w; }
    asm volatile("s_waitcnt lgkmcnt(0)" ::: "memory");
    int r0 = n0;
    if (mode == 1) { const int half = n0 >= FF ? 1 : 0, np = n0 - FF * half; r0 = 256 * (np / 128) + 128 * half + (np % 128); }
    const int c = lane & 7;
#pragma unroll
    for (int j = 0; j < 4; ++j) { const int n = (lane >> 3) + 8 * j; const LAS float* s = scr + (8 * c) * 33 + n;
        u32x4 o; o.x = pk2(s[0 * 33], s[1 * 33]); o.y = pk2(s[2 * 33], s[3 * 33]); o.z = pk2(s[4 * 33], s[5 * 33]); o.w = pk2(s[6 * 33], s[7 * 33]);
        *(gu32x4*)(WT + (size_t)(r0 + n) * K + k0 + 8 * c) = o; }
    asm volatile("s_waitcnt lgkmcnt(0)" ::: "memory");
}
__device__ __forceinline__ void transpose64_bf16(const gbf16* src, size_t src_pitch, gbf16* dst, size_t dst_pitch, LAS unsigned short* scr, int lane) {
#pragma unroll
    for (int p = 0; p < 8; ++p) { const int row = 8 * p + (lane >> 3), ch = lane & 7; const u32x4 v = *(const gu32x4*)(src + (size_t)row * src_pitch + 8 * ch);
        LAS unsigned short* d = scr + row * 66 + 8 * ch;
        d[0] = (unsigned short)v.x; d[1] = (unsigned short)(v.x >> 16); d[2] = (unsigned short)v.y; d[3] = (unsigned short)(v.y >> 16);
        d[4] = (unsigned short)v.z; d[5] = (unsigned short)(v.z >> 16); d[6] = (unsigned short)v.w; d[7] = (unsigned short)(v.w >> 16); }
    asm volatile("s_waitcnt lgkmcnt(0)" ::: "memory");
#pragma unroll
    for (int p = 0; p < 8; ++p) { const int j = 8 * p + (lane >> 3), i0 = 8 * (lane & 7); const LAS unsigned short* s = scr + i0 * 66 + j;
        u32x4 o; o.x = (unsigned)s[0] | ((unsigned)s[66] << 16); o.y = (unsigned)s[2 * 66] | ((unsigned)s[3 * 66] << 16);
        o.z = (unsigned)s[4 * 66] | ((unsigned)s[5 * 66] << 16); o.w = (unsigned)s[6 * 66] | ((unsigned)s[7 * 66] << 16);
        *(gu32x4*)(dst + (size_t)j * dst_pitch + i0) = o; }
    asm volatile("s_waitcnt lgkmcnt(0)" ::: "memory");
}
__device__ __forceinline__ void sincos_d(double a, float& sn, float& cs) {
    const double k = rint(a * 0.63661977236758134308);
    const double r = (a - k * 1.57079632679489655800) - k * 6.123233995736766036e-17;
    const double r2 = r * r;
    const double s = r * (1.0 + r2 * (-1.0 / 6 + r2 * (1.0 / 120 + r2 * (-1.0 / 5040 + r2 * (1.0 / 362880 + r2 * (-1.0 / 39916800 + r2 * (1.0 / 6227020800.0)))))));
    const double c = 1.0 + r2 * (-0.5 + r2 * (1.0 / 24 + r2 * (-1.0 / 720 + r2 * (1.0 / 40320 + r2 * (-1.0 / 3628800 + r2 * (1.0 / 479001600.0 + r2 * (-1.0 / 87178291200.0)))))));
    const int q = ((int)k) & 3;
    const double ss = (q == 0) ? s : (q == 1) ? c : (q == 2) ? -s : -c;
    const double cc = (q == 0) ? c : (q == 1) ? -s : (q == 2) ? -c : s;
    sn = (float)ss; cs = (float)cc;
}

#define XB_TMO      128
#define XB_XCNT(j)  (256  + 64 * (j))
#define XB_XSUB(j)  (1280 + 64 * (j))
#define XB_XGEN(j)  (2304 + 64 * (j))
#define XB_TOP      3328
#define XB_TOPGEN   3392
#define XCD_BAR_WORDS 3456
#define XB_SPIN_CAP (1u << 18)

__device__ __forceinline__ unsigned xb_ld(unsigned* p)              { return __hip_atomic_load(p, __ATOMIC_RELAXED, __HIP_MEMORY_SCOPE_AGENT); }
__device__ __forceinline__ unsigned xb_add(unsigned* p, unsigned v) { return __hip_atomic_fetch_add(p, v, __ATOMIC_RELAXED, __HIP_MEMORY_SCOPE_AGENT); }
__device__ __forceinline__ unsigned xb_xcc_id() { return (unsigned)__builtin_amdgcn_s_getreg((3 << 11) | 20) & 0xFu; }
#define XB_SPIN(cond, bar) do { unsigned _sp = 0; while (cond) { __builtin_amdgcn_s_sleep(1); \
    if ((++_sp & 255u) == 0u) { if (xb_ld(&(bar)[XB_TMO])) break; if (_sp > XB_SPIN_CAP) { atomicAdd(&(bar)[XB_TMO], 1u); break; } } } } while (0)

struct XcdBarrier {
    unsigned* bar; unsigned x;
    volatile LAS unsigned* st;
};

__device__ __forceinline__ XcdBarrier xcd_barrier_post(unsigned* bar, volatile LAS unsigned* st) {
    XcdBarrier b; b.bar = bar; b.x = xb_xcc_id(); b.st = st;
    if (threadIdx.x == 0) (void)xb_add(&bar[XB_XCNT(b.x)], 1u);
    return b;
}
__device__ __forceinline__ void xcd_barrier_complete(unsigned* bar, unsigned x, unsigned& nloc, unsigned& nx) {
    const unsigned G = gridDim.x * gridDim.y * gridDim.z;
    unsigned sum, cnt, mine, sp = 0u;
    for (;;) {
        sum = 0u; cnt = 0u; mine = 0u;
#pragma unroll
        for (unsigned j = 0; j < 16; ++j) { const unsigned c = xb_ld(&bar[XB_XCNT(j)]); sum += c; cnt += (c > 0u) ? 1u : 0u; mine = (j == x) ? c : mine; }
        if (sum == G) break;
        __builtin_amdgcn_s_sleep(1);
        if ((++sp & 255u) == 0u) { if (xb_ld(&bar[XB_TMO])) break; if (sp > XB_SPIN_CAP) { atomicAdd(&bar[XB_TMO], 1u); break; } }
    }
    nloc = mine > 0u ? mine : 1u; nx = cnt > 0u ? cnt : 1u;
}

__device__ __forceinline__ void xcd_barrier(const XcdBarrier& b) {
    asm volatile("s_waitcnt vmcnt(0)" ::: "memory");
    __syncthreads();
    if (threadIdx.x == 0) {
        unsigned* bar = b.bar; const unsigned bx_ = xb_xcc_id();
        __builtin_amdgcn_s_waitcnt(0);
        unsigned nloc = b.st[0], nx = b.st[1];
        if (nloc == 0u) { xcd_barrier_complete(bar, bx_, nloc, nx); b.st[0] = nloc; b.st[1] = nx; }
        const unsigned old = xb_add(&bar[XB_XSUB(bx_)], 1u);
        const unsigned gen = old / nloc;
        if (old + 1u == (gen + 1u) * nloc) {
            __builtin_amdgcn_fence(__ATOMIC_RELEASE, "agent");
            asm volatile("s_waitcnt vmcnt(0)" ::: "memory");
            const unsigned og = xb_add(&bar[XB_TOP], 1u);
            const unsigned tg = og / nx;
            if (og + 1u == (tg + 1u) * nx) xb_add(&bar[XB_TOPGEN], 1u);
            else XB_SPIN(xb_ld(&bar[XB_TOPGEN]) == tg, bar);
            __builtin_amdgcn_fence(__ATOMIC_ACQUIRE, "agent");
            xb_add(&bar[XB_XGEN(bx_)], 1u);
            asm volatile("s_waitcnt vmcnt(0)" ::: "memory");
        } else {
            XB_SPIN(xb_ld(&bar[XB_XGEN(bx_)]) == gen, bar);
            __builtin_amdgcn_fence(__ATOMIC_ACQUIRE, "agent");
            asm volatile("s_waitcnt vmcnt(0)" ::: "memory");
        }
    }
    __syncthreads();
}


#define XL_SUB(j)  (4096 + 64 * (j))
#define XL_GEN(j)  (5120 + 64 * (j))
#define XL_RANK(j) (6144 + 64 * (j))
#define XL_BAD     7168
__device__ __forceinline__ void xcd_local_barrier(const XcdBarrier& b) {
    asm volatile("s_waitcnt vmcnt(0)" ::: "memory");
    __syncthreads();
    if (threadIdx.x == 0) {
        unsigned* bar = b.bar; const unsigned x_ = xb_xcc_id();
        __builtin_amdgcn_s_waitcnt(0);
        const unsigned nloc = b.st[0];
        const unsigned old = xb_add(&bar[XL_SUB(x_)], 1u);
        const unsigned gen = old / nloc;
        if (old + 1u == (gen + 1u) * nloc) xb_add(&bar[XL_GEN(x_)], 1u);
        else XB_SPIN(xb_ld(&bar[XL_GEN(x_)]) == gen, bar);
        __builtin_amdgcn_fence(__ATOMIC_ACQUIRE, "agent");
        asm volatile("s_waitcnt vmcnt(0)" ::: "memory");
    }
    __syncthreads();
}

struct Args { const float* in[23]; float* out; unsigned char* ws; int ph_lo, ph_hi; };
enum { I_XP = 0, I_XS, I_MP, I_MS, I_RELB, I_NFF1, I_FF1I, I_FF1O, I_NMIX, I_WIN, I_QN, I_KN, I_SINK, I_NMEM, I_WMEM, I_BRA, I_BRB, I_BRC, I_WOUT, I_NFF2, I_FF2I, I_FF2O, I_NFIN };
constexpr int N_PRO = 3, N_PER = 10, N_STEPS = N_PRO + N_PER * NCH + 1;

constexpr int LDS_XB = 136192 + 256;
constexpr int LDS_PTRS = 136192;
__device__ __forceinline__ const gfloat* ldsptr(LAS unsigned char* lds, int i) {
    const unsigned long long v = ((const LAS unsigned long long*)(lds + LDS_PTRS))[i];
    const unsigned lo = __builtin_amdgcn_readfirstlane((unsigned)v), hi = __builtin_amdgcn_readfirstlane((unsigned)(v >> 32));
    return (const gfloat*)(((unsigned long long)hi << 32) | lo);
}
#define INP(i) ldsptr(lds, (i))
__global__ void __launch_bounds__(512, 2) mega_fwd(Args a) {
    extern __shared__ __attribute__((aligned(16))) unsigned char lds_raw[];
    LAS unsigned char* lds = (LAS unsigned char*)lds_raw;
    cg::grid_group grid = cg::this_grid();
    if (threadIdx.x < 23) ((LAS unsigned long long*)(lds + LDS_PTRS))[threadIdx.x] = (unsigned long long)a.in[threadIdx.x];
    if (threadIdx.x == 23) ((LAS unsigned long long*)(lds + LDS_PTRS))[23] = (unsigned long long)a.out;
    if (threadIdx.x == 24) ((LAS unsigned long long*)(lds + LDS_PTRS))[24] = (unsigned long long)a.ws;
    if (threadIdx.x == 25) { ((volatile LAS unsigned*)(lds + LDS_XB))[0] = 0u; ((volatile LAS unsigned*)(lds + LDS_XB))[1] = 0u; }
    __syncthreads();
    const XcdBarrier xbar = xcd_barrier_post((unsigned*)(a.ws + WS_BAR), (volatile LAS unsigned*)(lds + LDS_XB));
    if (threadIdx.x == 0) { const unsigned x_ = xb_xcc_id(); ((volatile LAS unsigned*)(lds + LDS_XB))[2] = x_; ((volatile LAS unsigned*)(lds + LDS_XB))[3] = xb_add((unsigned*)(a.ws + WS_BAR) + XL_RANK(x_), 1u); ((volatile LAS unsigned*)(lds + LDS_XB))[4] = 0u; }
    __syncthreads();
    const int wave_s = __builtin_amdgcn_readfirstlane((int)threadIdx.x >> 6);
#define STEP_LOCALS \
        int tid = wave_s * 64 + (int)__builtin_amdgcn_mbcnt_hi(~0u, __builtin_amdgcn_mbcnt_lo(~0u, 0u)); asm volatile("" : "+v"(tid)); \
        const int lane = tid & 63, wave = __builtin_amdgcn_readfirstlane(tid >> 6); \
        const int G = gridDim.x, bx = blockIdx.x; \
        const int vcu = (G % 8 == 0) ? (bx % 8) * (G / 8) + bx / 8 : bx; \
        const int gw = vcu * 8 + wave, NGW = G * 8; \
        guchar* ws = (guchar*)INP(24); \
        gfloat* const outp = (gfloat*)INP(23); \
        gbf16* const W_ff1i = (gbf16*)(ws + WS_WFF1I); gbf16* const W_ff1o = (gbf16*)(ws + WS_WFF1O); gbf16* const W_in = (gbf16*)(ws + WS_WIN); \
        gbf16* const W_mem = (gbf16*)(ws + WS_WMEM); gbf16* const W_br = (gbf16*)(ws + WS_WBR); gbf16* const W_out = (gbf16*)(ws + WS_WOUT); \
        gbf16* const W_ff2i = (gbf16*)(ws + WS_WFF2I); gbf16* const W_ff2o = (gbf16*)(ws + WS_WFF2O); \
        gbf16* const memn = (gbf16*)(ws + WS_MEMN); gbf16* const kvm = (gbf16*)(ws + WS_KVM); gbf16* const vtc = (gbf16*)(ws + WS_VTC); \
        gf32x2* const rope = (gf32x2*)(ws + WS_ROPE); gfloat* const biast = (gfloat*)(ws + WS_BIAS); \
        gbf16* const xn = (gbf16*)(ws + WS_XN); gbf16* const hid = (gbf16*)(ws + WS_HID); gbf16* const proj = (gbf16*)(ws + WS_PROJ); \
        gbf16* const vta = (gbf16*)(ws + WS_VTA); gbf16* const vtb = (gbf16*)(ws + WS_VTB); gbf16* const yb3 = (gbf16*)(ws + WS_Y); \
        gbf16* const part = (gbf16*)(ws + WS_PART); gbf16* const mrg = (gbf16*)(ws + WS_MRG); gfloat* const ssq = (gfloat*)(ws + WS_SSQ);
    if (PH_EN(0)) { STEP_LOCALS
            LAS float* scr = (LAS float*)(lds + wave * 16384);
            constexpr int I_FI = (DM / 64) * (2 * FF / 32), I_FO = (FF / 64) * (DM / 32), I_IN = (DM / 64) * (PROJ / 32), I_SQ = (DM / 64) * (DM / 32), I_BR = (512 / 64) * (DM / 32);
            constexpr int NITEMS = 2 * I_FI + 2 * I_FO + I_IN + 2 * I_SQ + 3 * I_BR;
            for (int it = gw; it < NITEMS; it += NGW) {
                int r = it;
                if (r < I_FI) { transpose_item(INP(I_FF1I), DM, 2 * FF, W_ff1i, 1, scr, r, lane); continue; } r -= I_FI;
                if (r < I_FI) { transpose_item(INP(I_FF2I), DM, 2 * FF, W_ff2i, 1, scr, r, lane, INP(I_NFF2)); continue; } r -= I_FI;
                if (r < I_FO) { transpose_item(INP(I_FF1O), FF, DM, W_ff1o, 0, scr, r, lane); continue; } r -= I_FO;
                if (r < I_FO) { transpose_item(INP(I_FF2O), FF, DM, W_ff2o, 0, scr, r, lane); continue; } r -= I_FO;
                if (r < I_IN) { transpose_item(INP(I_WIN), DM, PROJ, W_in, 0, scr, r, lane, INP(I_NMIX)); continue; } r -= I_IN;
                if (r < I_SQ) { transpose_item(INP(I_WMEM), DM, DM, W_mem, 0, scr, r, lane); continue; } r -= I_SQ;
                if (r < I_SQ) { transpose_item(INP(I_WOUT), DM, DM, W_out, 0, scr, r, lane); continue; } r -= I_SQ;
                if (r < I_BR) { transpose_item(INP(I_BRA), 512, DM, W_br, 0, scr, r, lane); continue; } r -= I_BR;
                if (r < I_BR) { transpose_item(INP(I_BRB), 512, DM, W_br + (size_t)DM * 512, 0, scr, r, lane); continue; } r -= I_BR;
                transpose_item(INP(I_BRC), 512, DM, W_br + (size_t)2 * DM * 512, 0, scr, r, lane);
            }
            const gfloat* mp_p = INP(I_MP); const gfloat* ms_p = INP(I_MS); const gfloat* nmem_p = INP(I_NMEM);
            for (int m = gw; m < NMEM; m += NGW) {
                const gfloat* src = (m < 2048) ? mp_p + (size_t)m * DM : ms_p + (size_t)(m - 2048) * DM;
                rms_row_bf16(src, nmem_p, memn + (size_t)m * DM, lane);
            }
            for (int i = vcu * 512 + tid; i < 2048; i += G * 512) {
                const int n = i >> 4, j = i & 15;
                const int jl = j & 3, jh = j >> 2;
                const float b = (jl == 0) ? 1.0f : (jl == 1) ? 0.5623413251903491f : (jl == 2) ? 0.31622776601683794f : 0.1778279410038923f;
                const float s = (jh == 0) ? 1.0f : (jh == 1) ? 0.1f : (jh == 2) ? 0.01f : 0.001f;
                const float inv = b * s;
                const float ang = (float)n * inv;
                float sn, cs; sincos_d((double)ang, sn, cs);
                rope[i] = (f32x2){cs, sn};
            }
            const gfloat* relb_p = INP(I_RELB);
            for (int i = vcu * 512 + tid; i < 8 * 768; i += G * 512) {
                const int h = i / 768, rel = (i % 768) - 384;
                if (rel < -128 || rel > 128) { biast[i] = -1e30f; continue; }
                const int n = rel < 0 ? -rel : rel;
                int large = 33 - __clz(n * n > 0 ? n * n : 1); if (large > 15) large = 15;
                const int bucket = (rel > 0 ? 16 : 0) + (n < 8 ? n : large);
                biast[i] = relb_p[bucket * 8 + h] * LOG2E;
            }
    }
    grid.sync();
    if (PH_EN(1)) { STEP_LOCALS
            pg8::Gemm g{memn, W_mem, NMEM, DM, DM, 0, 0}; pg8::StaticOrder S; S.init(NMEM, DM, G, bx);
            pg8::EpiPlain E{kvm, DM};
            pg8::gemm_phase(lds, tid, g, S, E);
    }
    xcd_barrier(xbar);
    if (threadIdx.x == 0) { volatile LAS unsigned* w_ = (volatile LAS unsigned*)(lds + LDS_XB);
        if (w_[0] * 8u != gridDim.x || w_[1] != 8u || w_[2] >= 8u || w_[3] >= gridDim.x / 8u) __hip_atomic_store((unsigned*)(a.ws + WS_BAR) + XL_BAD, 1u, __ATOMIC_RELAXED, __HIP_MEMORY_SCOPE_AGENT); }
    if (PH_EN(2)) { STEP_LOCALS
            LAS unsigned short* scr = (LAS unsigned short*)(lds + wave * 16384);
            for (int it = gw; it < 40 * 4 * 4 * 2; it += NGW) {
                const int db = it & 1, h = (it >> 1) & 3, mb = (it >> 3) & 3, seq = it >> 5;
                transpose64_bf16(kvm + (size_t)(seq * 256 + 64 * mb) * DM + 512 + 128 * h + 64 * db, DM,
                                 vtc + ((size_t)(seq * 4 + h) * 128 + 64 * db) * 256 + 64 * mb, 256, scr, lane);
            }
    }
    xcd_barrier(xbar);
    if (threadIdx.x == 0) ((volatile LAS unsigned*)(lds + LDS_XB))[4] = (__hip_atomic_load((unsigned*)(a.ws + WS_BAR) + XL_BAD, __ATOMIC_RELAXED, __HIP_MEMORY_SCOPE_AGENT) == 0u) ? 1u : 0u;
    __syncthreads();
    constexpr int NS = N_PER * NCH;
    for (int step2 = 0; step2 < 2 * NS; ++step2) {
        const int step = step2 >> 1;
        const bool dup_ = ((PH_DUP >> (step % N_PER)) & 1);
        if ((step2 & 1) && !dup_) continue;
        STEP_LOCALS
        const int xl_good = __builtin_amdgcn_readfirstlane((int)((volatile LAS unsigned*)(lds + LDS_XB))[4]);
        const int xl_x = __builtin_amdgcn_readfirstlane((int)((volatile LAS unsigned*)(lds + LDS_XB))[2]), xl_r = __builtin_amdgcn_readfirstlane((int)((volatile LAS unsigned*)(lds + LDS_XB))[3]);
        const int cx = xl_good ? (xl_x + 8 * xl_r) : bx;
        {
            const int c = step / N_PER, k = step % N_PER;
            const bool prompt = c < NCH_P;
#define XIN() (INP(prompt ? I_XP : I_XS) + (size_t)(prompt ? c : c - NCH_P) * CH * DM)
#define HOUT() ((gfloat*)INP(23) + (size_t)c * CH * DM)
            const int S_ = prompt ? 8192 : 2048, nseq = CH / S_, NQB = S_ / 256;
            const int memseq0 = prompt ? (CH / 8192) * c : 8 + (CH / 2048) * (c - NCH_P);
            gfloat* const ssq1 = ssq; gfloat* const ssq2 = ssq + CH * 4; gfloat* const ssq3 = ssq + 2 * CH * 4;
            if (PH_EN(3) && k == 0) {
                const gfloat* gain = INP(I_NFF1);
                const gfloat* xin_ = XIN();
                if (xl_good && (CH / 8) % (2 * G) == 0) {
                    const int m0 = (CH / 8) * xl_x + xl_r * 8 + wave;
                    for (int i0 = 0; i0 < CH / 8; i0 += 2 * G) { const size_t ra = (size_t)(m0 + i0) * DM, rb = (size_t)(m0 + i0 + G) * DM; rms_row2_bf16(xin_ + ra, xin_ + rb, gain, xn + ra, xn + rb, lane); }
                } else
                for (int m = gw; m < CH; m += 2 * NGW) { const int m1 = (m + NGW < CH) ? m + NGW : m; rms_row2_bf16(xin_ + (size_t)m * DM, xin_ + (size_t)m1 * DM, gain, xn + (size_t)m * DM, xn + (size_t)m1 * DM, lane); }
            } else if (PH_EN(4) && k == 1) {
                pg8::Gemm g{xn, W_ff1i, CH, 2 * FF, DM, 0, 0}; pg8::StaticOrder S; S.init(CH, 2 * FF, G, cx);
                pg8::EpiSwiglu E{hid};
                pg8::gemm_phase(lds, tid, g, S, E);
            } else if (PH_EN(5) && k == 2) {
                pg8::Gemm g{hid, W_ff1o, CH, DM, FF, 0, 0}; pg8::StaticOrder S; S.init(CH, DM, G, cx);
                pg8::EpiResidStats<false> E{XIN(), nullptr, xn, ssq1, 0.5f};
                pg8::gemm_phase(lds, tid, g, S, E);
            } else if (PH_EN(5) && k == 9) {
                pg8::Gemm g{hid, W_ff2o, CH, DM, FF, 0, 0}; pg8::StaticOrder S; S.init(CH, DM, G, cx);
                pg8::EpiResidFinal E{xn, HOUT(), ssq3, (unsigned*)(ws + WS_CNT), INP(I_NFIN), 0.5f, 4u * (unsigned)(c + 1)};
                pg8::gemm_phase(lds, tid, g, S, E);
            } else if (PH_EN(6) && k == 3) {
                pg8::Gemm g{xn, W_in, CH, PROJ, DM, 0, 0}; pg8::StaticOrder S; S.init(CH, PROJ, G, cx);
                pg8::EpiPlainRstd E{proj, PROJ, ssq1, 1};
                pg8::gemm_phase(lds, tid, g, S, E);
            } else if (PH_EN(7) && k == 4) {
                const gfloat* qn_p = INP(I_QN); const gfloat* kn_p = INP(I_KN);
                for (int wi = gw; wi < CH * 2 / 8; wi += 2 * NGW) {
                    const int sub = lane & 7;
                    gbf16* pp[2]; u32x4 vv[2]; int posv[2], hhv[2];
#pragma unroll
                    for (int q = 0; q < 2; ++q) { const int item = (wi + q * NGW) * 8 + (lane >> 3); const int tok = item / 2, hh = 8 + (item & 1);
                        pp[q] = proj + (size_t)tok * PROJ + 64 * hh + 8 * sub; vv[q] = *(const gu32x4*)pp[q]; posv[q] = tok % S_; hhv[q] = hh; }
#pragma unroll
                    for (int q = 0; q < 2; ++q) {
                        const u32x4 v = vv[q]; const int hh = hhv[q], pos = posv[q];
                        float x[8] = {bflo(v.x), bfhi(v.x), bflo(v.y), bfhi(v.y), bflo(v.z), bfhi(v.z), bflo(v.w), bfhi(v.w)};
                        float ss = 0.f;
#pragma unroll
                        for (int e = 0; e < 8; ++e) ss += x[e] * x[e];
                        ss += __shfl_xor(ss, 1); ss += __shfl_xor(ss, 2); ss += __shfl_xor(ss, 4);
                        const float rstd = (1.0f / sqrtf(ss * (1.0f / 64) + EPS)) * ((hh < 8) ? 0.125f * LOG2E : 1.0f);
                        const gfloat* gn = ((hh < 8) ? qn_p : kn_p) + 8 * sub;
                        const f32x4 g0 = *(const gf32x4*)gn, g1 = *(const gf32x4*)(gn + 4);
                        x[0] *= rstd * g0.x; x[1] *= rstd * g0.y; x[2] *= rstd * g0.z; x[3] *= rstd * g0.w;
                        x[4] *= rstd * g1.x; x[5] *= rstd * g1.y; x[6] *= rstd * g1.z; x[7] *= rstd * g1.w;
                        const int nidx = (sub < 4) ? (pos >> 6) : (pos & 63);
                        const gf32x4* rt = (const gf32x4*)(rope + nidx * 16 + 4 * (sub & 3));
                        const f32x4 c01 = rt[0], c23 = rt[1];
                        float y[8];
                        y[0] = x[0] * c01.x - x[1] * c01.y; y[1] = x[0] * c01.y + x[1] * c01.x;
                        y[2] = x[2] * c01.z - x[3] * c01.w; y[3] = x[2] * c01.w + x[3] * c01.z;
                        y[4] = x[4] * c23.x - x[5] * c23.y; y[5] = x[4] * c23.y + x[5] * c23.x;
                        y[6] = x[6] * c23.z - x[7] * c23.w; y[7] = x[6] * c23.w + x[7] * c23.z;
                        u32x4 w; w.x = pk2(y[0], y[1]); w.y = pk2(y[2], y[3]); w.z = pk2(y[4], y[5]); w.w = pk2(y[6], y[7]);
                        *(gu32x4*)pp[q] = w;
                    }
                }
                LAS unsigned short* scr = (LAS unsigned short*)(lds + wave * 16384);
                for (int it = gw; it < (CH / 64) * 4; it += NGW) {
                    const int kvh = it & 1, which = (it >> 1) & 1, tt = it >> 2;
                    const int tok = 64 * tt, seq = tok / S_, pos = tok % S_;
                    transpose64_bf16(proj + (size_t)tok * PROJ + (which ? 1408 : 640) + 64 * kvh, PROJ,
                                     (which ? vtb : vta) + ((size_t)(seq * 2 + kvh) * 64) * S_ + pos, S_, scr, lane);
                }
            } else if (PH_EN(8) && k == 5) {
                const gfloat* qn_att = INP(I_QN);
                for (int u = vcu; ATT_EN(0) && u < (CH / 256) * 8; u += G) {
                    const int qb = u % NQB, g4 = (u / NQB) % 4, kvh = (u / NQB / 4) % 2, seq = u / (NQB * 8), head = kvh * 4 + g4;
                    const size_t tokq = (size_t)seq * S_ + (size_t)qb * 256;
                    attn_unit<64, 0>(lds, tid, proj + tokq * PROJ + 64 * head, PROJ, proj + (size_t)seq * S_ * PROJ + 512 + 64 * kvh, PROJ,
                                     vta + ((size_t)(seq * 2 + kvh) * 64) * S_, S_, yb3 + tokq * 512 + 64 * head, 512, 0, S_ / 64,
                                     0.125f * LOG2E, qb * 256, nullptr, -1e30f, 0.f, qn_att, rope);
                }
                for (int u = vcu; ATT_EN(1) && u < (CH / 256) * 8; u += G) {
                    const int qb = u % NQB, g4 = (u / NQB) % 4, kvh = (u / NQB / 4) % 2, seq = u / (NQB * 8), head = kvh * 4 + g4;
                    const size_t tokq = (size_t)seq * S_ + (size_t)qb * 256;
                    const int q0 = qb * 256;
                    const int t0 = (q0 >= 128) ? (q0 - 128) / 64 : 0, t1 = min(S_, q0 + 384) / 64;
                    attn_unit_np<64, 1>(lds, tid, proj + tokq * PROJ + 768 + 64 * head, PROJ, proj + (size_t)seq * S_ * PROJ + 1280 + 64 * kvh, PROJ,
                                     vtb + ((size_t)(seq * 2 + kvh) * 64) * S_, S_, yb3 + (size_t)CH * 512 + tokq * 512 + 64 * head, 512, t0, t1,
                                     0.125f * LOG2E, q0, biast + head * 768, INP(I_SINK)[head] * LOG2E, 1.0f);
                }
                for (int u = vcu; ATT_EN(2) && u < (CH / 256) * 4; u += G) {
                    const int qb = u % NQB, h = (u / NQB) % 4, seq = u / (NQB * 4);
                    const size_t tokq = (size_t)seq * S_ + (size_t)qb * 256;
                    const int ms = memseq0 + seq;
                    attn_unit_np<128, 0>(lds, tid, proj + tokq * PROJ + 1536 + 128 * h, PROJ, kvm + (size_t)ms * 256 * DM + 128 * h, DM,
                                      vtc + ((size_t)(ms * 4 + h) * 128) * 256, 256, yb3 + (size_t)2 * CH * 512 + tokq * 512 + 128 * h, 512, 0, 4,
                                      0.08838834764831845f * LOG2E, 0, nullptr, -1e30f, 0.f);
                }
                __syncthreads();
            } else if (PH_EN(9) && k == 6) {
                pg8::Gemm g{yb3, W_br, CH, DM, 512, (size_t)CH * 512 * 2, (size_t)DM * 512 * 2}; pg8::BranchOrder S; S.b.init(CH, DM, G, cx);
                pg8::EpiGate E{proj, part, mrg};
                pg8::gemm_phase(lds, tid, g, S, E);
            } else if (PH_EN(10) && k == 7) {
                pg8::Gemm g{mrg, W_out, CH, DM, DM, 0, 0}; pg8::StaticOrder S; S.init(CH, DM, G, cx);
                pg8::EpiResidStats<true> E{nullptr, xn, xn, ssq2, 1.0f};
                pg8::gemm_phase(lds, tid, g, S, E);
            } else if (PH_EN(11) && k == 8) {
                pg8::Gemm g{xn, W_ff2i, CH, 2 * FF, DM, 0, 0}; pg8::StaticOrder S; S.init(CH, 2 * FF, G, cx);
                pg8::EpiSwigluRstd E{hid, ssq2};
                pg8::gemm_phase(lds, tid, g, S, E);
            }
        }
        if ((step2 & 1) || !dup_) {
            if (step + 1 < NS) { const int k_ = step % N_PER;
                if (xl_good && PH_DUP == 0 && (k_ <= 2 || k_ >= 6)) xcd_local_barrier(xbar);
                else xcd_barrier(xbar); }
        } else xcd_barrier(xbar);
    }
}

extern "C" void kernel_launch(void* const* d_in, const int* in_sizes, int n_in, void* d_out, int out_size, void* d_ws, size_t ws_size, hipStream_t stream) {
    static int grid = 0;
    if (grid == 0) {
        if (n_in != 23 || ws_size < WS_END) { fprintf(stderr, "kernel_launch: unexpected n_in %d or ws_size %zu (need %zu)\n", n_in, ws_size, (size_t)WS_END); grid = -1; return; }
        int dev = 0, cus = 0, per_cu = 0;
        hipGetDevice(&dev);
        hipDeviceGetAttribute(&cus, hipDeviceAttributeMultiprocessorCount, dev);
        if (hipFuncSetAttribute((const void*)mega_fwd, hipFuncAttributeMaxDynamicSharedMemorySize, LDS_BYTES) != hipSuccess) { fprintf(stderr, "kernel_launch: hipFuncSetAttribute failed\n"); }
        if (hipOccupancyMaxActiveBlocksPerMultiprocessor(&per_cu, (const void*)mega_fwd, 512, LDS_BYTES) != hipSuccess || per_cu < 1) { fprintf(stderr, "kernel_launch: occupancy query gave %d\n", per_cu); per_cu = 1; }
        (void)hipGetLastError();
        grid = cus * 1;
        fprintf(stderr, "kernel_launch: cus %d per_cu %d grid %d ws %zu\n", cus, per_cu, grid, ws_size);
    }
    if (grid < 0) return;
    Args a{};
    for (int i = 0; i < 23; ++i) a.in[i] = (const float*)d_in[i];
    a.out = (float*)d_out; a.ws = (unsigned char*)d_ws;
    a.ph_lo = 0; a.ph_hi = 0;
    if (hipMemsetAsync((char*)d_ws + WS_BAR, 0, 32768 + 32768, stream) != hipSuccess) { fprintf(stderr, "kernel_launch: hipMemsetAsync failed\n"); return; }
    void* args[] = {&a};
    hipError_t e = hipLaunchCooperativeKernel((const void*)mega_fwd, dim3(grid), dim3(512), args, LDS_BYTES, stream);
    if (e != hipSuccess) fprintf(stderr, "cooperative launch failed: %s (grid %d)\n", hipGetErrorString(e), grid);
}
```

```cpp
#include <hip/hip_runtime.h>
#include <hip/hip_cooperative_groups.h>
#include <cstdio>
#include <cstdint>
namespace cg = cooperative_groups;

#ifndef MK_MULTI_LAUNCH
#define MK_MULTI_LAUNCH 0
#endif

#ifndef PH_MASK
#define PH_MASK 0xFFFF
#endif
#define PH_EN(i) ((PH_MASK >> (i)) & 1)
#ifndef ATT_MASK
#define ATT_MASK 7
#endif
#define ATT_EN(i) ((ATT_MASK >> (i)) & 1)
#ifndef PH_DUP
#define PH_DUP 0
#endif
#define LAS __attribute__((address_space(3)))
typedef unsigned short bf16_t;
typedef short bf16x8 __attribute__((ext_vector_type(8)));
typedef float f32x4 __attribute__((ext_vector_type(4)));
typedef float f32x2 __attribute__((ext_vector_type(2)));
typedef float f32x16 __attribute__((ext_vector_type(16)));
typedef unsigned u32x4 __attribute__((ext_vector_type(4)));
typedef unsigned u32x2 __attribute__((ext_vector_type(2)));
typedef __bf16 bf16x2_t __attribute__((ext_vector_type(2)));
#define GAS __attribute__((address_space(1)))
typedef GAS float gfloat; typedef GAS bf16_t gbf16; typedef GAS f32x4 gf32x4; typedef GAS f32x2 gf32x2; typedef GAS u32x4 gu32x4; typedef GAS u32x2 gu32x2;
typedef GAS bf16x8 gbf16x8; typedef GAS unsigned char guchar; typedef GAS char gchar; typedef GAS unsigned gunsigned;

constexpr int DM = 1024, FF = 2816, PROJ = 5120, CH = 32768, NCH = 131072 / CH, NCH_P = NCH / 2;
constexpr int NMEM = 40 * 256;
constexpr float EPS = 1e-6f;
constexpr float LOG2E = 1.4426950408889634f;

constexpr size_t al(size_t x) { return (x + 4095) & ~(size_t)4095; }
constexpr size_t WS_WFF1I = 0;
constexpr size_t WS_WFF1O = WS_WFF1I + al((size_t)2 * FF * DM * 2);
constexpr size_t WS_WIN   = WS_WFF1O + al((size_t)DM * FF * 2);
constexpr size_t WS_WMEM  = WS_WIN + al((size_t)PROJ * DM * 2);
constexpr size_t WS_WBR   = WS_WMEM + al((size_t)DM * DM * 2);
constexpr size_t WS_WOUT  = WS_WBR + al((size_t)3 * DM * 512 * 2);
constexpr size_t WS_WFF2I = WS_WOUT + al((size_t)DM * DM * 2);
constexpr size_t WS_WFF2O = WS_WFF2I + al((size_t)2 * FF * DM * 2);
constexpr size_t WS_MEMN  = WS_WFF2O + al((size_t)DM * FF * 2);
constexpr size_t WS_KVM   = WS_MEMN + al((size_t)NMEM * DM * 2);
constexpr size_t WS_VTC   = WS_KVM + al((size_t)NMEM * DM * 2);
constexpr size_t WS_ROPE  = WS_VTC + al((size_t)NMEM * 512 * 2);
constexpr size_t WS_BIAS  = WS_ROPE + al((size_t)128 * 16 * 8);
constexpr size_t WS_XN    = WS_BIAS + al((size_t)8 * 768 * 4);
constexpr size_t WS_HID   = WS_XN + al((size_t)CH * DM * 2);
constexpr size_t WS_PROJ  = WS_HID + al((size_t)CH * FF * 2);
constexpr size_t WS_VTA   = WS_PROJ + al((size_t)CH * PROJ * 2);
constexpr size_t WS_VTB   = WS_VTA + al((size_t)CH * 128 * 2);
constexpr size_t WS_Y     = WS_VTB + al((size_t)CH * 128 * 2);
constexpr size_t WS_PART  = WS_Y + al((size_t)3 * CH * 512 * 2);
constexpr size_t WS_MRG   = WS_PART + al((size_t)CH * DM * 4);
constexpr size_t WS_SSQ   = WS_MRG + al((size_t)CH * DM * 2);
constexpr size_t WS_BAR   = WS_SSQ + al((size_t)3 * CH * 4 * 4);
constexpr size_t WS_CNT   = WS_BAR + 32768;
constexpr size_t WS_END   = WS_CNT + 32768;

constexpr int LDS_RED = 131072;
constexpr int LDS_BYTES = 138240;

__device__ __forceinline__ unsigned pk2(float lo, float hi) { f32x2 v = {lo, hi}; bf16x2_t b = __builtin_convertvector(v, bf16x2_t); return __builtin_bit_cast(unsigned, b); }
__device__ __forceinline__ float bflo(unsigned w) { return __uint_as_float(w << 16); }
__device__ __forceinline__ float bfhi(unsigned w) { return __uint_as_float(w & 0xffff0000u); }
__device__ __forceinline__ float wave_sum(float v) {
#pragma unroll
    for (int o = 1; o < 64; o <<= 1) v += __shfl_xor(v, o);
    return v;
}
__device__ __forceinline__ float sigmoidf_(float x) { return __builtin_amdgcn_rcpf(1.0f + __builtin_amdgcn_exp2f(-x * LOG2E)); }

namespace pg8 {
constexpr int BM = 256, BK = 64, HALF = 128, HTB = HALF * BK * 2, STAGE_BYTES = 8 * HTB, NXCD = 8, WGM = 8;
__host__ __device__ __forceinline__ int lds_byte(int r, int c) { const int st = (r >> 4) * 2 + (c >> 5), rr = r & 15, cc = c & 31, ob = rr * 64 + cc * 2; return st * 1024 + (ob ^ (((ob >> 9) & 1) << 5)); }
__host__ __device__ __forceinline__ void stage_rc(int b, int& R, int& C) { const int st = b / 1024, sb = b % 1024, swz = sb ^ (((sb >> 9) & 1) << 5); R = (st >> 1) * 16 + swz / 64; C = (st & 1) * 32 + (swz % 64) / 2; }
__host__ __device__ __forceinline__ int perm32(int rho) { const int n = rho >> 4, i = rho & 15; return 8 * (i >> 2) + 4 * n + (i & 3); }

struct Unit { int pm, pn, pz; };
struct Gemm { const gbf16* A; const gbf16* Bt; int M, N, K; size_t zA, zB; };

struct StaticOrder {
    int nM, nN, nwg, G, c;
    __device__ void init(int M, int N, int G_, int c_) { nM = M / BM; nN = N / BM; nwg = nM * nN; G = G_; c = c_; }
    __device__ bool next(int i, Unit& u) const {
        const long L = (long)i * G + c; if (L >= nwg) return false;
        int wgid = (int)L; { const int q = nwg / NXCD, r = nwg % NXCD, xcd = wgid % NXCD, off = wgid / NXCD; wgid = (xcd < r ? xcd * (q + 1) : r * (q + 1) + (xcd - r) * q) + off; }
        const int nig = WGM * nN, gid = wgid / nig, fm = gid * WGM, gsz = (nM - fm) < WGM ? (nM - fm) : WGM;
        u.pm = fm + ((wgid % nig) % gsz); u.pn = (wgid % nig) / gsz; u.pz = 0; return true;
    }
};
struct BranchOrder {
    StaticOrder b;
    __device__ bool next(int i, Unit& u) const { if (!b.next(i / 3, u)) return false; u.pz = i % 3; return true; }
};

struct EpiPlain {
    static constexpr bool PERM = true;
    gbf16* O; int ldc;
    __device__ __forceinline__ void operator()(const f32x4 (&acc)[2][2][4][2], const Unit& u, int wr, int wc, int fr, int fq, LAS unsigned char* lds, int tid) const {
        const int row0 = u.pm * BM + wr * 64 + fr, col0 = u.pn * BM + wc * 32 + 8 * fq;
#pragma unroll
        for (int ai = 0; ai < 2; ++ai)
#pragma unroll
            for (int m = 0; m < 4; ++m) { gbf16* rowp = O + (size_t)(row0 + ai * HALF + m * 16) * ldc + col0;
#pragma unroll
                for (int bj = 0; bj < 2; ++bj) { const f32x4 v0 = acc[ai][bj][m][0], v1 = acc[ai][bj][m][1];
                    u32x4 w; w.x = pk2(v0[0], v0[1]); w.y = pk2(v0[2], v0[3]); w.z = pk2(v1[0], v1[1]); w.w = pk2(v1[2], v1[3]);
                    *(gu32x4*)(rowp + bj * HALF) = w; } }
    }
};
struct EpiSwiglu {
    static constexpr bool PERM = true;
    gbf16* O;
    __device__ __forceinline__ void operator()(const f32x4 (&acc)[2][2][4][2], const Unit& u, int wr, int wc, int fr, int fq, LAS unsigned char* lds, int tid) const {
        const int row0 = u.pm * BM + wr * 64 + fr, col0 = u.pn * HALF + wc * 32 + 8 * fq;
#pragma unroll
        for (int ai = 0; ai < 2; ++ai)
#pragma unroll
            for (int m = 0; m < 4; ++m) { gbf16* rowp = O + (size_t)(row0 + ai * HALF + m * 16) * FF + col0;
                float h[8];
#pragma unroll
                for (int n = 0; n < 2; ++n)
#pragma unroll
                    for (int e = 0; e < 4; ++e) { const float g = acc[ai][0][m][n][e], uu = acc[ai][1][m][n][e]; h[n * 4 + e] = g * sigmoidf_(g) * uu; }
                u32x4 w; w.x = pk2(h[0], h[1]); w.y = pk2(h[2], h[3]); w.z = pk2(h[4], h[5]); w.w = pk2(h[6], h[7]);
                *(gu32x4*)rowp = w; }
    }
};
struct EpiGate {
    static constexpr bool PERM = true;
    const gbf16* proj; gbf16* part; gbf16* merged;
    __device__ __forceinline__ void operator()(const f32x4 (&acc)[2][2][4][2], const Unit& u, int wr, int wc, int fr, int fq, LAS unsigned char* lds, int tid) const {
        const int row0 = u.pm * BM + wr * 64 + fr, col0 = u.pn * BM + wc * 32 + 8 * fq;
        const int pz = u.pz;
        gbf16* dst = (pz == 2) ? merged : part;
#pragma unroll
        for (int ai = 0; ai < 2; ++ai) {
            u32x4 gv[4][2], pv[4][2];
#pragma unroll
            for (int m = 0; m < 4; ++m) { const size_t row = (size_t)(row0 + ai * HALF + m * 16);
#pragma unroll
                for (int bj = 0; bj < 2; ++bj) { const int col = col0 + bj * HALF;
                    gv[m][bj] = *(const gu32x4*)(proj + row * PROJ + 2048 + 1024 * pz + col);
                    if (pz != 0) pv[m][bj] = *(const gu32x4*)(part + row * DM + col); else pv[m][bj] = (u32x4){0u, 0u, 0u, 0u}; } }
            asm volatile("" ::: "memory");
#pragma unroll
            for (int m = 0; m < 4; ++m) { const size_t row = (size_t)(row0 + ai * HALF + m * 16);
#pragma unroll
                for (int bj = 0; bj < 2; ++bj) { const int col = col0 + bj * HALF; const u32x4 gw = gv[m][bj], pw = pv[m][bj];
                    f32x4 z0, z1;
                    z0[0] = sigmoidf_(bflo(gw.x)); z0[1] = sigmoidf_(bfhi(gw.x)); z0[2] = sigmoidf_(bflo(gw.y)); z0[3] = sigmoidf_(bfhi(gw.y));
                    z1[0] = sigmoidf_(bflo(gw.z)); z1[1] = sigmoidf_(bfhi(gw.z)); z1[2] = sigmoidf_(bflo(gw.w)); z1[3] = sigmoidf_(bfhi(gw.w));
                    const f32x4 q0 = {bflo(pw.x), bfhi(pw.x), bflo(pw.y), bfhi(pw.y)}, q1 = {bflo(pw.z), bfhi(pw.z), bflo(pw.w), bfhi(pw.w)};
                    z0 = z0 * acc[ai][bj][m][0] + q0; z1 = z1 * acc[ai][bj][m][1] + q1;
                    u32x4 w; w.x = pk2(z0[0], z0[1]); w.y = pk2(z0[2], z0[3]); w.z = pk2(z1[0], z1[1]); w.w = pk2(z1[2], z1[3]);
                    *(gu32x4*)(dst + row * DM + col) = w; } }
            asm volatile("" ::: "memory");
        }
    }
};


__device__ __forceinline__ float rstd_from(const gfloat* ssq, size_t row) { const f32x4 p = *(const gf32x4*)(ssq + row * 4); return 1.0f / sqrtf(((p.x + p.y) + (p.z + p.w)) * (1.0f / DM) + EPS); }
struct EpiPlainRstd {
    static constexpr bool PERM = true;
    gbf16* O; int ldc; const gfloat* ssq; int qscale;
    __device__ __forceinline__ void operator()(const f32x4 (&acc)[2][2][4][2], const Unit& u, int wr, int wc, int fr, int fq, LAS unsigned char* lds, int tid) const {
        const int row0 = u.pm * BM + wr * 64 + fr, col0 = u.pn * BM + wc * 32 + 8 * fq;
        const float tsc = !qscale ? 1.0f : (u.pn == 3 || u.pn == 4) ? 0.125f * LOG2E : (u.pn == 6 || u.pn == 7) ? 0.08838834764831845f * LOG2E : 1.0f;
        float rsv[2][4];
        { f32x4 pv_[2][4];
#pragma unroll
          for (int ai = 0; ai < 2; ++ai)
#pragma unroll
              for (int m = 0; m < 4; ++m) pv_[ai][m] = *(const gf32x4*)(ssq + (size_t)(row0 + ai * HALF + m * 16) * 4);
          asm volatile("" ::: "memory");
#pragma unroll
          for (int ai = 0; ai < 2; ++ai)
#pragma unroll
              for (int m = 0; m < 4; ++m) { const f32x4 p = pv_[ai][m]; rsv[ai][m] = __builtin_amdgcn_rsqf(((p.x + p.y) + (p.z + p.w)) * (1.0f / DM) + EPS) * tsc; } }
#pragma unroll
        for (int ai = 0; ai < 2; ++ai)
#pragma unroll
            for (int m = 0; m < 4; ++m) { const size_t row = (size_t)(row0 + ai * HALF + m * 16); const float rs = rsv[ai][m]; gbf16* rowp = O + row * ldc + col0;
#pragma unroll
                for (int bj = 0; bj < 2; ++bj) { const f32x4 v0 = acc[ai][bj][m][0] * rs, v1 = acc[ai][bj][m][1] * rs;
                    u32x4 w; w.x = pk2(v0[0], v0[1]); w.y = pk2(v0[2], v0[3]); w.z = pk2(v1[0], v1[1]); w.w = pk2(v1[2], v1[3]);
                    *(gu32x4*)(rowp + bj * HALF) = w; } }
    }
};
struct EpiSwigluRstd {
    static constexpr bool PERM = true;
    gbf16* O; const gfloat* ssq;
    __device__ __forceinline__ void operator()(const f32x4 (&acc)[2][2][4][2], const Unit& u, int wr, int wc, int fr, int fq, LAS unsigned char* lds, int tid) const {
        const int row0 = u.pm * BM + wr * 64 + fr, col0 = u.pn * HALF + wc * 32 + 8 * fq;
        float rsv[2][4];
        { f32x4 pv_[2][4];
#pragma unroll
          for (int ai = 0; ai < 2; ++ai)
#pragma unroll
              for (int m = 0; m < 4; ++m) pv_[ai][m] = *(const gf32x4*)(ssq + (size_t)(row0 + ai * HALF + m * 16) * 4);
          asm volatile("" ::: "memory");
#pragma unroll
          for (int ai = 0; ai < 2; ++ai)
#pragma unroll
              for (int m = 0; m < 4; ++m) { const f32x4 p = pv_[ai][m]; rsv[ai][m] = __builtin_amdgcn_rsqf(((p.x + p.y) + (p.z + p.w)) * (1.0f / DM) + EPS); } }
#pragma unroll
        for (int ai = 0; ai < 2; ++ai)
#pragma unroll
            for (int m = 0; m < 4; ++m) { const size_t row = (size_t)(row0 + ai * HALF + m * 16); const float rs = rsv[ai][m]; gbf16* rowp = O + row * FF + col0;
                float h[8];
#pragma unroll
                for (int n = 0; n < 2; ++n)
#pragma unroll
                    for (int e = 0; e < 4; ++e) { const float g = acc[ai][0][m][n][e] * rs, uu = acc[ai][1][m][n][e] * rs; h[n * 4 + e] = g * sigmoidf_(g) * uu; }
                u32x4 w; w.x = pk2(h[0], h[1]); w.y = pk2(h[2], h[3]); w.z = pk2(h[4], h[5]); w.w = pk2(h[6], h[7]);
                *(gu32x4*)rowp = w; }
    }
};
template <bool RES_BF16>
struct EpiResidStats {
    static constexpr bool PERM = true;
    const gfloat* resf; const gbf16* resb; gbf16* xb; gfloat* ssq; float scale;
    __device__ __forceinline__ void operator()(const f32x4 (&acc)[2][2][4][2], const Unit& u, int wr, int wc, int fr, int fq, LAS unsigned char* lds, int tid) const {
        const int row0 = u.pm * BM + wr * 64 + fr, col0 = u.pn * BM + wc * 32 + 8 * fq;
        LAS float* red = (LAS float*)(lds + LDS_RED);
#pragma unroll
        for (int ai = 0; ai < 2; ++ai) {
            f32x4 rv[4][2][2]; u32x4 rw[4][2];
#pragma unroll
            for (int m = 0; m < 4; ++m) { const size_t off = (size_t)(row0 + ai * HALF + m * 16) * DM + col0;
#pragma unroll
                for (int bj = 0; bj < 2; ++bj) {
                    if (RES_BF16) rw[m][bj] = *(const gu32x4*)(resb + off + bj * HALF);
                    else { rv[m][bj][0] = *(const gf32x4*)(resf + off + bj * HALF); rv[m][bj][1] = *(const gf32x4*)(resf + off + bj * HALF + 4); } } }
            asm volatile("" ::: "memory");
            if (RES_BF16) {
#pragma unroll
                for (int m = 0; m < 4; ++m)
#pragma unroll
                    for (int bj = 0; bj < 2; ++bj) { const u32x4 w = rw[m][bj];
                        rv[m][bj][0] = (f32x4){bflo(w.x), bfhi(w.x), bflo(w.y), bfhi(w.y)}; rv[m][bj][1] = (f32x4){bflo(w.z), bfhi(w.z), bflo(w.w), bfhi(w.w)}; } }
#pragma unroll
            for (int m = 0; m < 4; ++m) { const size_t off = (size_t)(row0 + ai * HALF + m * 16) * DM + col0; float ss = 0.f;
#pragma unroll
                for (int bj = 0; bj < 2; ++bj) { const f32x4 v0 = rv[m][bj][0] + acc[ai][bj][m][0] * scale, v1 = rv[m][bj][1] + acc[ai][bj][m][1] * scale;
                    u32x4 w; w.x = pk2(v0[0], v0[1]); w.y = pk2(v0[2], v0[3]); w.z = pk2(v1[0], v1[1]); w.w = pk2(v1[2], v1[3]);
                    *(gu32x4*)(xb + off + bj * HALF) = w;
                    ss += ((v0[0] * v0[0] + v0[1] * v0[1]) + (v0[2] * v0[2] + v0[3] * v0[3])) + ((v1[0] * v1[0] + v1[1] * v1[1]) + (v1[2] * v1[2] + v1[3] * v1[3])); }
                ss += __shfl_xor(ss, 16); ss += __shfl_xor(ss, 32);
                if (fq == 0) red[wc * 256 + ai * HALF + wr * 64 + m * 16 + fr] = ss; }
            asm volatile("" ::: "memory"); }
        asm volatile("s_waitcnt lgkmcnt(0)" ::: "memory"); __builtin_amdgcn_s_barrier(); asm volatile("" ::: "memory");
        if (tid < 256) ssq[(size_t)(u.pm * BM + tid) * 4 + u.pn] = (red[tid] + red[256 + tid]) + (red[512 + tid] + red[768 + tid]);
    }
};


struct EpiResidFinal {
    static constexpr bool PERM = true;
    const gbf16* res; gfloat* out; gfloat* ssq; unsigned* cnt; const gfloat* gain; float scale; unsigned want;
    __device__ __forceinline__ void operator()(f32x4 (&acc)[2][2][4][2], const Unit& u, int wr, int wc, int fr, int fq, LAS unsigned char* lds, int tid) const {
        const int row0 = u.pm * BM + wr * 64 + fr, col0 = u.pn * BM + wc * 32 + 8 * fq;
        LAS float* red = (LAS float*)(lds + LDS_RED);
        LAS float* rsl = (LAS float*)(lds + LDS_RED) + 1024;
#pragma unroll
        for (int ai = 0; ai < 2; ++ai) {
            f32x4 rv[4][2][2]; u32x4 rw[4][2];
#pragma unroll
            for (int m = 0; m < 4; ++m) { const size_t off = (size_t)(row0 + ai * HALF + m * 16) * DM + col0;
#pragma unroll
                for (int bj = 0; bj < 2; ++bj) rw[m][bj] = *(const gu32x4*)(res + off + bj * HALF); }
            asm volatile("" ::: "memory");
#pragma unroll
            for (int m = 0; m < 4; ++m)
#pragma unroll
                for (int bj = 0; bj < 2; ++bj) { const u32x4 w = rw[m][bj];
                    rv[m][bj][0] = (f32x4){bflo(w.x), bfhi(w.x), bflo(w.y), bfhi(w.y)}; rv[m][bj][1] = (f32x4){bflo(w.z), bfhi(w.z), bflo(w.w), bfhi(w.w)}; }
#pragma unroll
            for (int m = 0; m < 4; ++m) { float ss = 0.f;
#pragma unroll
                for (int bj = 0; bj < 2; ++bj)
#pragma unroll
                    for (int n = 0; n < 2; ++n) { const f32x4 v = rv[m][bj][n] + acc[ai][bj][m][n] * scale; acc[ai][bj][m][n] = v;
                        ss += (v[0] * v[0] + v[1] * v[1]) + (v[2] * v[2] + v[3] * v[3]); }
                ss += __shfl_xor(ss, 16); ss += __shfl_xor(ss, 32);
                if (fq == 0) red[wc * 256 + ai * HALF + wr * 64 + m * 16 + fr] = ss; }
            asm volatile("" ::: "memory"); }
        asm volatile("s_waitcnt lgkmcnt(0)" ::: "memory"); __builtin_amdgcn_s_barrier(); asm volatile("" ::: "memory");
        if (tid < 256) __hip_atomic_store(ssq + (size_t)(u.pm * BM + tid) * 4 + u.pn, (red[tid] + red[256 + tid]) + (red[512 + tid] + red[768 + tid]), __ATOMIC_RELAXED, __HIP_MEMORY_SCOPE_AGENT);
        asm volatile("s_waitcnt vmcnt(0)" ::: "memory"); __builtin_amdgcn_s_barrier(); asm volatile("" ::: "memory");
        if (tid == 0) {
            unsigned* c = cnt + 64 * u.pm;
            __hip_atomic_fetch_add(c, 1u, __ATOMIC_RELAXED, __HIP_MEMORY_SCOPE_AGENT);
            unsigned sp = 0;
            while (__hip_atomic_load(c, __ATOMIC_RELAXED, __HIP_MEMORY_SCOPE_AGENT) < want) { __builtin_amdgcn_s_sleep(1); if (++sp > (1u << 22)) break; }
            __builtin_amdgcn_fence(__ATOMIC_ACQUIRE, "agent");
        }
        asm volatile("s_waitcnt vmcnt(0) lgkmcnt(0)" ::: "memory"); __builtin_amdgcn_s_barrier(); asm volatile("" ::: "memory");
        if (tid < 256) { const gfloat* p = ssq + (size_t)(u.pm * BM + tid) * 4; f32x4 pv4;
            asm volatile("global_load_dwordx4 %0, %1, off sc0 sc1\n\ts_waitcnt vmcnt(0)" : "=v"(pv4) : "v"(p) : "memory");
            rsl[tid] = __builtin_amdgcn_rsqf(((pv4.x + pv4.y) + (pv4.z + pv4.w)) * (1.0f / DM) + EPS); }
        asm volatile("s_waitcnt vmcnt(0) lgkmcnt(0)" ::: "memory"); __builtin_amdgcn_s_barrier(); asm volatile("" ::: "memory");
        f32x4 gv[2][2];
#pragma unroll
        for (int bj = 0; bj < 2; ++bj)
#pragma unroll
            for (int n = 0; n < 2; ++n) gv[bj][n] = *(const gf32x4*)(gain + col0 + bj * HALF + n * 4);
#pragma unroll
        for (int ai = 0; ai < 2; ++ai)
#pragma unroll
            for (int m = 0; m < 4; ++m) { const int rl = ai * HALF + wr * 64 + m * 16 + fr; const float rs = rsl[rl]; const size_t off = (size_t)(u.pm * BM + rl) * DM + col0;
#pragma unroll
                for (int bj = 0; bj < 2; ++bj)
#pragma unroll
                    for (int n = 0; n < 2; ++n) *(gf32x4*)(out + off + bj * HALF + n * 4) = acc[ai][bj][m][n] * rs * gv[bj][n]; }
    }
};

template <class Epi, class Sched>
__device__ __forceinline__ void gemm_phase(LAS unsigned char* lds, const int tid, const Gemm g, const Sched& S, const Epi& E) {
    const int wid = __builtin_amdgcn_readfirstlane(tid >> 6), lane = tid & 63, wr = wid >> 2, wc = wid & 3, fr = lane & 15, fq = lane >> 4;
    const int K = g.K, nt = K / BK;
    unsigned voffA[2], voffB[2];
#pragma unroll
    for (int i = 0; i < 2; ++i) { int R, C; stage_rc(tid * 16 + i * 8192, R, C); const int Rb = Epi::PERM ? ((R & ~31) + perm32(R & 31)) : R;
        voffA[i] = (unsigned)(R * K + C) * 2u; voffB[i] = (unsigned)(Rb * K + C) * 2u; }
    const size_t kstep = (size_t)(BK * 2);
    const size_t hstep = (size_t)HALF * K * 2;
    const size_t tstep = 2 * hstep;
    const unsigned ldsw = (unsigned)wid * 1024u;
    const int aoff = lds_byte(wr * 64 + fr, fq * 8), boff = lds_byte(wc * 32 + fr, fq * 8);
#define PG8_SA(b, h) (((b) * 2 + (h)) * HTB)
#define PG8_SB(b, h) ((4 + (b) * 2 + (h)) * HTB)
#define PG8_STAGE(bufoff, gbase, voff) do { _Pragma("unroll") for (int _i = 0; _i < 2; ++_i) \
        __builtin_amdgcn_global_load_lds((const gunsigned*)((const gchar*)(gbase) + (voff)[_i]), (LAS unsigned*)(lds + (bufoff) + ldsw + _i * 8192), 16, 0, 0); } while (0)
#define PG8_LDA(dst, b, h) do { _Pragma("unroll") for (int m = 0; m < 4; ++m) _Pragma("unroll") for (int k = 0; k < 2; ++k) dst[m][k] = *(const LAS bf16x8*)(lds + PG8_SA(b, h) + aoff + m * 2048 + k * 1024); } while (0)
#define PG8_LDB(dst, b, h) do { _Pragma("unroll") for (int n = 0; n < 2; ++n) _Pragma("unroll") for (int k = 0; k < 2; ++k) dst[n][k] = *(const LAS bf16x8*)(lds + PG8_SB(b, h) + boff + n * 2048 + k * 1024); } while (0)
#define PG8_MMA(ai, bj, At, Bt) do { __builtin_amdgcn_s_setprio(1); _Pragma("unroll") for (int m = 0; m < 4; ++m) _Pragma("unroll") for (int n = 0; n < 2; ++n) _Pragma("unroll") for (int k = 0; k < 2; ++k) \
        acc[ai][bj][m][n] = __builtin_amdgcn_mfma_f32_16x16x32_bf16(Bt[n][k], At[m][k], acc[ai][bj][m][n], 0, 0, 0); __builtin_amdgcn_s_setprio(0); } while (0)
#define PG8_WAIT_V(n) asm volatile("s_waitcnt vmcnt(" #n ")" ::: "memory")
#define PG8_WAIT_L(n) asm volatile("s_waitcnt lgkmcnt(" #n ")" ::: "memory")
#define PG8_BAR __builtin_amdgcn_s_barrier()
#define PG8_SCHED __builtin_amdgcn_sched_barrier(0)
    Unit cur, nxt; int ui = 0;
    if (!S.next(0, cur)) return;
    f32x4 acc[2][2][4][2];
#pragma unroll
    for (int a = 0; a < 2; ++a)
#pragma unroll
        for (int b = 0; b < 2; ++b)
#pragma unroll
            for (int m = 0; m < 4; ++m)
#pragma unroll
                for (int n = 0; n < 2; ++n) acc[a][b][m][n] = (f32x4){0.f, 0.f, 0.f, 0.f};
    bf16x8 At[4][2], B0[2][2], B1[2][2];
    const gchar* cA = (const gchar*)g.A + (size_t)cur.pm * tstep + (size_t)cur.pz * g.zA; const gchar* cB = (const gchar*)g.Bt + (size_t)cur.pn * tstep + (size_t)cur.pz * g.zB;
    PG8_STAGE(PG8_SB(0, 0), cB, voffB); PG8_STAGE(PG8_SB(0, 1), cB + hstep, voffB); PG8_STAGE(PG8_SA(0, 0), cA, voffA); PG8_STAGE(PG8_SA(0, 1), cA + hstep, voffA);
    if (wr == 1) PG8_BAR;
    PG8_WAIT_V(2); PG8_BAR;
    PG8_STAGE(PG8_SB(1, 0), cB + kstep, voffB); PG8_STAGE(PG8_SA(1, 0), cA + kstep, voffA); PG8_STAGE(PG8_SB(1, 1), cB + hstep + kstep, voffB);
    PG8_WAIT_V(6); PG8_BAR;
    for (;;) {
        const bool has_next = S.next(ui + 1, nxt);
        const gchar* nA = has_next ? (const gchar*)g.A + (size_t)nxt.pm * tstep + (size_t)nxt.pz * g.zA : cA;
        const gchar* nB = has_next ? (const gchar*)g.Bt + (size_t)nxt.pn * tstep + (size_t)nxt.pz * g.zB : cB;
        for (int t = 0; t < nt; t += 2) {
            const bool last = (t == nt - 2);
            const gchar* a1 = cA + (size_t)(t + 1) * kstep;
            const gchar* a2 = last ? nA : cA + (size_t)(t + 2) * kstep; const gchar* b2 = last ? nB : cB + (size_t)(t + 2) * kstep;
            const gchar* a3 = a2 + kstep; const gchar* b3 = b2 + kstep;
            PG8_LDB(B0, 0, 0); PG8_LDB(B1, 0, 1); PG8_SCHED; PG8_LDA(At, 0, 0); PG8_STAGE(PG8_SA(1, 1), a1 + hstep, voffA);
            PG8_WAIT_V(8); PG8_WAIT_L(0); PG8_BAR; PG8_MMA(0, 0, At, B0); PG8_MMA(0, 1, At, B1); PG8_BAR; PG8_SCHED;
            PG8_LDA(At, 0, 1); PG8_STAGE(PG8_SB(0, 0), b2, voffB); PG8_STAGE(PG8_SB(0, 1), b2 + hstep, voffB); PG8_STAGE(PG8_SA(0, 0), a2, voffA);
            PG8_WAIT_V(8); PG8_WAIT_L(0); PG8_BAR; PG8_MMA(1, 0, At, B0); PG8_MMA(1, 1, At, B1); PG8_BAR; PG8_SCHED;
            PG8_LDB(B0, 1, 0); PG8_LDB(B1, 1, 1); PG8_SCHED; PG8_LDA(At, 1, 0); PG8_STAGE(PG8_SA(0, 1), a2 + hstep, voffA);
            PG8_WAIT_V(8); PG8_WAIT_L(0); PG8_BAR; PG8_MMA(0, 0, At, B0); PG8_MMA(0, 1, At, B1); PG8_BAR; PG8_SCHED;
            PG8_LDA(At, 1, 1); PG8_STAGE(PG8_SB(1, 0), b3, voffB); PG8_STAGE(PG8_SB(1, 1), b3 + hstep, voffB); PG8_STAGE(PG8_SA(1, 0), a3, voffA);
            PG8_WAIT_V(8); PG8_WAIT_L(0); PG8_BAR; PG8_MMA(1, 0, At, B0); PG8_MMA(1, 1, At, B1); PG8_BAR; PG8_SCHED;
        }
        if (wr == 0) PG8_BAR;
        E(acc, cur, wr, wc, fr, fq, lds, tid);
        if (!has_next) break;
#pragma unroll
        for (int a = 0; a < 2; ++a)
#pragma unroll
            for (int b = 0; b < 2; ++b)
#pragma unroll
                for (int m = 0; m < 4; ++m)
#pragma unroll
                    for (int n = 0; n < 2; ++n) acc[a][b][m][n] = (f32x4){0.f, 0.f, 0.f, 0.f};
        cur = nxt; cA = nA; cB = nB; ++ui;
        if (wr == 1) PG8_BAR;
    }
    PG8_WAIT_V(0);
    PG8_BAR;
#undef PG8_SA
#undef PG8_SB
#undef PG8_STAGE
#undef PG8_LDA
#undef PG8_LDB
#undef PG8_MMA
#undef PG8_WAIT_V
#undef PG8_WAIT_L
#undef PG8_BAR
#undef PG8_SCHED
}
}

constexpr int ATT_BIAS_OFF = 110592;
template <int HD, int MODE>
__device__ __forceinline__ void attn_unit(LAS unsigned char* lds, const int tid_in, const gbf16* Qg, int q_pitch, const gbf16* Kg, int k_pitch,
                                          const gbf16* Vtg, int vt_pitch, gbf16* Og, int o_pitch, int t0, int t1, float c,
                                          int q0, const gfloat* biasg, float m_init, float l_init, const gfloat* qgain, const gf32x2* ropet) {
    constexpr int KROW = HD * 2 + 16, VROW = 144, KBYTES = 64 * KROW, VBYTES = HD * VROW, BUF = KBYTES + VBYTES, NP = HD / 64;
    static_assert(3 * BUF <= ATT_BIAS_OFF, "attention LDS");
    int tid = tid_in; asm volatile("" : "+v"(tid));
    const int lane = tid & 63, wid = __builtin_amdgcn_readfirstlane(tid >> 6), r32 = lane & 31, hi = lane >> 5;
    bf16x8 qf[HD / 16];
    { const gbf16* qrow = Qg + (size_t)(wid * 32 + r32) * q_pitch + hi * 8;
      u32x4 qraw[HD / 16]; f32x4 gq[HD / 16][2], cs[HD / 16][2];
      const int pos = q0 + wid * 32 + r32;
#pragma unroll
      for (int d0 = 0; d0 < HD / 16; ++d0) { qraw[d0] = *(const gu32x4*)(qrow + d0 * 16);
          const gf32x4* gp_ = (const gf32x4*)(qgain + 16 * d0 + 8 * hi); gq[d0][0] = gp_[0]; gq[d0][1] = gp_[1];
          const gf32x4* rp_ = (const gf32x4*)(ropet + ((d0 < HD / 32) ? (pos >> 6) : (pos & 63)) * 16 + 8 * (d0 % (HD / 32)) + 4 * hi); cs[d0][0] = rp_[0]; cs[d0][1] = rp_[1]; }
      float x[HD / 16][8]; float ss = 0.f;
#pragma unroll
      for (int d0 = 0; d0 < HD / 16; ++d0) { const u32x4 v = qraw[d0];
          x[d0][0] = bflo(v.x); x[d0][1] = bfhi(v.x); x[d0][2] = bflo(v.y); x[d0][3] = bfhi(v.y); x[d0][4] = bflo(v.z); x[d0][5] = bfhi(v.z); x[d0][6] = bflo(v.w); x[d0][7] = bfhi(v.w);
#pragma unroll
          for (int e = 0; e < 8; ++e) ss += x[d0][e] * x[d0][e]; }
      { auto rr = __builtin_amdgcn_permlane32_swap(__float_as_uint(ss), __float_as_uint(ss), false, false); ss = __uint_as_float(rr[0]) + __uint_as_float(rr[1]); }
      const float rstd = (1.0f / sqrtf(ss * (1.0f / HD) + EPS)) * c;
#pragma unroll
      for (int d0 = 0; d0 < HD / 16; ++d0) {
          float y[8];
#pragma unroll
          for (int p = 0; p < 4; ++p) { const float a = x[d0][2 * p] * rstd * gq[d0][p >> 1][2 * (p & 1)], b = x[d0][2 * p + 1] * rstd * gq[d0][p >> 1][2 * (p & 1) + 1];
              const float co = cs[d0][p >> 1][2 * (p & 1)], si = cs[d0][p >> 1][2 * (p & 1) + 1];
              y[2 * p] = a * co - b * si; y[2 * p + 1] = a * si + b * co; }
          u32x4 w; w.x = pk2(y[0], y[1]); w.y = pk2(y[2], y[3]); w.z = pk2(y[4], y[5]); w.w = pk2(y[6], y[7]); qf[d0] = __builtin_bit_cast(bf16x8, w); } }
    u32x4 kstA[NP], vstA[NP], kstB[NP], vstB[NP];
    unsigned kgo[NP], vgo[NP], kl[NP], vl[NP];
#pragma unroll
    for (int p = 0; p < NP; ++p) { const int idx = tid + 512 * p; const int krow = idx / (HD / 8), kch = idx % (HD / 8), vd = idx >> 3, vch = idx & 7;
        kgo[p] = (unsigned)(krow * k_pitch + kch * 8) * 2u; vgo[p] = (unsigned)(vd * vt_pitch + vch * 8) * 2u;
        kl[p] = krow * KROW + kch * 16; vl[p] = KBYTES + vd * VROW + vch * 16; }
#define ATT_LOAD(t, KS, VS) do { const gchar* kb0_ = (const gchar*)(Kg + (size_t)(t) * 64 * k_pitch); const gchar* vb0_ = (const gchar*)(Vtg + (t) * 64); \
        _Pragma("unroll") for (int p = 0; p < NP; ++p) { KS[p] = *(const gu32x4*)(kb0_ + kgo[p]); VS[p] = *(const gu32x4*)(vb0_ + vgo[p]); } } while (0)
#define ATT_STORE(boff, KS, VS) do { _Pragma("unroll") for (int p = 0; p < NP; ++p) { *(LAS u32x4*)(lds + (boff) + kl[p]) = KS[p]; *(LAS u32x4*)(lds + (boff) + vl[p]) = VS[p]; } } while (0)
#define ATT_QK(S0, S1, boff) do { const LAS unsigned char* kb_ = lds + (boff) + krd; \
        _Pragma("unroll") for (int r = 0; r < 16; ++r) { S0[r] = 0.f; S1[r] = 0.f; } \
        _Pragma("unroll") for (int d0 = 0; d0 < HD / 16; ++d0) { \
            const bf16x8 k0_ = *(const LAS bf16x8*)(kb_ + d0 * 32); const bf16x8 k1_ = *(const LAS bf16x8*)(kb_ + 32 * KROW + d0 * 32); \
            S0 = __builtin_amdgcn_mfma_f32_32x32x16_bf16(k0_, qf[d0], S0, 0, 0, 0); S1 = __builtin_amdgcn_mfma_f32_32x32x16_bf16(k1_, qf[d0], S1, 0, 0, 0); } } while (0)
    const int pr = (r32 & 0x13) | ((r32 & 4) << 1) | ((r32 & 8) >> 1);
    const unsigned krd = pr * KROW + hi * 16, vrd = KBYTES + r32 * VROW + hi * 16;
    f32x16 o[HD / 32];
#pragma unroll
    for (int d0 = 0; d0 < HD / 32; ++d0)
#pragma unroll
        for (int r = 0; r < 16; ++r) o[d0][r] = 0.f;
    float m_run = m_init, l_run = l_init;
    const LAS float* biasl = (const LAS float*)(lds + ATT_BIAS_OFF);
    const int qpos = q0 + wid * 32 + r32;
    __syncthreads();
    ATT_LOAD(t0, kstA, vstA); if (t0 + 1 < t1) ATT_LOAD(t0 + 1, kstB, vstB);
    ATT_STORE(0, kstA, vstA); if (t0 + 1 < t1) ATT_STORE(BUF, kstB, vstB);
    if (t0 + 2 < t1) ATT_LOAD(t0 + 2, kstA, vstA);
    if (MODE == 1) { if (tid < 257) ((LAS float*)(lds + ATT_BIAS_OFF))[tid] = biasg[tid]; }
    __syncthreads();
    int bc = 0, bn = BUF, bw = 2 * BUF;
    f32x16 sa0, sa1, sb0, sb1, negm;
    ATT_QK(sa0, sa1, 0);
    { float mx0 = fmaxf(sa0[0], sa1[0]);
#pragma unroll
      for (int r = 1; r < 16; ++r) mx0 = fmaxf(fmaxf(mx0, sa0[r]), sa1[r]);
      { auto rr = __builtin_amdgcn_permlane32_swap(__float_as_uint(mx0), __float_as_uint(mx0), false, false); mx0 = fmaxf(__uint_as_float(rr[0]), __uint_as_float(rr[1])); }
      m_run = mx0;
#pragma unroll
      for (int r = 0; r < 16; ++r) { sa0[r] -= mx0; sa1[r] -= mx0; negm[r] = -mx0; } }
#define ATT_SB() __builtin_amdgcn_sched_barrier(0)
#define ATT_STEP(SC0, SC1, SN0, SN1, t, KL, VL, KSt, VSt) do { \
        const bool has2_ = ((t) + 2 < t1); \
        if ((t) > t0) __syncthreads(); \
        ATT_LOAD(min((t) + 3, t1 - 1), KL, VL);        \
        ATT_SB(); \
          \
        bf16x8 kf0_[HD / 16], kf1_[HD / 16]; \
        { const LAS unsigned char* kb_ = lds + bn + krd; \
          _Pragma("unroll") for (int d0 = 0; d0 < HD / 16; ++d0) { kf0_[d0] = *(const LAS bf16x8*)(kb_ + d0 * 32); kf1_[d0] = *(const LAS bf16x8*)(kb_ + 32 * KROW + d0 * 32); } } \
        ATT_SB(); \
__builtin_amdgcn_s_setprio(1); \
                  \
        float mx_ = fmaxf(SC0[0], SC1[0]); \
        _Pragma("unroll") for (int r = 1; r < 16; ++r) mx_ = fmaxf(fmaxf(mx_, SC0[r]), SC1[r]); \
        { auto rr = __builtin_amdgcn_permlane32_swap(__float_as_uint(mx_), __float_as_uint(mx_), false, false); mx_ = fmaxf(__uint_as_float(rr[0]), __uint_as_float(rr[1])); } \
        if (__any(mx_ > 4.0f)) { \
            const float dl_ = fmaxf(mx_, 0.f); const float al_ = __builtin_amdgcn_exp2f(-dl_); \
            m_run += dl_; l_run *= al_; \
            _Pragma("unroll") for (int r = 0; r < 16; ++r) { SC0[r] -= dl_; SC1[r] -= dl_; } \
            _Pragma("unroll") for (int d0 = 0; d0 < HD / 32; ++d0) _Pragma("unroll") for (int r = 0; r < 16; ++r) o[d0][r] *= al_; \
            _Pragma("unroll") for (int r = 0; r < 16; ++r) negm[r] = -m_run; } \
        ATT_SB(); \
          \
        SN0 = __builtin_amdgcn_mfma_f32_32x32x16_bf16(kf0_[0], qf[0], negm, 0, 0, 0); SN1 = __builtin_amdgcn_mfma_f32_32x32x16_bf16(kf1_[0], qf[0], negm, 0, 0, 0); \
        _Pragma("unroll") for (int d0 = 1; d0 < HD / 16; ++d0) { \
            SN0 = __builtin_amdgcn_mfma_f32_32x32x16_bf16(kf0_[d0], qf[d0], SN0, 0, 0, 0); SN1 = __builtin_amdgcn_mfma_f32_32x32x16_bf16(kf1_[d0], qf[d0], SN1, 0, 0, 0); } \
        float rs_ = 0.f; \
        _Pragma("unroll") for (int r = 0; r < 16; ++r) { SC0[r] = __builtin_amdgcn_exp2f(SC0[r]); rs_ += SC0[r]; } \
        bf16x8 pf_[4]; \
        { u32x4 w; \
          w.x = pk2(SC0[0], SC0[1]); w.y = pk2(SC0[2], SC0[3]); w.z = pk2(SC0[4], SC0[5]); w.w = pk2(SC0[6], SC0[7]); pf_[0] = __builtin_bit_cast(bf16x8, w); \
          w.x = pk2(SC0[8], SC0[9]); w.y = pk2(SC0[10], SC0[11]); w.z = pk2(SC0[12], SC0[13]); w.w = pk2(SC0[14], SC0[15]); pf_[1] = __builtin_bit_cast(bf16x8, w); } \
        _Pragma("unroll") for (int g_ = 0; g_ < HD / 8; ++g_) { \
            __builtin_amdgcn_sched_group_barrier(0x008, 1, 0); __builtin_amdgcn_sched_group_barrier(0x400, 2, 0); __builtin_amdgcn_sched_group_barrier(0x002, 5, 0); } \
        ATT_SB(); \
        __builtin_amdgcn_s_setprio(0); \
          \
        bf16x8 vf_[HD / 32][4]; \
        { const LAS unsigned char* vb_ = lds + bc + vrd; \
          _Pragma("unroll") for (int d0 = 0; d0 < HD / 32; ++d0) _Pragma("unroll") for (int kk = 0; kk < 4; ++kk) vf_[d0][kk] = *(const LAS bf16x8*)(vb_ + d0 * 32 * VROW + kk * 32); } \
        ATT_SB(); \
          \
        _Pragma("unroll") for (int r = 0; r < 16; ++r) { SC1[r] = __builtin_amdgcn_exp2f(SC1[r]); rs_ += SC1[r]; } \
        { u32x4 w; \
          w.x = pk2(SC1[0], SC1[1]); w.y = pk2(SC1[2], SC1[3]); w.z = pk2(SC1[4], SC1[5]); w.w = pk2(SC1[6], SC1[7]); pf_[2] = __builtin_bit_cast(bf16x8, w); \
          w.x = pk2(SC1[8], SC1[9]); w.y = pk2(SC1[10], SC1[11]); w.z = pk2(SC1[12], SC1[13]); w.w = pk2(SC1[14], SC1[15]); pf_[3] = __builtin_bit_cast(bf16x8, w); } \
        l_run += rs_; \
        ATT_SB(); \
          \
        __builtin_amdgcn_s_setprio(1); \
        _Pragma("unroll") for (int d0 = 0; d0 < HD / 32; ++d0) _Pragma("unroll") for (int kk = 0; kk < 4; ++kk) \
            o[d0] = __builtin_amdgcn_mfma_f32_32x32x16_bf16(vf_[d0][kk], pf_[kk], o[d0], 0, 0, 0); \
        ATT_SB(); \
        __builtin_amdgcn_s_setprio(0); \
        if (has2_) ATT_STORE(bw, KSt, VSt); \
        { const int tmp_ = bc; bc = bn; bn = bw; bw = tmp_; } \
    } while (0)
    int t = t0;
    for (; t + 1 < t1; t += 2) { ATT_STEP(sa0, sa1, sb0, sb1, t, kstB, vstB, kstA, vstA); ATT_STEP(sb0, sb1, sa0, sa1, t + 1, kstA, vstA, kstB, vstB); }
    if (t < t1) ATT_STEP(sa0, sa1, sb0, sb1, t, kstB, vstB, kstA, vstA);
    float l_tot; { auto rr = __builtin_amdgcn_permlane32_swap(__float_as_uint(l_run), __float_as_uint(l_run), false, false); l_tot = __uint_as_float(rr[0]) + __uint_as_float(rr[1]); }
    const float inv = 1.0f / l_tot;
    gbf16* orow = Og + (size_t)(wid * 32 + r32) * o_pitch + 4 * hi;
#pragma unroll
    for (int d0 = 0; d0 < HD / 32; ++d0)
#pragma unroll
        for (int rq = 0; rq < 4; ++rq) { u32x2 w; w.x = pk2(o[d0][4 * rq] * inv, o[d0][4 * rq + 1] * inv); w.y = pk2(o[d0][4 * rq + 2] * inv, o[d0][4 * rq + 3] * inv);
            *(gu32x2*)(orow + 32 * d0 + 8 * rq) = w; }
#undef ATT_STEP
#undef ATT_SB
#undef ATT_QK
#undef ATT_LOAD
#undef ATT_STORE
}

template <int HD, int MODE>
__device__ __forceinline__ void attn_unit_np(LAS unsigned char* lds, const int tid_in, const gbf16* Qg, int q_pitch, const gbf16* Kg, int k_pitch,
                                          const gbf16* Vtg, int vt_pitch, gbf16* Og, int o_pitch, int t0, int t1, float c,
                                          int q0, const gfloat* biasg, float m_init, float l_init) {
    constexpr int KROW = HD * 2 + 16, VROW = 144, KBYTES = 64 * KROW, VBYTES = HD * VROW, BUF = KBYTES + VBYTES, NP = HD / 64;
    static_assert(2 * BUF <= ATT_BIAS_OFF, "attention LDS");
    int tid = tid_in; asm volatile("" : "+v"(tid));
    const int lane = tid & 63, wid = __builtin_amdgcn_readfirstlane(tid >> 6), r32 = lane & 31, hi = lane >> 5;
    bf16x8 qf[HD / 16];
    { const gbf16* qrow = Qg + (size_t)(wid * 32 + r32) * q_pitch + hi * 8;
#pragma unroll
      for (int d0 = 0; d0 < HD / 16; ++d0) qf[d0] = *(const gbf16x8*)(qrow + d0 * 16); }
    u32x4 kst[NP], vst[NP];
    const gbf16* kg[NP]; const gbf16* vg[NP]; unsigned kl[NP], vl[NP];
#pragma unroll
    for (int p = 0; p < NP; ++p) { const int idx = tid + 512 * p; const int krow = idx / (HD / 8), kch = idx % (HD / 8), vd = idx >> 3, vch = idx & 7;
        kg[p] = Kg + (size_t)krow * k_pitch + kch * 8; vg[p] = Vtg + (size_t)vd * vt_pitch + vch * 8;
        kl[p] = krow * KROW + kch * 16; vl[p] = KBYTES + vd * VROW + vch * 16; }
#define ATT_LOAD(t) do { _Pragma("unroll") for (int p = 0; p < NP; ++p) { kst[p] = *(const gu32x4*)(kg[p] + (size_t)(t) * 64 * k_pitch); vst[p] = *(const gu32x4*)(vg[p] + (t) * 64); } } while (0)
#define ATT_STORE(b) do { _Pragma("unroll") for (int p = 0; p < NP; ++p) { *(LAS u32x4*)(lds + (b) * BUF + kl[p]) = kst[p]; *(LAS u32x4*)(lds + (b) * BUF + vl[p]) = vst[p]; } } while (0)
    const int pr = (r32 & 0x13) | ((r32 & 4) << 1) | ((r32 & 8) >> 1);
    const unsigned krd = pr * KROW + hi * 16, vrd = KBYTES + r32 * VROW + hi * 16;
    f32x16 o[HD / 32];
#pragma unroll
    for (int d0 = 0; d0 < HD / 32; ++d0)
#pragma unroll
        for (int r = 0; r < 16; ++r) o[d0][r] = 0.f;
    float m_run = m_init, l_run = l_init;
    const LAS float* biasl = (const LAS float*)(lds + ATT_BIAS_OFF);
    __syncthreads();
    ATT_LOAD(t0); ATT_STORE(0);
    if (MODE == 1) { ((LAS float*)(lds + ATT_BIAS_OFF))[tid] = biasg[tid]; if (tid < 256) ((LAS float*)(lds + ATT_BIAS_OFF))[512 + tid] = biasg[512 + tid]; }
    int cur = 0;
    const int qlo = q0 + wid * 32;
    for (int t = t0; t < t1; ++t) {
        __syncthreads();
        const bool more = (t + 1 < t1);
        if (more) ATT_LOAD(t + 1);
        bool active = true;
        if (MODE == 1) active = !(64 * t + 63 < qlo - 128 || 64 * t > qlo + 31 + 128);
        if (active) {
            const LAS unsigned char* kb = lds + cur * BUF + krd;
            const LAS unsigned char* vb = lds + cur * BUF + vrd;
            f32x16 s0, s1;
#pragma unroll
            for (int r = 0; r < 16; ++r) { s0[r] = 0.f; s1[r] = 0.f; }
            if constexpr (HD == 64) {
                bf16x8 kf0[HD / 16], kf1[HD / 16];
#pragma unroll
                for (int d0 = 0; d0 < HD / 16; ++d0) { kf0[d0] = *(const LAS bf16x8*)(kb + d0 * 32); kf1[d0] = *(const LAS bf16x8*)(kb + 32 * KROW + d0 * 32); }
                __builtin_amdgcn_sched_barrier(0);
                __builtin_amdgcn_s_setprio(1);
#pragma unroll
                for (int d0 = 0; d0 < HD / 16; ++d0) { s0 = __builtin_amdgcn_mfma_f32_32x32x16_bf16(kf0[d0], qf[d0], s0, 0, 0, 0); s1 = __builtin_amdgcn_mfma_f32_32x32x16_bf16(kf1[d0], qf[d0], s1, 0, 0, 0); }
                __builtin_amdgcn_s_setprio(0);
            } else {
            __builtin_amdgcn_s_setprio(1);
#pragma unroll
            for (int d0 = 0; d0 < HD / 16; ++d0) {
                const bf16x8 k0 = *(const LAS bf16x8*)(kb + d0 * 32);
                const bf16x8 k1 = *(const LAS bf16x8*)(kb + 32 * KROW + d0 * 32);
                s0 = __builtin_amdgcn_mfma_f32_32x32x16_bf16(k0, qf[d0], s0, 0, 0, 0);
                s1 = __builtin_amdgcn_mfma_f32_32x32x16_bf16(k1, qf[d0], s1, 0, 0, 0);
            }
            __builtin_amdgcn_s_setprio(0); }
            if (MODE == 1) {
                const LAS float* bl = biasl + (64 * t + 8 * hi - (qlo + r32) + 384);
#pragma unroll
                for (int r = 0; r < 16; ++r) { s0[r] += bl[16 * (r >> 3) + (r & 7)]; s1[r] += bl[32 + 16 * (r >> 3) + (r & 7)]; }
            }
            float mx = fmaxf(s0[0], s1[0]);
#pragma unroll
            for (int r = 1; r < 16; ++r) mx = fmaxf(mx, fmaxf(s0[r], s1[r]));
            { auto rr = __builtin_amdgcn_permlane32_swap(__float_as_uint(mx), __float_as_uint(mx), false, false); mx = fmaxf(__uint_as_float(rr[0]), __uint_as_float(rr[1])); }
            const float m_new = fmaxf(m_run, mx);
            const bool grew = __any(m_new > m_run);
            const float alpha = __builtin_amdgcn_exp2f(m_run - m_new);
            m_run = m_new;
            float rs = 0.f;
#pragma unroll
            for (int r = 0; r < 16; ++r) { s0[r] = __builtin_amdgcn_exp2f(s0[r] - m_new); s1[r] = __builtin_amdgcn_exp2f(s1[r] - m_new); rs += s0[r] + s1[r]; }
            l_run = l_run * alpha + rs;
            if (grew) {
#pragma unroll
                for (int d0 = 0; d0 < HD / 32; ++d0)
#pragma unroll
                    for (int r = 0; r < 16; ++r) o[d0][r] *= alpha;
            }
            bf16x8 pf[4];
            { u32x4 w;
              w.x = pk2(s0[0], s0[1]); w.y = pk2(s0[2], s0[3]); w.z = pk2(s0[4], s0[5]); w.w = pk2(s0[6], s0[7]); pf[0] = __builtin_bit_cast(bf16x8, w);
              w.x = pk2(s0[8], s0[9]); w.y = pk2(s0[10], s0[11]); w.z = pk2(s0[12], s0[13]); w.w = pk2(s0[14], s0[15]); pf[1] = __builtin_bit_cast(bf16x8, w);
              w.x = pk2(s1[0], s1[1]); w.y = pk2(s1[2], s1[3]); w.z = pk2(s1[4], s1[5]); w.w = pk2(s1[6], s1[7]); pf[2] = __builtin_bit_cast(bf16x8, w);
              w.x = pk2(s1[8], s1[9]); w.y = pk2(s1[10], s1[11]); w.z = pk2(s1[12], s1[13]); w.w = pk2(s1[14], s1[15]); pf[3] = __builtin_bit_cast(bf16x8, w); }
            if constexpr (HD == 64) {
                bf16x8 vfr[HD / 32][4];
#pragma unroll
                for (int d0 = 0; d0 < HD / 32; ++d0)
#pragma unroll
                    for (int kk = 0; kk < 4; ++kk) vfr[d0][kk] = *(const LAS bf16x8*)(vb + d0 * 32 * VROW + kk * 32);
                __builtin_amdgcn_sched_barrier(0);
                __builtin_amdgcn_s_setprio(1);
#pragma unroll
                for (int d0 = 0; d0 < HD / 32; ++d0)
#pragma unroll
                    for (int kk = 0; kk < 4; ++kk) o[d0] = __builtin_amdgcn_mfma_f32_32x32x16_bf16(vfr[d0][kk], pf[kk], o[d0], 0, 0, 0);
                __builtin_amdgcn_s_setprio(0);
            } else {
            __builtin_amdgcn_s_setprio(1);
#pragma unroll
            for (int d0 = 0; d0 < HD / 32; ++d0)
#pragma unroll
                for (int kk = 0; kk < 4; ++kk) {
                    const bf16x8 vf = *(const LAS bf16x8*)(vb + d0 * 32 * VROW + kk * 32);
                    o[d0] = __builtin_amdgcn_mfma_f32_32x32x16_bf16(vf, pf[kk], o[d0], 0, 0, 0);
                }
            __builtin_amdgcn_s_setprio(0); }
        }
        if (more) ATT_STORE(cur ^ 1);
        cur ^= 1;
    }
    float l_tot; { auto rr = __builtin_amdgcn_permlane32_swap(__float_as_uint(l_run), __float_as_uint(l_run), false, false); l_tot = __uint_as_float(rr[0]) + __uint_as_float(rr[1]); }
    const float inv = 1.0f / l_tot;
    gbf16* orow = Og + (size_t)(wid * 32 + r32) * o_pitch + 4 * hi;
#pragma unroll
    for (int d0 = 0; d0 < HD / 32; ++d0)
#pragma unroll
        for (int rq = 0; rq < 4; ++rq) { u32x2 w; w.x = pk2(o[d0][4 * rq] * inv, o[d0][4 * rq + 1] * inv); w.y = pk2(o[d0][4 * rq + 2] * inv, o[d0][4 * rq + 3] * inv);
            *(gu32x2*)(orow + 32 * d0 + 8 * rq) = w; }
#undef ATT_LOAD
#undef ATT_STORE
}

__device__ __forceinline__ void rms_row_bf16(const gfloat* src, const gfloat* gain, gbf16* dst, int lane) {
    const gf32x4* xr = (const gf32x4*)src + lane; const gf32x4* gr = (const gf32x4*)gain + lane;
    f32x4 v[4]; float s = 0.f;
#pragma unroll
    for (int j = 0; j < 4; ++j) { v[j] = xr[64 * j]; s += (v[j].x * v[j].x + v[j].y * v[j].y) + (v[j].z * v[j].z + v[j].w * v[j].w); }
    const float rstd = 1.0f / sqrtf(wave_sum(s) * (1.0f / DM) + EPS);
    gu32x2* o8 = (gu32x2*)dst + lane;
#pragma unroll
    for (int j = 0; j < 4; ++j) { const f32x4 g = gr[64 * j]; u32x2 w; w.x = pk2(v[j].x * rstd * g.x, v[j].y * rstd * g.y); w.y = pk2(v[j].z * rstd * g.z, v[j].w * rstd * g.w); o8[64 * j] = w; }
}
__device__ __forceinline__ void rms_row2_bf16(const gfloat* src0, const gfloat* src1, const gfloat* gain, gbf16* dst0, gbf16* dst1, int lane) {
    const gf32x4* x0 = (const gf32x4*)src0 + lane; const gf32x4* x1 = (const gf32x4*)src1 + lane; const gf32x4* gr = (const gf32x4*)gain + lane;
    f32x4 v[4], w[4], g[4]; float s = 0.f, t = 0.f;
#pragma unroll
    for (int j = 0; j < 4; ++j) { v[j] = x0[64 * j]; w[j] = x1[64 * j]; g[j] = gr[64 * j]; }
    asm volatile("" ::: "memory");
#pragma unroll
    for (int j = 0; j < 4; ++j) { s += (v[j].x * v[j].x + v[j].y * v[j].y) + (v[j].z * v[j].z + v[j].w * v[j].w); t += (w[j].x * w[j].x + w[j].y * w[j].y) + (w[j].z * w[j].z + w[j].w * w[j].w); }
#pragma unroll
    for (int o = 1; o < 64; o <<= 1) { s += __shfl_xor(s, o); t += __shfl_xor(t, o); }
    const float r0 = __builtin_amdgcn_rsqf(s * (1.0f / DM) + EPS), r1 = __builtin_amdgcn_rsqf(t * (1.0f / DM) + EPS);
    gu32x2* o0 = (gu32x2*)dst0 + lane; gu32x2* o1 = (gu32x2*)dst1 + lane;
#pragma unroll
    for (int j = 0; j < 4; ++j) { u32x2 a, b;
        a.x = pk2(v[j].x * r0 * g[j].x, v[j].y * r0 * g[j].y); a.y = pk2(v[j].z * r0 * g[j].z, v[j].w * r0 * g[j].w); o0[64 * j] = a;
        b.x = pk2(w[j].x * r1 * g[j].x, w[j].y * r1 * g[j].y); b.y = pk2(w[j].z * r1 * g[j].z, w[j].w * r1 * g[j].w); o1[64 * j] = b; }
}
__device__ __forceinline__ void final_row2(gfloat* p0, gfloat* p1, const gfloat* gain, float rs0, float rs1, int lane) {
    gf32x4* x0 = (gf32x4*)p0 + lane; gf32x4* x1 = (gf32x4*)p1 + lane; const gf32x4* gr = (const gf32x4*)gain + lane;
    f32x4 v[4], w[4];
#pragma unroll
    for (int j = 0; j < 4; ++j) { v[j] = x0[64 * j]; w[j] = x1[64 * j]; }
#pragma unroll
    for (int j = 0; j < 4; ++j) { const f32x4 g = gr[64 * j]; x0[64 * j] = v[j] * rs0 * g; x1[64 * j] = w[j] * rs1 * g; }
}
__device__ __forceinline__ float rstd_row(const gfloat* ssq, int row) { const f32x4 p = *(const gf32x4*)(ssq + (size_t)row * 4); return 1.0f / sqrtf(((p.x + p.y) + (p.z + p.w)) * (1.0f / DM) + EPS); }
__device__ __forceinline__ void final_row(gfloat* p, const gfloat* gain, float rstd, int lane) {
    gf32x4* xr = (gf32x4*)p + lane; const gf32x4* gr = (const gf32x4*)gain + lane;
    f32x4 v[4];
#pragma unroll
    for (int j = 0; j < 4; ++j) v[j] = xr[64 * j];
#pragma unroll
    for (int j = 0; j < 4; ++j) { const f32x4 g = gr[64 * j]; xr[64 * j] = v[j] * rstd * g; }
}
__device__ __forceinline__ void transpose_item(const gfloat* W, int K, int N, gbf16* WT, int mode, LAS float* scr, int item, int lane, const gfloat* gain = nullptr) {
    const int nblk = N / 32, kb = item / nblk, nb = item % nblk, k0 = 64 * kb, n0 = 32 * nb;
#pragma unroll 8
    for (int i = 0; i < 32; ++i) { const int kk = 2 * i + (lane >> 5); float w = W[(size_t)(k0 + kk) * N + n0 + (lane & 31)]; if (gain) w *= gain[k0 + kk]; scr[kk * 33 + (lane & 31)] = w; }
    asm volatile("s_waitcnt lgkmcnt(0)" ::: "memory");
    int r0 = n0;
    if (mode == 1) { const int half = n0 >= FF ? 1 : 0, np = n0 - FF * half; r0 = 256 * (np / 128) + 128 * half + (np % 128); }
    const int c = lane & 7;
#pragma unroll
    for (int j = 0; j < 4; ++j) { const int n = (lane >> 3) + 8 * j; const LAS float* s = scr + (8 * c) * 33 + n;
        u32x4 o; o.x = pk2(s[0 * 33], s[1 * 33]); o.y = pk2(s[2 * 33], s[3 * 33]); o.z = pk2(s[4 * 33], s[5 * 33]); o.w = pk2(s[6 * 33], s[7 * 33]);
        *(gu32x4*)(WT + (size_t)(r0 + n) * K + k0 + 8 * c) = o; }
    asm volatile("s_waitcnt lgkmcnt(0)" ::: "memory");
}
__device__ __forceinline__ void transpose64_bf16(const gbf16* src, size_t src_pitch, gbf16* dst, size_t dst_pitch, LAS unsigned short* scr, int lane) {
#pragma unroll
    for (int p = 0; p < 8; ++p) { const int row = 8 * p + (lane >> 3), ch = lane & 7; const u32x4 v = *(const gu32x4*)(src + (size_t)row * src_pitch + 8 * ch);
        LAS unsigned short* d = scr + row * 66 + 8 * ch;
        d[0] = (unsigned short)v.x; d[1] = (unsigned short)(v.x >> 16); d[2] = (unsigned short)v.y; d[3] = (unsigned short)(v.y >> 16);
        d[4] = (unsigned short)v.z; d[5] = (unsigned short)(v.z >> 16); d[6] = (unsigned short)v.w; d[7] = (unsigned short)(v.w >> 16); }
    asm volatile("s_waitcnt lgkmcnt(0)" ::: "memory");
#pragma unroll
    for (int p = 0; p < 8; ++p) { const int j = 8 * p + (lane >> 3), i0 = 8 * (lane & 7); const LAS unsigned short* s = scr + i0 * 66 + j;
        u32x4 o; o.x = (unsigned)s[0] | ((unsigned)s[66] << 16); o.y = (unsigned)s[2 * 66] | ((unsigned)s[3 * 66] << 16);
        o.z = (unsigned)s[4 * 66] | ((unsigned)s[5 * 66] << 16); o.w = (unsigned)s[6 * 66] | ((unsigned)s[7 * 66] << 16);
        *(gu32x4*)(dst + (size_t)j * dst_pitch + i0) = o; }
    asm volatile("s_waitcnt lgkmcnt(0)" ::: "memory");
}
__device__ __forceinline__ void sincos_d(double a, float& sn, float& cs) {
    const double k = rint(a * 0.63661977236758134308);
    const double r = (a - k * 1.57079632679489655800) - k * 6.123233995736766036e-17;
    const double r2 = r * r;
    const double s = r * (1.0 + r2 * (-1.0 / 6 + r2 * (1.0 / 120 + r2 * (-1.0 / 5040 + r2 * (1.0 / 362880 + r2 * (-1.0 / 39916800 + r2 * (1.0 / 6227020800.0)))))));
    const double c = 1.0 + r2 * (-0.5 + r2 * (1.0 / 24 + r2 * (-1.0 / 720 + r2 * (1.0 / 40320 + r2 * (-1.0 / 3628800 + r2 * (1.0 / 479001600.0 + r2 * (-1.0 / 87178291200.0)))))));
    const int q = ((int)k) & 3;
    const double ss = (q == 0) ? s : (q == 1) ? c : (q == 2) ? -s : -c;
    const double cc = (q == 0) ? c : (q == 1) ? -s : (q == 2) ? -c : s;
    sn = (float)ss; cs = (float)cc;
}

#define XB_TMO      128
#define XB_XCNT(j)  (256  + 64 * (j))
#define XB_XSUB(j)  (1280 + 64 * (j))
#define XB_XGEN(j)  (2304 + 64 * (j))
#define XB_TOP      3328
#define XB_TOPGEN   3392
#define XCD_BAR_WORDS 3456
#define XB_SPIN_CAP (1u << 18)

__device__ __forceinline__ unsigned xb_ld(unsigned* p)              { return __hip_atomic_load(p, __ATOMIC_RELAXED, __HIP_MEMORY_SCOPE_AGENT); }
__device__ __forceinline__ unsigned xb_add(unsigned* p, unsigned v) { return __hip_atomic_fetch_add(p, v, __ATOMIC_RELAXED, __HIP_MEMORY_SCOPE_AGENT); }
__device__ __forceinline__ unsigned xb_xcc_id() { return (unsigned)__builtin_amdgcn_s_getreg((3 << 11) | 20) & 0xFu; }
#define XB_SPIN(cond, bar) do { unsigned _sp = 0; while (cond) { __builtin_amdgcn_s_sleep(1); \
    if ((++_sp & 255u) == 0u) { if (xb_ld(&(bar)[XB_TMO])) break; if (_sp > XB_SPIN_CAP) { atomicAdd(&(bar)[XB_TMO], 1u); break; } } } } while (0)

struct XcdBarrier {
    unsigned* bar; unsigned x;
    volatile LAS unsigned* st;
};

__device__ __forceinline__ XcdBarrier xcd_barrier_post(unsigned* bar, volatile LAS unsigned* st) {
    XcdBarrier b; b.bar = bar; b.x = xb_xcc_id(); b.st = st;
    if (threadIdx.x == 0) (void)xb_add(&bar[XB_XCNT(b.x)], 1u);
    return b;
}
__device__ __forceinline__ void xcd_barrier_complete(unsigned* bar, unsigned x, unsigned& nloc, unsigned& nx) {
    const unsigned G = gridDim.x * gridDim.y * gridDim.z;
    unsigned sum, cnt, mine, sp = 0u;
    for (;;) {
        sum = 0u; cnt = 0u; mine = 0u;
#pragma unroll
        for (unsigned j = 0; j < 16; ++j) { const unsigned c = xb_ld(&bar[XB_XCNT(j)]); sum += c; cnt += (c > 0u) ? 1u : 0u; mine = (j == x) ? c : mine; }
        if (sum == G) break;
        __builtin_amdgcn_s_sleep(1);
        if ((++sp & 255u) == 0u) { if (xb_ld(&bar[XB_TMO])) break; if (sp > XB_SPIN_CAP) { atomicAdd(&bar[XB_TMO], 1u); break; } }
    }
    nloc = mine > 0u ? mine : 1u; nx = cnt > 0u ? cnt : 1u;
}

__device__ __forceinline__ void xcd_barrier(const XcdBarrier& b) {
    asm volatile("s_waitcnt vmcnt(0)" ::: "memory");
    __syncthreads();
    if (threadIdx.x == 0) {
        unsigned* bar = b.bar; const unsigned bx_ = xb_xcc_id();
        __builtin_amdgcn_s_waitcnt(0);
        unsigned nloc = b.st[0], nx = b.st[1];
        if (nloc == 0u) { xcd_barrier_complete(bar, bx_, nloc, nx); b.st[0] = nloc; b.st[1] = nx; }
        const unsigned old = xb_add(&bar[XB_XSUB(bx_)], 1u);
        const unsigned gen = old / nloc;
        if (old + 1u == (gen + 1u) * nloc) {
            __builtin_amdgcn_fence(__ATOMIC_RELEASE, "agent");
            asm volatile("s_waitcnt vmcnt(0)" ::: "memory");
            const unsigned og = xb_add(&bar[XB_TOP], 1u);
            const unsigned tg = og / nx;
            if (og + 1u == (tg + 1u) * nx) xb_add(&bar[XB_TOPGEN], 1u);
            else XB_SPIN(xb_ld(&bar[XB_TOPGEN]) == tg, bar);
            __builtin_amdgcn_fence(__ATOMIC_ACQUIRE, "agent");
            xb_add(&bar[XB_XGEN(bx_)], 1u);
            asm volatile("s_waitcnt vmcnt(0)" ::: "memory");
        } else {
            XB_SPIN(xb_ld(&bar[XB_XGEN(bx_)]) == gen, bar);
            __builtin_amdgcn_fence(__ATOMIC_ACQUIRE, "agent");
            asm volatile("s_waitcnt vmcnt(0)" ::: "memory");
        }
    }
    __syncthreads();
}


#define XL_SUB(j)  (4096 + 64 * (j))
#define XL_GEN(j)  (5120 + 64 * (j))
#define XL_RANK(j) (6144 + 64 * (j))
#define XL_BAD     7168
__device__ __forceinline__ void xcd_local_barrier(const XcdBarrier& b) {
    asm volatile("s_waitcnt vmcnt(0)" ::: "memory");
    __syncthreads();
    if (threadIdx.x == 0) {
        unsigned* bar = b.bar; const unsigned x_ = xb_xcc_id();
        __builtin_amdgcn_s_waitcnt(0);
        const unsigned nloc = b.st[0];
        const unsigned old = xb_add(&bar[XL_SUB(x_)], 1u);
        const unsigned gen = old / nloc;
        if (old + 1u == (gen + 1u) * nloc) xb_add(&bar[XL_GEN(x_)], 1u);
        else XB_SPIN(xb_ld(&bar[XL_GEN(x_)]) == gen, bar);
        __builtin_amdgcn_fence(__ATOMIC_ACQUIRE, "agent");
        asm volatile("s_waitcnt vmcnt(0)" ::: "memory");
    }
    __syncthreads();
}

struct Args { const float* in[23]; float* out; unsigned char* ws; int ph_lo, ph_hi; };
enum { I_XP = 0, I_XS, I_MP, I_MS, I_RELB, I_NFF1, I_FF1I, I_FF1O, I_NMIX, I_WIN, I_QN, I_KN, I_SINK, I_NMEM, I_WMEM, I_BRA, I_BRB, I_BRC, I_WOUT, I_NFF2, I_FF2I, I_FF2O, I_NFIN };
constexpr int N_PRO = 3, N_PER = 10, N_STEPS = N_PRO + N_PER * NCH + 1;

constexpr int LDS_XB = 136192 + 256;
constexpr int LDS_PTRS = 136192;
__device__ __forceinline__ const gfloat* ldsptr(LAS unsigned char* lds, int i) {
    const unsigned long long v = ((const LAS unsigned long long*)(lds + LDS_PTRS))[i];
    const unsigned lo = __builtin_amdgcn_readfirstlane((unsigned)v), hi = __builtin_amdgcn_readfirstlane((unsigned)(v >> 32));
    return (const gfloat*)(((unsigned long long)hi << 32) | lo);
}
#define INP(i) ldsptr(lds, (i))
__global__ void __launch_bounds__(512, 2) mega_fwd(Args a) {
    extern __shared__ __attribute__((aligned(16))) unsigned char lds_raw[];
    LAS unsigned char* lds = (LAS unsigned char*)lds_raw;
    cg::grid_group grid = cg::this_grid();
    if (threadIdx.x < 23) ((LAS unsigned long long*)(lds + LDS_PTRS))[threadIdx.x] = (unsigned long long)a.in[threadIdx.x];
    if (threadIdx.x == 23) ((LAS unsigned long long*)(lds + LDS_PTRS))[23] = (unsigned long long)a.out;
    if (threadIdx.x == 24) ((LAS unsigned long long*)(lds + LDS_PTRS))[24] = (unsigned long long)a.ws;
    if (threadIdx.x == 25) { ((volatile LAS unsigned*)(lds + LDS_XB))[0] = 0u; ((volatile LAS unsigned*)(lds + LDS_XB))[1] = 0u; }
    __syncthreads();
    const XcdBarrier xbar = xcd_barrier_post((unsigned*)(a.ws + WS_BAR), (volatile LAS unsigned*)(lds + LDS_XB));
    if (threadIdx.x == 0) { const unsigned x_ = xb_xcc_id(); ((volatile LAS unsigned*)(lds + LDS_XB))[2] = x_; ((volatile LAS unsigned*)(lds + LDS_XB))[3] = xb_add((unsigned*)(a.ws + WS_BAR) + XL_RANK(x_), 1u); ((volatile LAS unsigned*)(lds + LDS_XB))[4] = 0u; }
    __syncthreads();
    const int wave_s = __builtin_amdgcn_readfirstlane((int)threadIdx.x >> 6);
#define STEP_LOCALS \
        int tid = wave_s * 64 + (int)__builtin_amdgcn_mbcnt_hi(~0u, __builtin_amdgcn_mbcnt_lo(~0u, 0u)); asm volatile("" : "+v"(tid)); \
        const int lane = tid & 63, wave = __builtin_amdgcn_readfirstlane(tid >> 6); \
        const int G = gridDim.x, bx = blockIdx.x; \
        const int vcu = (G % 8 == 0) ? (bx % 8) * (G / 8) + bx / 8 : bx; \
        const int gw = vcu * 8 + wave, NGW = G * 8; \
        guchar* ws = (guchar*)INP(24); \
        gfloat* const outp = (gfloat*)INP(23); \
        gbf16* const W_ff1i = (gbf16*)(ws + WS_WFF1I); gbf16* const W_ff1o = (gbf16*)(ws + WS_WFF1O); gbf16* const W_in = (gbf16*)(ws + WS_WIN); \
        gbf16* const W_mem = (gbf16*)(ws + WS_WMEM); gbf16* const W_br = (gbf16*)(ws + WS_WBR); gbf16* const W_out = (gbf16*)(ws + WS_WOUT); \
        gbf16* const W_ff2i = (gbf16*)(ws + WS_WFF2I); gbf16* const W_ff2o = (gbf16*)(ws + WS_WFF2O); \
        gbf16* const memn = (gbf16*)(ws + WS_MEMN); gbf16* const kvm = (gbf16*)(ws + WS_KVM); gbf16* const vtc = (gbf16*)(ws + WS_VTC); \
        gf32x2* const rope = (gf32x2*)(ws + WS_ROPE); gfloat* const biast = (gfloat*)(ws + WS_BIAS); \
        gbf16* const xn = (gbf16*)(ws + WS_XN); gbf16* const hid = (gbf16*)(ws + WS_HID); gbf16* const proj = (gbf16*)(ws + WS_PROJ); \
        gbf16* const vta = (gbf16*)(ws + WS_VTA); gbf16* const vtb = (gbf16*)(ws + WS_VTB); gbf16* const yb3 = (gbf16*)(ws + WS_Y); \
        gbf16* const part = (gbf16*)(ws + WS_PART); gbf16* const mrg = (gbf16*)(ws + WS_MRG); gfloat* const ssq = (gfloat*)(ws + WS_SSQ);
    if (PH_EN(0)) { STEP_LOCALS
            LAS float* scr = (LAS float*)(lds + wave * 16384);
            constexpr int I_FI = (DM / 64) * (2 * FF / 32), I_FO = (FF / 64) * (DM / 32), I_IN = (DM / 64) * (PROJ / 32), I_SQ = (DM / 64) * (DM / 32), I_BR = (512 / 64) * (DM / 32);
            constexpr int NITEMS = 2 * I_FI + 2 * I_FO + I_IN + 2 * I_SQ + 3 * I_BR;
            for (int it = gw; it < NITEMS; it += NGW) {
                int r = it;
                if (r < I_FI) { transpose_item(INP(I_FF1I), DM, 2 * FF, W_ff1i, 1, scr, r, lane); continue; } r -= I_FI;
                if (r < I_FI) { transpose_item(INP(I_FF2I), DM, 2 * FF, W_ff2i, 1, scr, r, lane, INP(I_NFF2)); continue; } r -= I_FI;
                if (r < I_FO) { transpose_item(INP(I_FF1O), FF, DM, W_ff1o, 0, scr, r, lane); continue; } r -= I_FO;
                if (r < I_FO) { transpose_item(INP(I_FF2O), FF, DM, W_ff2o, 0, scr, r, lane); continue; } r -= I_FO;
                if (r < I_IN) { transpose_item(INP(I_WIN), DM, PROJ, W_in, 0, scr, r, lane, INP(I_NMIX)); continue; } r -= I_IN;
                if (r < I_SQ) { transpose_item(INP(I_WMEM), DM, DM, W_mem, 0, scr, r, lane); continue; } r -= I_SQ;
                if (r < I_SQ) { transpose_item(INP(I_WOUT), DM, DM, W_out, 0, scr, r, lane); continue; } r -= I_SQ;
                if (r < I_BR) { transpose_item(INP(I_BRA), 512, DM, W_br, 0, scr, r, lane); continue; } r -= I_BR;
                if (r < I_BR) { transpose_item(INP(I_BRB), 512, DM, W_br + (size_t)DM * 512, 0, scr, r, lane); continue; } r -= I_BR;
                transpose_item(INP(I_BRC), 512, DM, W_br + (size_t)2 * DM * 512, 0, scr, r, lane);
            }
            const gfloat* mp_p = INP(I_MP); const gfloat* ms_p = INP(I_MS); const gfloat* nmem_p = INP(I_NMEM);
            for (int m = gw; m < NMEM; m += NGW) {
                const gfloat* src = (m < 2048) ? mp_p + (size_t)m * DM : ms_p + (size_t)(m - 2048) * DM;
                rms_row_bf16(src, nmem_p, memn + (size_t)m * DM, lane);
            }
            for (int i = vcu * 512 + tid; i < 2048; i += G * 512) {
                const int n = i >> 4, j = i & 15;
                const int jl = j & 3, jh = j >> 2;
                const float b = (jl == 0) ? 1.0f : (jl == 1) ? 0.5623413251903491f : (jl == 2) ? 0.31622776601683794f : 0.1778279410038923f;
                const float s = (jh == 0) ? 1.0f : (jh == 1) ? 0.1f : (jh == 2) ? 0.01f : 0.001f;
                const float inv = b * s;
                const float ang = (float)n * inv;
                float sn, cs; sincos_d((double)ang, sn, cs);
                rope[i] = (f32x2){cs, sn};
            }
            const gfloat* relb_p = INP(I_RELB);
            for (int i = vcu * 512 + tid; i < 8 * 768; i += G * 512) {
                const int h = i / 768, rel = (i % 768) - 384;
                if (rel < -128 || rel > 128) { biast[i] = -1e30f; continue; }
                const int n = rel < 0 ? -rel : rel;
                int large = 33 - __clz(n * n > 0 ? n * n : 1); if (large > 15) large = 15;
                const int bucket = (rel > 0 ? 16 : 0) + (n < 8 ? n : large);
                biast[i] = relb_p[bucket * 8 + h] * LOG2E;
            }
    }
    grid.sync();
    if (PH_EN(1)) { STEP_LOCALS
            pg8::Gemm g{memn, W_mem, NMEM, DM, DM, 0, 0}; pg8::StaticOrder S; S.init(NMEM, DM, G, bx);
            pg8::EpiPlain E{kvm, DM};
            pg8::gemm_phase(lds, tid, g, S, E);
    }
    xcd_barrier(xbar);
    if (threadIdx.x == 0) { volatile LAS unsigned* w_ = (volatile LAS unsigned*)(lds + LDS_XB);
        if (w_[0] * 8u != gridDim.x || w_[1] != 8u || w_[2] >= 8u || w_[3] >= gridDim.x / 8u) __hip_atomic_store((unsigned*)(a.ws + WS_BAR) + XL_BAD, 1u, __ATOMIC_RELAXED, __HIP_MEMORY_SCOPE_AGENT); }
    if (PH_EN(2)) { STEP_LOCALS
            LAS unsigned short* scr = (LAS unsigned short*)(lds + wave * 16384);
            for (int it = gw; it < 40 * 4 * 4 * 2; it += NGW) {
                const int db = it & 1, h = (it >> 1) & 3, mb = (it >> 3) & 3, seq = it >> 5;
                transpose64_bf16(kvm + (size_t)(seq * 256 + 64 * mb) * DM + 512 + 128 * h + 64 * db, DM,
                                 vtc + ((size_t)(seq * 4 + h) * 128 + 64 * db) * 256 + 64 * mb, 256, scr, lane);
            }
    }
    xcd_barrier(xbar);
    if (threadIdx.x == 0) ((volatile LAS unsigned*)(lds + LDS_XB))[4] = (__hip_atomic_load((unsigned*)(a.ws + WS_BAR) + XL_BAD, __ATOMIC_RELAXED, __HIP_MEMORY_SCOPE_AGENT) == 0u) ? 1u : 0u;
    __syncthreads();
    constexpr int NS = N_PER * NCH;
    for (int step2 = 0; step2 < 2 * NS; ++step2) {
        const int step = step2 >> 1;
        const bool dup_ = ((PH_DUP >> (step % N_PER)) & 1);
        if ((step2 & 1) && !dup_) continue;
        STEP_LOCALS
        const int xl_good = __builtin_amdgcn_readfirstlane((int)((volatile LAS unsigned*)(lds + LDS_XB))[4]);
        const int xl_x = __builtin_amdgcn_readfirstlane((int)((volatile LAS unsigned*)(lds + LDS_XB))[2]), xl_r = __builtin_amdgcn_readfirstlane((int)((volatile LAS unsigned*)(lds + LDS_XB))[3]);
        const int cx = xl_good ? (xl_x + 8 * xl_r) : bx;
        {
            const int c = step / N_PER, k = step % N_PER;
            const bool prompt = c < NCH_P;
#define XIN() (INP(prompt ? I_XP : I_XS) + (size_t)(prompt ? c : c - NCH_P) * CH * DM)
#define HOUT() ((gfloat*)INP(23) + (size_t)c * CH * DM)
            const int S_ = prompt ? 8192 : 2048, nseq = CH / S_, NQB = S_ / 256;
            const int memseq0 = prompt ? (CH / 8192) * c : 8 + (CH / 2048) * (c - NCH_P);
            gfloat* const ssq1 = ssq; gfloat* const ssq2 = ssq + CH * 4; gfloat* const ssq3 = ssq + 2 * CH * 4;
            if (PH_EN(3) && k == 0) {
                const gfloat* gain = INP(I_NFF1);
                const gfloat* xin_ = XIN();
                if (xl_good && (CH / 8) % (2 * G) == 0) {
                    const int m0 = (CH / 8) * xl_x + xl_r * 8 + wave;
                    for (int i0 = 0; i0 < CH / 8; i0 += 2 * G) { const size_t ra = (size_t)(m0 + i0) * DM, rb = (size_t)(m0 + i0 + G) * DM; rms_row2_bf16(xin_ + ra, xin_ + rb, gain, xn + ra, xn + rb, lane); }
                } else
                for (int m = gw; m < CH; m += 2 * NGW) { const int m1 = (m + NGW < CH) ? m + NGW : m; rms_row2_bf16(xin_ + (size_t)m * DM, xin_ + (size_t)m1 * DM, gain, xn + (size_t)m * DM, xn + (size_t)m1 * DM, lane); }
            } else if (PH_EN(4) && k == 1) {
                pg8::Gemm g{xn, W_ff1i, CH, 2 * FF, DM, 0, 0}; pg8::StaticOrder S; S.init(CH, 2 * FF, G, cx);
                pg8::EpiSwiglu E{hid};
                pg8::gemm_phase(lds, tid, g, S, E);
            } else if (PH_EN(5) && k == 2) {
                pg8::Gemm g{hid, W_ff1o, CH, DM, FF, 0, 0}; pg8::StaticOrder S; S.init(CH, DM, G, cx);
                pg8::EpiResidStats<false> E{XIN(), nullptr, xn, ssq1, 0.5f};
                pg8::gemm_phase(lds, tid, g, S, E);
            } else if (PH_EN(5) && k == 9) {
                pg8::Gemm g{hid, W_ff2o, CH, DM, FF, 0, 0}; pg8::StaticOrder S; S.init(CH, DM, G, cx);
                pg8::EpiResidFinal E{xn, HOUT(), ssq3, (unsigned*)(ws + WS_CNT), INP(I_NFIN), 0.5f, 4u * (unsigned)(c + 1)};
                pg8::gemm_phase(lds, tid, g, S, E);
            } else if (PH_EN(6) && k == 3) {
                pg8::Gemm g{xn, W_in, CH, PROJ, DM, 0, 0}; pg8::StaticOrder S; S.init(CH, PROJ, G, cx);
                pg8::EpiPlainRstd E{proj, PROJ, ssq1, 1};
                pg8::gemm_phase(lds, tid, g, S, E);
            } else if (PH_EN(7) && k == 4) {
                const gfloat* qn_p = INP(I_QN); const gfloat* kn_p = INP(I_KN);
                for (int wi = gw; wi < CH * 2 / 8; wi += 2 * NGW) {
                    const int sub = lane & 7;
                    gbf16* pp[2]; u32x4 vv[2]; int posv[2], hhv[2];
#pragma unroll
                    for (int q = 0; q < 2; ++q) { const int item = (wi + q * NGW) * 8 + (lane >> 3); const int tok = item / 2, hh = 8 + (item & 1);
                        pp[q] = proj + (size_t)tok * PROJ + 64 * hh + 8 * sub; vv[q] = *(const gu32x4*)pp[q]; posv[q] = tok % S_; hhv[q] = hh; }
#pragma unroll
                    for (int q = 0; q < 2; ++q) {
                        const u32x4 v = vv[q]; const int hh = hhv[q], pos = posv[q];
                        float x[8] = {bflo(v.x), bfhi(v.x), bflo(v.y), bfhi(v.y), bflo(v.z), bfhi(v.z), bflo(v.w), bfhi(v.w)};
                        float ss = 0.f;
#pragma unroll
                        for (int e = 0; e < 8; ++e) ss += x[e] * x[e];
                        ss += __shfl_xor(ss, 1); ss += __shfl_xor(ss, 2); ss += __shfl_xor(ss, 4);
                        const float rstd = (1.0f / sqrtf(ss * (1.0f / 64) + EPS)) * ((hh < 8) ? 0.125f * LOG2E : 1.0f);
                        const gfloat* gn = ((hh < 8) ? qn_p : kn_p) + 8 * sub;
                        const f32x4 g0 = *(const gf32x4*)gn, g1 = *(const gf32x4*)(gn + 4);
                        x[0] *= rstd * g0.x; x[1] *= rstd * g0.y; x[2] *= rstd * g0.z; x[3] *= rstd * g0.w;
                        x[4] *= rstd * g1.x; x[5] *= rstd * g1.y; x[6] *= rstd * g1.z; x[7] *= rstd * g1.w;
                        const int nidx = (sub < 4) ? (pos >> 6) : (pos & 63);
                        const gf32x4* rt = (const gf32x4*)(rope + nidx * 16 + 4 * (sub & 3));
                        const f32x4 c01 = rt[0], c23 = rt[1];
                        float y[8];
                        y[0] = x[0] * c01.x - x[1] * c01.y; y[1] = x[0] * c01.y + x[1] * c01.x;
                        y[2] = x[2] * c01.z - x[3] * c01.w; y[3] = x[2] * c01.w + x[3] * c01.z;
                        y[4] = x[4] * c23.x - x[5] * c23.y; y[5] = x[4] * c23.y + x[5] * c23.x;
                        y[6] = x[6] * c23.z - x[7] * c23.w; y[7] = x[6] * c23.w + x[7] * c23.z;
                        u32x4 w; w.x = pk2(y[0], y[1]); w.y = pk2(y[2], y[3]); w.z = pk2(y[4], y[5]); w.w = pk2(y[6], y[7]);
                        *(gu32x4*)pp[q] = w;
                    }
                }
                LAS unsigned short* scr = (LAS unsigned short*)(lds + wave * 16384);
                for (int it = gw; it < (CH / 64) * 4; it += NGW) {
                    const int kvh = it & 1, which = (it >> 1) & 1, tt = it >> 2;
                    const int tok = 64 * tt, seq = tok / S_, pos = tok % S_;
                    transpose64_bf16(proj + (size_t)tok * PROJ + (which ? 1408 : 640) + 64 * kvh, PROJ,
                                     (which ? vtb : vta) + ((size_t)(seq * 2 + kvh) * 64) * S_ + pos, S_, scr, lane);
                }
            } else if (PH_EN(8) && k == 5) {
                const gfloat* qn_att = INP(I_QN);
                for (int u = vcu; ATT_EN(0) && u < (CH / 256) * 8; u += G) {
                    const int qb = u % NQB, g4 = (u / NQB) % 4, kvh = (u / NQB / 4) % 2, seq = u / (NQB * 8), head = kvh * 4 + g4;
                    const size_t tokq = (size_t)seq * S_ + (size_t)qb * 256;
                    attn_unit<64, 0>(lds, tid, proj + tokq * PROJ + 64 * head, PROJ, proj + (size_t)seq * S_ * PROJ + 512 + 64 * kvh, PROJ,
                                     vta + ((size_t)(seq * 2 + kvh) * 64) * S_, S_, yb3 + tokq * 512 + 64 * head, 512, 0, S_ / 64,
                                     0.125f * LOG2E, qb * 256, nullptr, -1e30f, 0.f, qn_att, rope);
                }
                for (int u = vcu; ATT_EN(1) && u < (CH / 256) * 8; u += G) {
                    const int qb = u % NQB, g4 = (u / NQB) % 4, kvh = (u / NQB / 4) % 2, seq = u / (NQB * 8), head = kvh * 4 + g4;
                    const size_t tokq = (size_t)seq * S_ + (size_t)qb * 256;
                    const int q0 = qb * 256;
                    const int t0 = (q0 >= 128) ? (q0 - 128) / 64 : 0, t1 = min(S_, q0 + 384) / 64;
                    attn_unit_np<64, 1>(lds, tid, proj + tokq * PROJ + 768 + 64 * head, PROJ, proj + (size_t)seq * S_ * PROJ + 1280 + 64 * kvh, PROJ,
                                     vtb + ((size_t)(seq * 2 + kvh) * 64) * S_, S_, yb3 + (size_t)CH * 512 + tokq * 512 + 64 * head, 512, t0, t1,
                                     0.125f * LOG2E, q0, biast + head * 768, INP(I_SINK)[head] * LOG2E, 1.0f);
                }
                for (int u = vcu; ATT_EN(2) && u < (CH / 256) * 4; u += G) {
                    const int qb = u % NQB, h = (u / NQB) % 4, seq = u / (NQB * 4);
                    const size_t tokq = (size_t)seq * S_ + (size_t)qb * 256;
                    const int ms = memseq0 + seq;
                    attn_unit_np<128, 0>(lds, tid, proj + tokq * PROJ + 1536 + 128 * h, PROJ, kvm + (size_t)ms * 256 * DM + 128 * h, DM,
                                      vtc + ((size_t)(ms * 4 + h) * 128) * 256, 256, yb3 + (size_t)2 * CH * 512 + tokq * 512 + 128 * h, 512, 0, 4,
                                      0.08838834764831845f * LOG2E, 0, nullptr, -1e30f, 0.f);
                }
                __syncthreads();
            } else if (PH_EN(9) && k == 6) {
                pg8::Gemm g{yb3, W_br, CH, DM, 512, (size_t)CH * 512 * 2, (size_t)DM * 512 * 2}; pg8::BranchOrder S; S.b.init(CH, DM, G, cx);
                pg8::EpiGate E{proj, part, mrg};
                pg8::gemm_phase(lds, tid, g, S, E);
            } else if (PH_EN(10) && k == 7) {
                pg8::Gemm g{mrg, W_out, CH, DM, DM, 0, 0}; pg8::StaticOrder S; S.init(CH, DM, G, cx);
                pg8::EpiResidStats<true> E{nullptr, xn, xn, ssq2, 1.0f};
                pg8::gemm_phase(lds, tid, g, S, E);
            } else if (PH_EN(11) && k == 8) {
                pg8::Gemm g{xn, W_ff2i, CH, 2 * FF, DM, 0, 0}; pg8::StaticOrder S; S.init(CH, 2 * FF, G, cx);
                pg8::EpiSwigluRstd E{hid, ssq2};
                pg8::gemm_phase(lds, tid, g, S, E);
            }
        }
        if ((step2 & 1) || !dup_) {
            if (step + 1 < NS) { const int k_ = step % N_PER;
                if (xl_good && PH_DUP == 0 && (k_ <= 2 || k_ >= 6)) xcd_local_barrier(xbar);
                else xcd_barrier(xbar); }
        } else xcd_barrier(xbar);
    }
}

extern "C" void kernel_launch(void* const* d_in, const int* in_sizes, int n_in, void* d_out, int out_size, void* d_ws, size_t ws_size, hipStream_t stream) {
    static int grid = 0;
    if (grid == 0) {
        if (n_in != 23 || ws_size < WS_END) { fprintf(stderr, "kernel_launch: unexpected n_in %d or ws_size %zu (need %zu)\n", n_in, ws_size, (size_t)WS_END); grid = -1; return; }
        int dev = 0, cus = 0, per_cu = 0;
        hipGetDevice(&dev);
        hipDeviceGetAttribute(&cus, hipDeviceAttributeMultiprocessorCount, dev);
        if (hipFuncSetAttribute((const void*)mega_fwd, hipFuncAttributeMaxDynamicSharedMemorySize, LDS_BYTES) != hipSuccess) { fprintf(stderr, "kernel_launch: hipFuncSetAttribute failed\n"); }
        if (hipOccupancyMaxActiveBlocksPerMultiprocessor(&per_cu, (const void*)mega_fwd, 512, LDS_BYTES) != hipSuccess || per_cu < 1) { fprintf(stderr, "kernel_launch: occupancy query gave %d\n", per_cu); per_cu = 1; }
        (void)hipGetLastError();
        grid = cus * 1;
        fprintf(stderr, "kernel_launch: cus %d per_cu %d grid %d ws %zu\n", cus, per_cu, grid, ws_size);
    }
    if (grid < 0) return;
    Args a{};
    for (int i = 0; i < 23; ++i) a.in[i] = (const float*)d_in[i];
    a.out = (float*)d_out; a.ws = (unsigned char*)d_ws;
    a.ph_lo = 0; a.ph_hi = 0;
    if (hipMemsetAsync((char*)d_ws + WS_BAR, 0, 32768 + 32768, stream) != hipSuccess) { fprintf(stderr, "kernel_launch: hipMemsetAsync failed\n"); return; }
    void* args[] = {&a};
    hipError_t e = hipLaunchCooperativeKernel((const void*)mega_fwd, dim3(grid), dim3(512), args, LDS_BYTES, stream);
    if (e != hipSuccess) fprintf(stderr, "cooperative launch failed: %s (grid %d)\n", hipGetErrorString(e), grid);
}
```
